# Optimizing an MI355X kernel written in HIP

```python
import math
import jax, jax.numpy as jnp
from jax import lax
import numpy as np


D_MODEL = 4096
BATCH = 1
SEQ = 8192
DEPTH = 1
DEC_BATCH = 16
DEC_SEQ = 16
PAST_LEN = 2048

CHUNK = 64
QBLK = 128
HEAD_DIM = 128
MIX_WIDTH = D_MODEL
A_WIDTH = MIX_WIDTH // 2
B_WIDTH = MIX_WIDTH - A_WIDTH
A_HEADS = A_WIDTH // (2 * HEAD_DIM)
B_HEADS = B_WIDTH // HEAD_DIM
ROT_DIM = HEAD_DIM // 4
ROPE_THETA = 500000.0
D_FF = 4 * D_MODEL
IN_WIDTH = 3 * A_WIDTH + 3 * B_WIDTH
EPS = 1e-6
NEG = -1e30

kernel_name = "hybrid_diff_stickbreaking_stream_step"


def _rmsnorm(x, g):
    xf = x.astype(jnp.float32)
    y = xf * lax.rsqrt(jnp.mean(xf * xf, axis=-1, keepdims=True) + EPS)
    return (y * g.astype(jnp.float32)).astype(x.dtype)


def _partial_rope(x, pos):
    half = ROT_DIM // 2
    inv = 1.0 / (ROPE_THETA ** (jnp.arange(0, ROT_DIM, 2, dtype=jnp.float32) / ROT_DIM))
    ang = pos.astype(jnp.float32)[:, None] * inv[None, :]
    shape = (1, ang.shape[0]) + (1,) * (x.ndim - 3) + (half,)
    cos = jnp.cos(ang).reshape(shape).astype(x.dtype)
    sin = jnp.sin(ang).reshape(shape).astype(x.dtype)
    x1 = x[..., :half]
    x2 = x[..., half:ROT_DIM]
    return jnp.concatenate([x1 * cos - x2 * sin, x2 * cos + x1 * sin, x[..., ROT_DIM:]], axis=-1)


def _project(h, w_in, pos):
    B, T, _ = h.shape
    proj = jnp.einsum('btd,de->bte', h, w_in)
    aq, ak, av, bq, bk, bv = jnp.split(
        proj, [A_WIDTH, 2 * A_WIDTH, 3 * A_WIDTH, 3 * A_WIDTH + B_WIDTH, 3 * A_WIDTH + 2 * B_WIDTH], axis=-1)
    aq = _partial_rope(aq.reshape(B, T, A_HEADS, 2, HEAD_DIM), pos)
    ak = _partial_rope(ak.reshape(B, T, A_HEADS, 2, HEAD_DIM), pos)
    av = av.reshape(B, T, A_HEADS, 2 * HEAD_DIM)
    bq = bq.reshape(B, T, B_HEADS, HEAD_DIM)
    bk = bk.reshape(B, T, B_HEADS, HEAD_DIM)
    bv = bv.reshape(B, T, B_HEADS, HEAD_DIM)
    return aq, ak, av, bq, bk, bv


def _diff_attn_block(q, q_pos, k, v, k_pos, lam):
    s = jnp.einsum('bqhcd,bkhcd->bhcqk', q, k).astype(jnp.float32) * (HEAD_DIM ** -0.5)
    mask = (k_pos[None, :] // CHUNK) <= (q_pos[:, None] // CHUNK)
    s = jnp.where(mask, s, NEG)
    p = jax.nn.softmax(s, axis=-1)
    attn = p[:, :, 0] - lam * p[:, :, 1]
    return jnp.einsum('bhqk,bkhe->bqhe', attn.astype(v.dtype), v)


def _stick_block(q, q_pos, k, v, k_pos):
    z = jnp.einsum('bqhd,bkhd->bhqk', q, k).astype(jnp.float32) * (HEAD_DIM ** -0.5)
    mask = k_pos[None, :] < q_pos[:, None]
    log_beta = jax.nn.log_sigmoid(z)
    log_1mb = jnp.where(mask, jax.nn.log_sigmoid(-z), 0.0)
    tail = lax.cumsum(log_1mb, axis=3, reverse=True) - log_1mb
    a = jnp.where(mask, jnp.exp(log_beta + tail), 0.0)
    return jnp.einsum('bhqk,bkhd->bqhd', a.astype(v.dtype), v)


def _sweep(fn, q, q_pos, *rest):
    B, T = q.shape[0], q.shape[1]
    nb = T // QBLK
    qb = jnp.moveaxis(q.reshape((B, nb, QBLK) + q.shape[2:]), 1, 0)
    pb = q_pos.reshape(nb, QBLK)
    out = lax.map(lambda a: fn(a[0], a[1], *rest), (qb, pb))
    return jnp.moveaxis(out, 0, 1).reshape((B, T) + out.shape[3:])


def _merge(oa, ob, g_subln, g_sb, lam_init, w_out):
    B, T = oa.shape[0], oa.shape[1]
    oa = _rmsnorm(oa, g_subln) * (1.0 - lam_init)
    ob = _rmsnorm(ob, g_sb)
    o = jnp.concatenate([oa.reshape(B, T, A_WIDTH), ob.reshape(B, T, B_WIDTH)], axis=-1)
    return jnp.einsum('bte,ed->btd', o, w_out)


def _mlp(x, g, w_up, w_down):
    h = _rmsnorm(x, g)
    u = jnp.square(jax.nn.relu(jnp.einsum('btd,df->btf', h, w_up)))
    return jnp.einsum('btf,fd->btd', u, w_down)


def setup_inputs(seed: int = 0) -> dict:
    key = jax.random.key(seed)
    ks = jax.random.split(key, 20)
    f32 = jnp.float32
    nrm = lambda k, shape, s: jax.random.normal(k, shape, f32) * s
    return {
        'x_prompt': nrm(ks[0], (BATCH, SEQ, D_MODEL), 1.0),
        'x_sample': nrm(ks[1], (DEC_BATCH, DEC_SEQ, D_MODEL), 1.0),
        'cache_a_k': nrm(ks[2], (DEPTH, DEC_BATCH, PAST_LEN, A_HEADS, 2, HEAD_DIM), 1.0),
        'cache_a_v': nrm(ks[3], (DEPTH, DEC_BATCH, PAST_LEN, A_HEADS, 2 * HEAD_DIM), 1.0),
        'cache_b_k': nrm(ks[4], (DEPTH, DEC_BATCH, PAST_LEN, B_HEADS, HEAD_DIM), 1.0),
        'cache_b_v': nrm(ks[5], (DEPTH, DEC_BATCH, PAST_LEN, B_HEADS, HEAD_DIM), 1.0),
        'g_attn': 1.0 + nrm(ks[6], (DEPTH, D_MODEL), 0.02),
        'w_in': nrm(ks[7], (DEPTH, D_MODEL, IN_WIDTH), D_MODEL ** -0.5),
        'lambda_q1': nrm(ks[8], (DEPTH, HEAD_DIM), 0.1),
        'lambda_k1': nrm(ks[9], (DEPTH, HEAD_DIM), 0.1),
        'lambda_q2': nrm(ks[10], (DEPTH, HEAD_DIM), 0.1),
        'lambda_k2': nrm(ks[11], (DEPTH, HEAD_DIM), 0.1),
        'g_subln': 1.0 + nrm(ks[12], (DEPTH, 2 * HEAD_DIM), 0.02),
        'g_sb': 1.0 + nrm(ks[13], (DEPTH, HEAD_DIM), 0.02),
        'w_out': nrm(ks[14], (DEPTH, MIX_WIDTH, D_MODEL), MIX_WIDTH ** -0.5),
        'g_mlp': 1.0 + nrm(ks[15], (DEPTH, D_MODEL), 0.02),
        'w_up': nrm(ks[16], (DEPTH, D_MODEL, D_FF), D_MODEL ** -0.5),
        'w_down': nrm(ks[17], (DEPTH, D_FF, D_MODEL), D_FF ** -0.5),
        'g_final': 1.0 + nrm(ks[18], (D_MODEL,), 0.02),
    }


def reference(x_prompt, x_sample, cache_a_k, cache_a_v, cache_b_k, cache_b_v,
              g_attn, w_in, lambda_q1, lambda_k1, lambda_q2, lambda_k2,
              g_subln, g_sb, w_out, g_mlp, w_up, w_down, g_final):
    seq = x_prompt.shape[1]
    dec_seq = x_sample.shape[1]
    past = cache_a_k.shape[2]
    pos_p = jnp.arange(seq, dtype=jnp.int32)
    pos_s = past + jnp.arange(dec_seq, dtype=jnp.int32)
    pos_kv = jnp.arange(past + dec_seq, dtype=jnp.int32)

    xp, xs = x_prompt, x_sample
    akp, avp, bkp, bvp = [], [], [], []
    aks, avs, bks, bvs = [], [], [], []
    for l in range(DEPTH):
        lam_init = 0.8 - 0.6 * math.exp(-0.3 * l)
        lam = (jnp.exp(jnp.sum(lambda_q1[l].astype(jnp.float32) * lambda_k1[l].astype(jnp.float32)))
               - jnp.exp(jnp.sum(lambda_q2[l].astype(jnp.float32) * lambda_k2[l].astype(jnp.float32)))
               + lam_init)

        hp = _rmsnorm(xp, g_attn[l])
        aq, ak, av, bq, bk, bv = _project(hp, w_in[l], pos_p)
        oa = _sweep(_diff_attn_block, aq, pos_p, ak, av, pos_p, lam)
        ob = _sweep(_stick_block, bq, pos_p, bk, bv, pos_p)
        xp = xp + _merge(oa, ob, g_subln[l], g_sb[l], lam_init, w_out[l])
        xp = xp + _mlp(xp, g_mlp[l], w_up[l], w_down[l])
        akp.append(ak); avp.append(av); bkp.append(bk); bvp.append(bv)

        hs = _rmsnorm(xs, g_attn[l])
        aq, ak, av, bq, bk, bv = _project(hs, w_in[l], pos_s)
        ka = jnp.concatenate([cache_a_k[l], ak], axis=1)
        va = jnp.concatenate([cache_a_v[l], av], axis=1)
        kb = jnp.concatenate([cache_b_k[l], bk], axis=1)
        vb = jnp.concatenate([cache_b_v[l], bv], axis=1)
        oa = _diff_attn_block(aq, pos_s, ka, va, pos_kv, lam)
        ob = _stick_block(bq, pos_s, kb, vb, pos_kv)
        xs = xs + _merge(oa, ob, g_subln[l], g_sb[l], lam_init, w_out[l])
        xs = xs + _mlp(xs, g_mlp[l], w_up[l], w_down[l])
        aks.append(ak); avs.append(av); bks.append(bk); bvs.append(bv)

    y_prompt = _rmsnorm(xp, g_final)
    y_sample = _rmsnorm(xs, g_final)
    return (y_prompt, y_sample,
            jnp.stack(akp), jnp.stack(avp), jnp.stack(bkp), jnp.stack(bvp),
            jnp.stack(aks), jnp.stack(avs), jnp.stack(bks), jnp.stack(bvs))
```

```cpp
#ifndef MK_N_LAUNCHES
#define MK_N_LAUNCHES 8
#endif
#include <hip/hip_runtime.h>
#include <cstdio>
#include <cstdint>
#include <cmath>
namespace pg8 {
#define PG8_LAS __attribute__((address_space(3)))
typedef unsigned short bf16_t;
typedef short bf16x8 __attribute__((ext_vector_type(8)));
typedef float f32x4 __attribute__((ext_vector_type(4)));
typedef unsigned u32x4 __attribute__((ext_vector_type(4)));
constexpr int BM = 256, BK = 64, HALF = 128, HTB = HALF * BK * 2  , STAGE_BYTES = 8 * HTB, NXCD = 8, WGM = 8;

__host__ __device__ __forceinline__ int lds_byte(int r, int c) { const int st = (r >> 4) * 2 + (c >> 5), rr = r & 15, cc = c & 31, ob = rr * 64 + cc * 2; return st * 1024 + (ob ^ (((ob >> 9) & 1) << 5)); }
__host__ __device__ __forceinline__ void stage_rc(int b, int& R, int& C) { const int st = b / 1024, sb = b % 1024, swz = sb ^ (((sb >> 9) & 1) << 5); R = (st >> 1) * 16 + swz / 64; C = (st & 1) * 32 + (swz % 64) / 2; }
__host__ __device__ __forceinline__ int perm32(int rho) { const int n = rho >> 4, i = rho & 15; return 8 * (i >> 2) + 4 * n + (i & 3); }

struct Unit { int pm, pn; };
struct Gemm { const bf16_t* A; const bf16_t* Bt; int M, N, K; };

struct StaticOrder {
    int nM, nN, nwg, G, c;
    __host__ __device__ void init(int M, int N, int G_, int c_) { nM = M / BM; nN = N / BM; nwg = nM * nN; G = G_; c = c_; }
    __host__ __device__ bool next(int i, Unit& u) const {
        const long L = (long)i * G + c; if (L >= nwg) return false;
        int wgid = (int)L; { const int q = nwg / NXCD, r = nwg % NXCD, xcd = wgid % NXCD, off = wgid / NXCD; wgid = (xcd < r ? xcd * (q + 1) : r * (q + 1) + (xcd - r) * q) + off; }
        const int nig = WGM * nN, gid = wgid / nig, fm = gid * WGM, gsz = (nM - fm) < WGM ? (nM - fm) : WGM;
        u.pm = fm + ((wgid % nig) % gsz); u.pn = (wgid % nig) / gsz; return true;
    }
    __device__ __forceinline__ void a_ready(const Unit&) const {}
    __device__ __forceinline__ void done(const Unit&) const {}
};

__device__ __forceinline__ unsigned cvt_pk_bf16(float lo, float hi) { unsigned r; asm volatile("v_cvt_pk_bf16_f32 %0, %1, %2" : "=v"(r) : "v"(lo), "v"(hi)); return r; }
typedef float f32x2 __attribute__((ext_vector_type(2)));
constexpr int E_DM = 4096, E_TP = 8192, E_MROWS = 8448, E_HW = 2048, E_DFF = 16384;
constexpr float E_EPS = 1e-6f;
__device__ __forceinline__ float dot4(const f32x4 a) { return (a[0] * a[0] + a[1] * a[1]) + (a[2] * a[2] + a[3] * a[3]); }
__device__ __forceinline__ void ssq_add(float* p, float v) { __hip_atomic_fetch_add(p, v, __ATOMIC_RELAXED, __HIP_MEMORY_SCOPE_AGENT); }

struct EpiInProj {
    static constexpr bool PERM = true, AFTER_DRAIN = false;
    bf16_t* qkv;
    float* out_kvp;
    float* out_kvs;
    const float* rope;
    __device__ __forceinline__ void operator()(const f32x4 (&acc)[2][2][4][2], const Unit& u, int wr, int wc, int fr, int fq) const {
        const int t = u.pn >> 3;
        const int col0 = (u.pn & 7) * BM + wc * 32 + 8 * fq;
        const int row0 = u.pm * BM + wr * 64 + fr;
        bf16_t* base = qkv + (size_t)t * ((size_t)E_MROWS * E_HW);
        float* fo = nullptr;
        if (t == 1 || t == 2 || t == 4 || t == 5) {
            const int idx = (t == 1) ? 0 : (t == 2) ? 1 : (t == 4) ? 2 : 3;
            fo = (u.pm < 32) ? out_kvp + (size_t)idx * ((size_t)E_TP * E_HW) : out_kvs + (size_t)idx * (256 * E_HW) - (size_t)E_TP * E_HW;
        }
        const bool rope_on = (t < 2) && (wc == 0);
        const float sgn = (fq < 2) ? -1.f : 1.f;
#pragma unroll
        for (int ai = 0; ai < 2; ++ai)
#pragma unroll
            for (int m = 0; m < 4; ++m) {
                const int row = row0 + ai * HALF + m * 16;
                f32x4 v[2][2];
#pragma unroll
                for (int bj = 0; bj < 2; ++bj)
#pragma unroll
                    for (int n = 0; n < 2; ++n) v[bj][n] = acc[ai][bj][m][n];
                if (rope_on) {
                    const float* rp = rope + (size_t)row * 32 + 8 * (fq & 1);
                    const f32x4 c0 = *(const f32x4*)(rp), c1 = *(const f32x4*)(rp + 4), s0 = *(const f32x4*)(rp + 16), s1 = *(const f32x4*)(rp + 20);
#pragma unroll
                    for (int bj = 0; bj < 2; ++bj)
#pragma unroll
                        for (int n = 0; n < 2; ++n)
#pragma unroll
                            for (int j = 0; j < 4; ++j) {
                                const float mine = v[bj][n][j], other = __shfl_xor(mine, 32);
                                const float cc = n ? c1[j] : c0[j], ss = n ? s1[j] : s0[j];
                                v[bj][n][j] = mine * cc + sgn * other * ss;
                            }
                }
#pragma unroll
                for (int bj = 0; bj < 2; ++bj) {
                    u32x4 w; w.x = cvt_pk_bf16(v[bj][0][0], v[bj][0][1]); w.y = cvt_pk_bf16(v[bj][0][2], v[bj][0][3]); w.z = cvt_pk_bf16(v[bj][1][0], v[bj][1][1]); w.w = cvt_pk_bf16(v[bj][1][2], v[bj][1][3]);
                    *(u32x4*)(base + (size_t)row * E_HW + col0 + bj * HALF) = w;
                }
                if (fo) {
#pragma unroll
                    for (int bj = 0; bj < 2; ++bj) { float* p = fo + (size_t)row * E_HW + col0 + bj * HALF; *(f32x4*)p = v[bj][0]; *(f32x4*)(p + 4) = v[bj][1]; }
                }
            }
    }
};

struct EpiOutProj {
    static constexpr bool PERM = true, AFTER_DRAIN = false;
    const float* xp; const float* xs; const float* g; float* x1; bf16_t* h1; float* ssq;
    __device__ __forceinline__ void operator()(const f32x4 (&acc)[2][2][4][2], const Unit& u, int wr, int wc, int fr, int fq) const {
        const int col0 = u.pn * BM + wc * 32 + 8 * fq;
        const int row0 = u.pm * BM + wr * 64 + fr;
        f32x4 gv[2][2];
#pragma unroll
        for (int bj = 0; bj < 2; ++bj) { gv[bj][0] = *(const f32x4*)(g + col0 + bj * HALF); gv[bj][1] = *(const f32x4*)(g + col0 + bj * HALF + 4); }
#pragma unroll
        for (int ai = 0; ai < 2; ++ai)
#pragma unroll
            for (int m = 0; m < 4; ++m) {
                const int row = row0 + ai * HALF + m * 16;
                const float* xrow = (row < E_TP) ? xp + (size_t)row * E_DM : xs + (size_t)(row - E_TP) * E_DM;
                float s = 0.f;
#pragma unroll
                for (int bj = 0; bj < 2; ++bj) {
                    const f32x4 r0 = *(const f32x4*)(xrow + col0 + bj * HALF), r1 = *(const f32x4*)(xrow + col0 + bj * HALF + 4);
                    const f32x4 v0 = acc[ai][bj][m][0] + r0, v1 = acc[ai][bj][m][1] + r1;
                    float* p = x1 + (size_t)row * E_DM + col0 + bj * HALF; *(f32x4*)p = v0; *(f32x4*)(p + 4) = v1;
                    s += dot4(v0) + dot4(v1);
                    const f32x4 a = v0 * gv[bj][0], b = v1 * gv[bj][1];
                    u32x4 w; w.x = cvt_pk_bf16(a[0], a[1]); w.y = cvt_pk_bf16(a[2], a[3]); w.z = cvt_pk_bf16(b[0], b[1]); w.w = cvt_pk_bf16(b[2], b[3]);
                    *(u32x4*)(h1 + (size_t)row * E_DM + col0 + bj * HALF) = w;
                }
                s += __shfl_xor(s, 16); s += __shfl_xor(s, 32);
                if (fq == 0) ssq_add(ssq + row, s);
                if (m & 1) asm volatile("" ::: "memory");
            }
    }
};

struct EpiUp {
    static constexpr bool PERM = true, AFTER_DRAIN = false;
    const float* ssq; bf16_t* U;
    __device__ __forceinline__ void operator()(const f32x4 (&acc)[2][2][4][2], const Unit& u, int wr, int wc, int fr, int fq) const {
        const int col0 = u.pn * BM + wc * 32 + 8 * fq;
        const int row0 = u.pm * BM + wr * 64 + fr;
#pragma unroll
        for (int ai = 0; ai < 2; ++ai)
#pragma unroll
            for (int m = 0; m < 4; ++m) {
                const int row = row0 + ai * HALF + m * 16;
                const float rs = __builtin_amdgcn_rsqf(ssq[row] * (1.0f / E_DM) + E_EPS);
#pragma unroll
                for (int bj = 0; bj < 2; ++bj) {
                    f32x4 a = acc[ai][bj][m][0] * rs, b = acc[ai][bj][m][1] * rs;
#pragma unroll
                    for (int j = 0; j < 4; ++j) { const float x = fmaxf(a[j], 0.f), y = fmaxf(b[j], 0.f); a[j] = x * x; b[j] = y * y; }
                    u32x4 w; w.x = cvt_pk_bf16(a[0], a[1]); w.y = cvt_pk_bf16(a[2], a[3]); w.z = cvt_pk_bf16(b[0], b[1]); w.w = cvt_pk_bf16(b[2], b[3]);
                    *(u32x4*)(U + (size_t)row * E_DFF + col0 + bj * HALF) = w;
                }
            }
    }
};

struct EpiDown {
    static constexpr bool PERM = true, AFTER_DRAIN = false;
    const float* x1; float* y; float* ssq;
    __device__ __forceinline__ void operator()(const f32x4 (&acc)[2][2][4][2], const Unit& u, int wr, int wc, int fr, int fq) const {
        const int col0 = u.pn * BM + wc * 32 + 8 * fq;
        const int row0 = u.pm * BM + wr * 64 + fr;
#pragma unroll
        for (int ai = 0; ai < 2; ++ai)
#pragma unroll
            for (int m = 0; m < 4; ++m) {
                const int row = row0 + ai * HALF + m * 16;
                float s = 0.f;
#pragma unroll
                for (int bj = 0; bj < 2; ++bj) {
                    const float* xr = x1 + (size_t)row * E_DM + col0 + bj * HALF;
                    const f32x4 r0 = *(const f32x4*)xr, r1 = *(const f32x4*)(xr + 4);
                    const f32x4 v0 = acc[ai][bj][m][0] + r0, v1 = acc[ai][bj][m][1] + r1;
                    float* p = y + (size_t)row * E_DM + col0 + bj * HALF; *(f32x4*)p = v0; *(f32x4*)(p + 4) = v1;
                    s += dot4(v0) + dot4(v1);
                }
                s += __shfl_xor(s, 16); s += __shfl_xor(s, 32);
                if (fq == 0) ssq_add(ssq + row, s);
                if (m & 1) asm volatile("" ::: "memory");
            }
    }
};

template <class Epi, class Sched, bool ALIGN_EPI = false, bool SP2 = false>
__device__ __forceinline__ void gemm_phase(PG8_LAS unsigned char* lds, const Gemm g, const Sched& S, const Epi& E) {
    const int tid = threadIdx.x, wid = __builtin_amdgcn_readfirstlane(tid >> 6), lane = tid & 63, wr = wid >> 2, wc = wid & 3, fr = lane & 15, fq = lane >> 4;
    const int K = g.K, nt = K / BK;
    unsigned voffA[2], voffB[2];
#pragma unroll
    for (int i = 0; i < 2; ++i) { int R, C; stage_rc(tid * 16 + i * 8192, R, C); const int Rb = Epi::PERM ? ((R & ~31) + perm32(R & 31)) : R;
        voffA[i] = (unsigned)(R * K + C) * 2u; voffB[i] = (unsigned)(Rb * K + C) * 2u; }
    const size_t kstep = (size_t)(BK * 2);
    const size_t hstep = (size_t)HALF * K * 2;
    const size_t tstep = 2 * hstep;
    const unsigned ldsw = (unsigned)wid * 1024u;
    const int aoff = lds_byte(wr * 64 + fr, fq * 8), boff = lds_byte(wc * 32 + fr, fq * 8);
#define PG8_SA(b, h) (((b) * 2 + (h)) * HTB)
#define PG8_SB(b, h) ((4 + (b) * 2 + (h)) * HTB)
#define PG8_STAGE(bufoff, gbase, voff) do { _Pragma("unroll") for (int _i = 0; _i < 2; ++_i) \
        __builtin_amdgcn_global_load_lds((const unsigned*)((const char*)(gbase) + (voff)[_i]), (PG8_LAS unsigned*)(lds + (bufoff) + ldsw + _i * 8192), 16, 0, 0); } while (0)
#define PG8_LDA(dst, b, h) do { _Pragma("unroll") for (int m = 0; m < 4; ++m) _Pragma("unroll") for (int k = 0; k < 2; ++k) dst[m][k] = *(const PG8_LAS bf16x8*)(lds + PG8_SA(b, h) + aoff + m * 2048 + k * 1024); } while (0)
#define PG8_LDB(dst, b, h) do { _Pragma("unroll") for (int n = 0; n < 2; ++n) _Pragma("unroll") for (int k = 0; k < 2; ++k) dst[n][k] = *(const PG8_LAS bf16x8*)(lds + PG8_SB(b, h) + boff + n * 2048 + k * 1024); } while (0)
#define PG8_MMA(ai, bj, At, Bt) do { __builtin_amdgcn_s_setprio(1); _Pragma("unroll") for (int m = 0; m < 4; ++m) _Pragma("unroll") for (int n = 0; n < 2; ++n) _Pragma("unroll") for (int k = 0; k < 2; ++k) \
        acc[ai][bj][m][n] = __builtin_amdgcn_mfma_f32_16x16x32_bf16(Bt[n][k], At[m][k], acc[ai][bj][m][n], 0, 0, 0); __builtin_amdgcn_s_setprio(0); } while (0)
#define PG8_WAIT_V(n) asm volatile("s_waitcnt vmcnt(" #n ")" ::: "memory")
#define PG8_WAIT_L(n) asm volatile("s_waitcnt lgkmcnt(" #n ")" ::: "memory")
#define PG8_BAR __builtin_amdgcn_s_barrier()
#define PG8_SCHED __builtin_amdgcn_sched_barrier(0)
    Unit cur, nxt; int ui = 0;
    if (!S.next(0, cur)) return;
    f32x4 acc[2][2][4][2];
#pragma unroll
    for (int a = 0; a < 2; ++a)
#pragma unroll
        for (int b = 0; b < 2; ++b)
#pragma unroll
            for (int m = 0; m < 4; ++m)
#pragma unroll
                for (int n = 0; n < 2; ++n) acc[a][b][m][n] = (f32x4){0.f, 0.f, 0.f, 0.f};
    bf16x8 At[4][2], B0[2][2], B1[2][2];
    const char* cA = (const char*)g.A + (size_t)cur.pm * tstep; const char* cB = (const char*)g.Bt + (size_t)cur.pn * tstep;
    S.a_ready(cur);
    if constexpr (SP2) {
        PG8_STAGE(PG8_SB(0, 0), cB, voffB); PG8_STAGE(PG8_SB(0, 1), cB + hstep, voffB); PG8_STAGE(PG8_SA(0, 0), cA, voffA); PG8_STAGE(PG8_SA(0, 1), cA + hstep, voffA);
        if (wr == 1) PG8_BAR;
        PG8_WAIT_V(2); PG8_BAR;
        PG8_STAGE(PG8_SB(1, 0), cB + kstep, voffB); PG8_STAGE(PG8_SA(1, 0), cA + kstep, voffA); PG8_STAGE(PG8_SB(1, 1), cB + hstep + kstep, voffB);
        PG8_WAIT_V(6); PG8_BAR;
    } else {
        PG8_STAGE(PG8_SB(0, 0), cB, voffB); PG8_STAGE(PG8_SA(0, 0), cA, voffA); PG8_STAGE(PG8_SB(0, 1), cB + hstep, voffB); PG8_STAGE(PG8_SA(0, 1), cA + hstep, voffA);
        if (wr == 1) PG8_BAR;
        PG8_WAIT_V(4); PG8_BAR;
        PG8_STAGE(PG8_SB(1, 0), cB + kstep, voffB); PG8_STAGE(PG8_SA(1, 0), cA + kstep, voffA); PG8_STAGE(PG8_SB(1, 1), cB + hstep + kstep, voffB);
        PG8_WAIT_V(6); PG8_BAR;
    }
    for (;;) {
        const bool has_next = S.next(ui + 1, nxt);
        const char* nA = has_next ? (const char*)g.A + (size_t)nxt.pm * tstep : cA; const char* nB = has_next ? (const char*)g.Bt + (size_t)nxt.pn * tstep : cB;
        for (int t = 0; t < nt; t += 2) {
            const bool last = (t == nt - 2);
            const char* a1 = cA + (size_t)(t + 1) * kstep;
            const char* a2 = last ? nA : cA + (size_t)(t + 2) * kstep; const char* b2 = last ? nB : cB + (size_t)(t + 2) * kstep;
            const char* a3 = a2 + kstep; const char* b3 = b2 + kstep;
            if (last && has_next) S.a_ready(nxt);
            if constexpr (SP2) {
            PG8_LDB(B0, 0, 0); PG8_LDB(B1, 0, 1); PG8_SCHED; PG8_LDA(At, 0, 0); PG8_STAGE(PG8_SA(1, 1), a1 + hstep, voffA);
            PG8_WAIT_V(8); PG8_WAIT_L(0); PG8_BAR; PG8_MMA(0, 0, At, B0); PG8_MMA(0, 1, At, B1); PG8_BAR; PG8_SCHED;
            PG8_LDA(At, 0, 1); PG8_STAGE(PG8_SB(0, 0), b2, voffB); PG8_STAGE(PG8_SB(0, 1), b2 + hstep, voffB); PG8_STAGE(PG8_SA(0, 0), a2, voffA);
            PG8_WAIT_V(8); PG8_WAIT_L(0); PG8_BAR; PG8_MMA(1, 0, At, B0); PG8_MMA(1, 1, At, B1); PG8_BAR; PG8_SCHED;
            PG8_LDB(B0, 1, 0); PG8_LDB(B1, 1, 1); PG8_SCHED; PG8_LDA(At, 1, 0); PG8_STAGE(PG8_SA(0, 1), a2 + hstep, voffA);
            PG8_WAIT_V(8); PG8_WAIT_L(0); PG8_BAR; PG8_MMA(0, 0, At, B0); PG8_MMA(0, 1, At, B1); PG8_BAR; PG8_SCHED;
            PG8_LDA(At, 1, 1); PG8_STAGE(PG8_SB(1, 0), b3, voffB); PG8_STAGE(PG8_SB(1, 1), b3 + hstep, voffB); PG8_STAGE(PG8_SA(1, 0), a3, voffA);
            PG8_WAIT_V(8); PG8_WAIT_L(0); PG8_BAR; PG8_MMA(1, 0, At, B0); PG8_MMA(1, 1, At, B1); PG8_BAR; PG8_SCHED;
            } else {
            PG8_LDB(B0, 0, 0); PG8_SCHED; PG8_LDA(At, 0, 0); PG8_STAGE(PG8_SA(1, 1), a1 + hstep, voffA);
            PG8_WAIT_L(8); PG8_BAR; PG8_WAIT_L(0); PG8_MMA(0, 0, At, B0); PG8_BAR; PG8_SCHED;
            PG8_LDB(B1, 0, 1); PG8_STAGE(PG8_SB(0, 0), b2, voffB);
            PG8_BAR; PG8_WAIT_L(0); PG8_MMA(0, 1, At, B1); PG8_BAR;
            PG8_LDA(At, 0, 1); PG8_STAGE(PG8_SA(0, 0), a2, voffA);
            PG8_BAR; PG8_WAIT_L(0); PG8_MMA(1, 0, At, B0); PG8_BAR; PG8_SCHED;
            PG8_STAGE(PG8_SB(0, 1), b2 + hstep, voffB);
            PG8_WAIT_V(6); PG8_BAR; PG8_MMA(1, 1, At, B1); PG8_BAR;
            PG8_LDB(B0, 1, 0); PG8_SCHED; PG8_LDA(At, 1, 0); PG8_STAGE(PG8_SA(0, 1), a2 + hstep, voffA);
            PG8_WAIT_L(8); PG8_BAR; PG8_WAIT_L(0); PG8_MMA(0, 0, At, B0); PG8_BAR; PG8_SCHED;
            PG8_LDB(B1, 1, 1); PG8_STAGE(PG8_SB(1, 0), b3, voffB);
            PG8_BAR; PG8_WAIT_L(0); PG8_MMA(0, 1, At, B1); PG8_BAR;
            PG8_LDA(At, 1, 1); PG8_STAGE(PG8_SA(1, 0), a3, voffA);
            PG8_BAR; PG8_WAIT_L(0); PG8_MMA(1, 0, At, B0); PG8_BAR; PG8_SCHED;
            PG8_STAGE(PG8_SB(1, 1), b3 + hstep, voffB);
            PG8_WAIT_V(6); PG8_BAR; PG8_MMA(1, 1, At, B1); PG8_BAR;
            }
        }
        if constexpr (ALIGN_EPI) { if (wr == 0) PG8_BAR; }
        if constexpr (!Epi::AFTER_DRAIN) { E(acc, cur, wr, wc, fr, fq); S.done(cur); }
        if (!has_next) break;
#pragma unroll
        for (int a = 0; a < 2; ++a)
#pragma unroll
            for (int b = 0; b < 2; ++b)
#pragma unroll
                for (int m = 0; m < 4; ++m)
#pragma unroll
                    for (int n = 0; n < 2; ++n) acc[a][b][m][n] = (f32x4){0.f, 0.f, 0.f, 0.f};
        cur = nxt; cA = nA; cB = nB; ++ui;
        if constexpr (ALIGN_EPI) { if (wr == 1) PG8_BAR; }
    }
    PG8_WAIT_V(0);
    if constexpr (!ALIGN_EPI) { if (wr == 0) PG8_BAR; }
    PG8_BAR;
    if constexpr (Epi::AFTER_DRAIN) { E.fused(acc, cur, wr, wc, fr, fq, lds, wid, lane); S.done(cur); }
#undef PG8_SA
#undef PG8_SB
#undef PG8_STAGE
#undef PG8_LDA
#undef PG8_LDB
#undef PG8_MMA
#undef PG8_WAIT_V
#undef PG8_WAIT_L
#undef PG8_BAR
#undef PG8_SCHED
}
}
namespace att {
#define ALAS __attribute__((address_space(3)))
typedef unsigned short bf16;
using bf16x8 = __attribute__((ext_vector_type(8))) short;
using s16x4  = __attribute__((ext_vector_type(4))) short;
using f32x16 = __attribute__((ext_vector_type(16))) float;
using f32x8  = __attribute__((ext_vector_type(8))) float;
using f32x4  = __attribute__((ext_vector_type(4))) float;
using u32x4  = __attribute__((ext_vector_type(4))) unsigned;
constexpr int D = 128, NW = 8, QBLK = 32, KVBLK = 64;
constexpr float SCALE = 0.088388347648318440f;
constexpr float LOG2E = 1.4426950408889634f, LN2 = 0.6931471805599453f;
constexpr float THR = 8.f;
constexpr int HW = 2048;
constexpr int DMODEL = 4096, TP = 8192;
constexpr float EPS = 1e-6f;
constexpr int SHM_V = KVBLK * D * 2, SHM_K = KVBLK * D * 2;
#define KSWZ(row, colB) ((row) * 256 + ((colB) ^ (((row) & 7) << 4)))
#define SBAR() __builtin_amdgcn_sched_barrier(0)
__device__ __forceinline__ int crow(int r, int hi) { return (r & 3) + 8 * (r >> 2) + 4 * hi; }
__device__ __forceinline__ unsigned cvtpk(float lo, float hi) { unsigned r; asm volatile("v_cvt_pk_bf16_f32 %0, %1, %2" : "=v"(r) : "v"(lo), "v"(hi)); return r; }
__device__ __forceinline__ bf16x8 ld8bf(const bf16* p) { return *reinterpret_cast<const bf16x8*>(p); }
__device__ __forceinline__ f32x8 ld8f(const float* p) { return *reinterpret_cast<const f32x8*>(p); }
__device__ __forceinline__ bf16x8 tobf(f32x8 x) { u32x4 w = {cvtpk(x[0], x[1]), cvtpk(x[2], x[3]), cvtpk(x[4], x[5]), cvtpk(x[6], x[7])}; return *reinterpret_cast<bf16x8*>(&w); }
__device__ __forceinline__ bf16x8 ld8any(const bf16* p) { return ld8bf(p); }
__device__ __forceinline__ bf16x8 ld8any(const float* p) { return tobf(ld8f(p)); }
__device__ __forceinline__ float swap32(float x, int hi) {
    auto rr = __builtin_amdgcn_permlane32_swap(__float_as_uint(x), __float_as_uint(x), false, false);
    return __uint_as_float(hi ? rr[0] : rr[1]);
}

__device__ __forceinline__ void partialSM(f32x16& p0, f32x16& p1, float& m_reg, float& mn, float& alpha, float msk = 0.f) {
  constexpr float C = SCALE * LOG2E;
  float pmax = p0[0];
#pragma unroll
  for (int r = 1; r < 16; ++r) pmax = fmaxf(pmax, p0[r]);
#pragma unroll
  for (int r = 0; r < 16; ++r) pmax = fmaxf(pmax, p1[r]);
  { auto rr = __builtin_amdgcn_permlane32_swap(__float_as_uint(pmax), __float_as_uint(pmax), false, false);
    pmax = fmaxf(__uint_as_float(rr[0]), __uint_as_float(rr[1])) + msk; }
  if (__builtin_expect(__all(pmax - m_reg <= THR / SCALE), 1)) { mn = m_reg; alpha = 1.f; }
  else { mn = fmaxf(m_reg, pmax); alpha = __builtin_amdgcn_exp2f((m_reg - mn) * C); m_reg = mn; }
  float mnC = -mn * C + msk;
#pragma unroll
  for (int r = 0; r < 16; ++r) p0[r] = fmaf(p0[r], C, mnC);
#pragma unroll
  for (int r = 0; r < 16; ++r) p1[r] = fmaf(p1[r], C, mnC);
#pragma unroll
  for (int r = 0; r < 16; ++r) p0[r] = __builtin_amdgcn_exp2f(p0[r]);
}
#define PK4(P, BASE, OUT) do { unsigned a0 = cvtpk(P[BASE + 0], P[BASE + 1]), a1 = cvtpk(P[BASE + 2], P[BASE + 3]);   \
    unsigned b0 = cvtpk(P[BASE + 4], P[BASE + 5]), b1 = cvtpk(P[BASE + 6], P[BASE + 7]);                              \
    auto r0 = __builtin_amdgcn_permlane32_swap(a0, b0, false, false); auto r1 = __builtin_amdgcn_permlane32_swap(a1, b1, false, false); \
    u32x4 w = {r0[0], r1[0], r0[1], r1[1]}; OUT = *reinterpret_cast<bf16x8*>(&w); } while (0)
__device__ __forceinline__ void finishSM(f32x16& p0, f32x16& p1, float alpha, float& l_reg, bf16x8& pa0, bf16x8& pa1, bf16x8& pa2, bf16x8& pa3) {
#pragma unroll
  for (int r = 0; r < 16; ++r) p1[r] = __builtin_amdgcn_exp2f(p1[r]);
  float ps = 0;
#pragma unroll
  for (int r = 0; r < 16; ++r) ps += p0[r];
#pragma unroll
  for (int r = 0; r < 16; ++r) ps += p1[r];
  { auto rr = __builtin_amdgcn_permlane32_swap(__float_as_uint(ps), __float_as_uint(ps), false, false);
    ps = __uint_as_float(rr[0]) + __uint_as_float(rr[1]); }
  l_reg = l_reg * alpha + ps;
  PK4(p0, 0, pa0); PK4(p0, 8, pa1); PK4(p1, 0, pa2); PK4(p1, 8, pa3);
}
__device__ __forceinline__ void qkt(f32x16& p0, f32x16& p1, const ALAS char* Ks, const bf16x8* qr, int r32, int hi) {
  p0 = f32x16{}; p1 = f32x16{};
#pragma unroll
  for (int d0 = 0; d0 < 8; ++d0) { int cb = (d0 * 16 + hi * 8) * 2;
    bf16x8 b0 = *reinterpret_cast<const ALAS bf16x8*>(Ks + KSWZ(r32, cb));
    bf16x8 b1 = *reinterpret_cast<const ALAS bf16x8*>(Ks + KSWZ(32 + r32, cb));
    p0 = __builtin_amdgcn_mfma_f32_32x32x16_bf16(b0, qr[d0], p0, 0, 0, 0);
    p1 = __builtin_amdgcn_mfma_f32_32x32x16_bf16(b1, qr[d0], p1, 0, 0, 0); }
}
template <int NQR>
__device__ __forceinline__ void qkt_h(f32x16& p0, f32x16& p1, const ALAS char* Ks, const bf16x8* qr, const ALAS char* Qs, int qrow, int r32, int hi) {
  p0 = f32x16{}; p1 = f32x16{};
#pragma unroll
  for (int d0 = 0; d0 < 8; ++d0) { int cb = (d0 * 16 + hi * 8) * 2;
    bf16x8 b0 = *reinterpret_cast<const ALAS bf16x8*>(Ks + KSWZ(r32, cb));
    bf16x8 b1 = *reinterpret_cast<const ALAS bf16x8*>(Ks + KSWZ(32 + r32, cb));
    bf16x8 q = d0 < NQR ? qr[d0] : *reinterpret_cast<const ALAS bf16x8*>(Qs + KSWZ(qrow, cb));
    p0 = __builtin_amdgcn_mfma_f32_32x32x16_bf16(b0, q, p0, 0, 0, 0);
    p1 = __builtin_amdgcn_mfma_f32_32x32x16_bf16(b1, q, p1, 0, 0, 0); }
}
__device__ __forceinline__ int v_st(int k, int c) { const int kk = (k & ~0xC) | ((k & 4) << 1) | ((k & 8) >> 1); return ((kk >> 3) * 4 + (c >> 5)) * 512 + ((kk & 7) * 32 + (c & 31)) * 2; }
__device__ __forceinline__ int v_rd_base(int lane) { return ((lane & 3) << 3) | (((lane >> 2) & 3) << 6) | (((lane >> 4) & 1) << 5) | (((lane >> 5) & 1) << 8); }
constexpr int v_rd_off(int d0, int ks, int half) { return d0 * 512 + ks * 4096 + half * 2048; }
template <int OFF> __device__ __forceinline__ s16x4 tr_read(int vb) {
  s16x4 r; asm volatile("ds_read_b64_tr_b16 %0, %1 offset:%2" : "=&v"(r) : "v"(vb), "i"(OFF) : "memory"); return r;
}
template <int D0> __device__ __forceinline__ void pv_one(f32x16& od, int vb, bf16x8 pa0, bf16x8 pa1, bf16x8 pa2, bf16x8 pa3) {
  const s16x4 l0 = tr_read<v_rd_off(D0, 0, 0)>(vb), h0 = tr_read<v_rd_off(D0, 0, 1)>(vb), l1 = tr_read<v_rd_off(D0, 1, 0)>(vb), h1 = tr_read<v_rd_off(D0, 1, 1)>(vb);
  const s16x4 l2 = tr_read<v_rd_off(D0, 2, 0)>(vb), h2 = tr_read<v_rd_off(D0, 2, 1)>(vb), l3 = tr_read<v_rd_off(D0, 3, 0)>(vb), h3 = tr_read<v_rd_off(D0, 3, 1)>(vb);
  asm volatile("s_waitcnt lgkmcnt(0)" ::: "memory"); SBAR();
#define PK(L, H) (bf16x8){L[0], L[1], L[2], L[3], H[0], H[1], H[2], H[3]}
  od = __builtin_amdgcn_mfma_f32_32x32x16_bf16(pa0, PK(l0, h0), od, 0, 0, 0);
  od = __builtin_amdgcn_mfma_f32_32x32x16_bf16(pa1, PK(l1, h1), od, 0, 0, 0);
  od = __builtin_amdgcn_mfma_f32_32x32x16_bf16(pa2, PK(l2, h2), od, 0, 0, 0);
  od = __builtin_amdgcn_mfma_f32_32x32x16_bf16(pa3, PK(l3, h3), od, 0, 0, 0);
#undef PK
}
__device__ __forceinline__ void pv_d0(f32x16* o, int vb, bf16x8 pa0, bf16x8 pa1, bf16x8 pa2, bf16x8 pa3) {
  pv_one<0>(o[0], vb, pa0, pa1, pa2, pa3); pv_one<1>(o[1], vb, pa0, pa1, pa2, pa3); pv_one<2>(o[2], vb, pa0, pa1, pa2, pa3); pv_one<3>(o[3], vb, pa0, pa1, pa2, pa3);
}
__device__ __forceinline__ void fill_neg(f32x16& p0, f32x16& p1) {
#pragma unroll
  for (int r = 0; r < 16; ++r) { p0[r] = -1e30f; p1[r] = -1e30f; }
}

constexpr int SHM_QOFF = 2 * SHM_V + 2 * SHM_K + NW * 64 * 4, SHM_ATTN = SHM_QOFF + 256 * 256;
constexpr int NQR = 8;
__device__ __forceinline__ void attnA_prompt_unit(int vh, int qb, const bf16* __restrict__ AQ, const bf16* __restrict__ AK, const bf16* __restrict__ AV, float* __restrict__ OA, ALAS char* lds) {
  int tid = threadIdx.x; asm volatile("" : "+v"(tid));
  const int wid = __builtin_amdgcn_readfirstlane(tid >> 6), lane = tid & 63, r32 = lane & 31, hi = lane >> 5;
  const int h = vh >> 2, c = (vh >> 1) & 1, vhalf = vh & 1;
  const bf16* Qb = AQ + (size_t)(qb * 256) * HW + h * 256 + c * 128;
  const bf16* Kh = AK + h * 256 + c * 128;
  const bf16* Vh = AV + h * 256 + vhalf * 128;
  float* Ob = OA + (size_t)(qb * 256) * DMODEL + h * 512 + c * 256 + vhalf * 128;
  const int NT = 4 * qb + 4, jmax = 4 * qb + (wid >> 1);
  ALAS char* V_lds = lds; ALAS char* K_lds = lds + 2 * SHM_V;
  ALAS float* ws = (ALAS float*)(lds + 2 * SHM_V + 2 * SHM_K) + wid * 64; ALAS float* li_l = ws; ALAS float* al_l = ws + 32;
  float m_reg = -1e30f, l_reg = 0; f32x16 o[4] = {}; bf16x8 qr[NQR];
  const bf16* Qw = Qb + (size_t)(wid * QBLK + r32) * HW + hi * 8;
  ALAS char* Q_lds = lds + SHM_QOFF; const int qrow = wid * QBLK + r32;
#pragma unroll
  for (int d0 = 0; d0 < 8; ++d0) { const bf16x8 q = ld8bf(Qw + d0 * 16); if (d0 < NQR) qr[d0] = q; else *(ALAS bf16x8*)(Q_lds + KSWZ(qrow, (d0 * 16 + hi * 8) * 2)) = q; }
  const int sr = tid >> 4, sc = (tid & 15) * 8, vst0 = v_st(sr, sc), vst1 = v_st(32 + sr, sc);
  const int vb0 = (int)(unsigned)(uintptr_t)V_lds + v_rd_base(lane);
  constexpr int SDEPTH = 1;
  struct { bf16x8 vs0, vs1, ks0, ks1; } sr_[SDEPTH];
  const unsigned lo0 = (unsigned)(sr * HW + sc) * 2u, lo1 = lo0 + 32u * HW * 2u;
#define SLOAD(i, k0) do { const char* kb_ = (const char*)Kh + (size_t)(k0) * (HW * 2); const char* vb_ = (const char*)Vh + (size_t)(k0) * (HW * 2); \
    sr_[i].vs0 = *(const bf16x8*)(vb_ + lo0); sr_[i].vs1 = *(const bf16x8*)(vb_ + lo1); sr_[i].ks0 = *(const bf16x8*)(kb_ + lo0); sr_[i].ks1 = *(const bf16x8*)(kb_ + lo1); } while (0)
#define SWRITE(b, i) do { *(ALAS bf16x8*)(V_lds + (b) * SHM_V + vst0) = sr_[i].vs0;          \
    *(ALAS bf16x8*)(V_lds + (b) * SHM_V + vst1) = sr_[i].vs1; int kc = sc * 2;               \
    *(ALAS bf16x8*)(K_lds + (b) * SHM_K + KSWZ(sr, kc)) = sr_[i].ks0;                       \
    *(ALAS bf16x8*)(K_lds + (b) * SHM_K + KSWZ(32 + sr, kc)) = sr_[i].ks1; } while (0)
#define SWAIT() do { if constexpr (SDEPTH == 2) asm volatile("s_waitcnt vmcnt(4)" ::: "memory"); else asm volatile("s_waitcnt vmcnt(0)" ::: "memory"); } while (0)
#define RESC(a) do { if (__any((a) < 1.f)) { if (hi == 0) al_l[r32] = (a); asm volatile("s_waitcnt lgkmcnt(0)" ::: "memory"); \
    _Pragma("unroll") for (int d = 0; d < 4; ++d) _Pragma("unroll") for (int r = 0; r < 16; ++r) o[d][r] *= al_l[crow(r, hi)]; } } while (0)
#define QKT_M(P0, P1, KS, j) qkt_h<NQR>(P0, P1, KS, qr, Q_lds, qrow, r32, hi)
#define MSK(j) (((j) <= jmax) ? 0.f : -1e30f)
  f32x16 pA0, pA1, pB0, pB1; float mnA, mnB, alA, alB; bf16x8 pa0, pa1, pa2, pa3;
  constexpr int SE = 0, SO = SDEPTH - 1;
  SLOAD(SE, 0); asm volatile("s_waitcnt vmcnt(0)" ::: "memory"); SWRITE(0, SE); __syncthreads();
  QKT_M(pA0, pA1, K_lds, 0); partialSM(pA0, pA1, m_reg, mnA, alA);
  SLOAD(SO, KVBLK); if constexpr (SDEPTH == 2) { if (2 < NT) SLOAD(SE, 2 * KVBLK); }
  SWAIT(); SWRITE(1, SO); __syncthreads();
  for (int j = 1; j + 1 < NT; j += 2) {
    SBAR(); QKT_M(pB0, pB1, K_lds + SHM_K, j);
    finishSM(pA0, pA1, alA, l_reg, pa0, pa1, pa2, pa3); SBAR();
    SLOAD(SO, (j + SDEPTH) * KVBLK); SBAR();
    pv_d0(o, vb0, pa0, pa1, pa2, pa3); partialSM(pB0, pB1, m_reg, mnB, alB, MSK(j));
    __syncthreads(); SWAIT(); SWRITE(0, SE);
    RESC(alB); __syncthreads();
    SBAR(); QKT_M(pA0, pA1, K_lds, j + 1);
    finishSM(pB0, pB1, alB, l_reg, pa0, pa1, pa2, pa3); SBAR();
    if (SDEPTH == 1 || j + 3 < NT) SLOAD(SE, (j + 1 + SDEPTH) * KVBLK); SBAR();
    pv_d0(o, vb0 + SHM_V, pa0, pa1, pa2, pa3); partialSM(pA0, pA1, m_reg, mnA, alA, MSK(j + 1));
    __syncthreads(); SWAIT(); SWRITE(1, SO);
    RESC(alA); __syncthreads();
  }
  SBAR(); QKT_M(pB0, pB1, K_lds + SHM_K, NT - 1);
  finishSM(pA0, pA1, alA, l_reg, pa0, pa1, pa2, pa3); SBAR();
  pv_d0(o, vb0, pa0, pa1, pa2, pa3); partialSM(pB0, pB1, m_reg, mnB, alB, MSK(NT - 1));
  __syncthreads(); RESC(alB);
  finishSM(pB0, pB1, alB, l_reg, pa0, pa1, pa2, pa3); SBAR();
  pv_d0(o, vb0 + SHM_V, pa0, pa1, pa2, pa3);
  if (hi == 0) li_l[r32] = l_reg; asm volatile("s_waitcnt lgkmcnt(0)" ::: "memory");
  float rli[16];
#pragma unroll
  for (int r = 0; r < 16; ++r) rli[r] = __builtin_amdgcn_rcpf(li_l[crow(r, hi)]);
  float* Ow = Ob + (size_t)(wid * QBLK) * DMODEL;
#pragma unroll
  for (int r = 0; r < 16; ++r) { int orow = crow(r, hi);
#pragma unroll
    for (int d0 = 0; d0 < 4; ++d0) Ow[(size_t)orow * DMODEL + d0 * 32 + r32] = o[d0][r] * rli[r]; }
  __syncthreads();
#undef SLOAD
#undef SWRITE
#undef SWAIT
#undef QKT_M
#undef MSK
}

constexpr int SA_KB = 0, SA_VB = 65536, SA_WS = 131072, SA_LDS = SA_WS + NW * 64 * 4;
__device__ __forceinline__ void attnA_sample_unit(int b, int h, const float* __restrict__ cak, const float* __restrict__ cav, const float* __restrict__ nak, const float* __restrict__ nav,
                                                  const bf16* __restrict__ AQ, float lam, const float* __restrict__ g_subln, float post, bf16* __restrict__ O, ALAS char* lds) {
  int tid = threadIdx.x; asm volatile("" : "+v"(tid));
  const int wid = __builtin_amdgcn_readfirstlane(tid >> 6), lane = tid & 63, r32 = lane & 31, hi = lane >> 5;
  const int c = wid & 1, vq = wid >> 1;
  ALAS float* ws = (ALAS float*)(lds + SA_WS) + wid * 64; ALAS float* li_l = ws; ALAS float* al_l = ws + 32;
  bf16x8 qr[8];
  { const bf16* Qw = AQ + (size_t)(TP + b * 16 + (r32 & 15)) * HW + h * 256 + c * 128 + hi * 8;
#pragma unroll
    for (int d0 = 0; d0 < 8; ++d0) qr[d0] = ld8bf(Qw + d0 * 16); }
  const int sr = tid >> 3, sk = (tid & 7) * 16, sv = (tid & 7) * 32;
  f32x8 kreg[4], vreg[4];
#define SA_LOAD(j) do { if ((j) < 32) { const size_t ro = ((size_t)(b * 2048 + (j) * 64 + sr) * 8 + h) * 256; \
      kreg[0] = ld8f(cak + ro + sk); kreg[1] = ld8f(cak + ro + sk + 8); kreg[2] = ld8f(cak + ro + 128 + sk); kreg[3] = ld8f(cak + ro + 128 + sk + 8); \
      vreg[0] = ld8f(cav + ro + sv); vreg[1] = ld8f(cav + ro + sv + 8); vreg[2] = ld8f(cav + ro + sv + 16); vreg[3] = ld8f(cav + ro + sv + 24); } \
    else if (sr < 16) { const size_t ro = ((size_t)(b * 16 + sr) * 8 + h) * 256; \
      kreg[0] = ld8f(nak + ro + sk); kreg[1] = ld8f(nak + ro + sk + 8); kreg[2] = ld8f(nak + ro + 128 + sk); kreg[3] = ld8f(nak + ro + 128 + sk + 8); \
      vreg[0] = ld8f(nav + ro + sv); vreg[1] = ld8f(nav + ro + sv + 8); vreg[2] = ld8f(nav + ro + sv + 16); vreg[3] = ld8f(nav + ro + sv + 24); } \
    else { _Pragma("unroll") for (int i_ = 0; i_ < 4; ++i_) { kreg[i_] = f32x8{}; vreg[i_] = f32x8{}; } } } while (0)
#define SA_WRITE(buf) do { ALAS char* kb_ = lds + SA_KB + (buf) * 32768; ALAS char* vb_ = lds + SA_VB + (buf) * 32768 + (sv >> 7) * 16384; const int cv_ = sv & 127; \
    *(ALAS bf16x8*)(kb_ + KSWZ(sr, sk * 2)) = tobf(kreg[0]); *(ALAS bf16x8*)(kb_ + KSWZ(sr, (sk + 8) * 2)) = tobf(kreg[1]); \
    *(ALAS bf16x8*)(kb_ + 16384 + KSWZ(sr, sk * 2)) = tobf(kreg[2]); *(ALAS bf16x8*)(kb_ + 16384 + KSWZ(sr, (sk + 8) * 2)) = tobf(kreg[3]); \
    *(ALAS bf16x8*)(vb_ + v_st(sr, cv_)) = tobf(vreg[0]); *(ALAS bf16x8*)(vb_ + v_st(sr, cv_ + 8)) = tobf(vreg[1]); \
    *(ALAS bf16x8*)(vb_ + v_st(sr, cv_ + 16)) = tobf(vreg[2]); *(ALAS bf16x8*)(vb_ + v_st(sr, cv_ + 24)) = tobf(vreg[3]); } while (0)
  float m_reg = -1e30f, l_reg = 0.f; f32x16 o[2] = {};
  SA_LOAD(0); asm volatile("s_waitcnt vmcnt(0)" ::: "memory"); SA_WRITE(0); __syncthreads();
  for (int j = 0; j <= 32; ++j) {
    const int buf = j & 1;
    if (j < 32) SA_LOAD(j + 1);
    f32x16 p0, p1; float mn, alpha; bf16x8 pa0, pa1, pa2, pa3;
    qkt(p0, p1, lds + SA_KB + buf * 32768 + c * 16384, qr, r32, hi);
    if (j == 32) {
#pragma unroll
      for (int r = 0; r < 16; ++r) { if (crow(r, hi) >= 16) p0[r] = -1e30f; p1[r] = -1e30f; }
    }
    partialSM(p0, p1, m_reg, mn, alpha);
    if (__any(alpha < 1.f)) { if (hi == 0) al_l[r32] = alpha; asm volatile("s_waitcnt lgkmcnt(0)" ::: "memory");
#pragma unroll
      for (int d = 0; d < 2; ++d)
#pragma unroll
        for (int r = 0; r < 16; ++r) o[d][r] *= al_l[crow(r, hi)]; }
    finishSM(p0, p1, alpha, l_reg, pa0, pa1, pa2, pa3); SBAR();
    const int vb = (int)(unsigned)(uintptr_t)(lds + SA_VB + buf * 32768 + (vq >> 1) * 16384) + v_rd_base(lane);
    if (vq & 1) { pv_one<2>(o[0], vb, pa0, pa1, pa2, pa3); pv_one<3>(o[1], vb, pa0, pa1, pa2, pa3); }
    else        { pv_one<0>(o[0], vb, pa0, pa1, pa2, pa3); pv_one<1>(o[1], vb, pa0, pa1, pa2, pa3); }
    if (j < 32) { asm volatile("s_waitcnt vmcnt(0)" ::: "memory"); SA_WRITE(buf ^ 1); }
    __syncthreads();
  }
  if (hi == 0) li_l[r32] = l_reg; asm volatile("s_waitcnt lgkmcnt(0)" ::: "memory");
  ALAS float* OL = (ALAS float*)(lds + SA_KB);
#pragma unroll
  for (int r = 0; r < 8; ++r) { const int q = crow(r, hi); const float rl = __builtin_amdgcn_rcpf(li_l[q]);
#pragma unroll
    for (int dd = 0; dd < 2; ++dd) OL[(c * 16 + q) * 256 + vq * 64 + dd * 32 + r32] = o[dd][r] * rl; }
  __syncthreads();
  { const int q = tid >> 5, e0 = (tid & 31) * 8; float dv[8]; float ss = 0.f;
#pragma unroll
    for (int i = 0; i < 8; ++i) { dv[i] = OL[q * 256 + e0 + i] - lam * OL[(16 + q) * 256 + e0 + i]; ss += dv[i] * dv[i]; }
#pragma unroll
    for (int m = 1; m < 32; m <<= 1) ss += __shfl_xor(ss, m);
    const float rs = __builtin_amdgcn_rsqf(ss * (1.0f / 256.0f) + EPS) * post;
    u32x4 w; w.x = cvtpk(dv[0] * rs * g_subln[e0 + 0], dv[1] * rs * g_subln[e0 + 1]); w.y = cvtpk(dv[2] * rs * g_subln[e0 + 2], dv[3] * rs * g_subln[e0 + 3]);
    w.z = cvtpk(dv[4] * rs * g_subln[e0 + 4], dv[5] * rs * g_subln[e0 + 5]); w.w = cvtpk(dv[6] * rs * g_subln[e0 + 6], dv[7] * rs * g_subln[e0 + 7]);
    *(u32x4*)(O + (size_t)(TP + b * 16 + q) * DMODEL + h * 256 + e0) = w; }
  __syncthreads();
#undef SA_LOAD
#undef SA_WRITE
}

constexpr float SB_STOP = -104.0f;
__device__ __forceinline__ float softplus_f(float z) {
  const float e = __builtin_amdgcn_exp2f(-fabsf(z) * LOG2E);
  return fmaxf(z, 0.f) + LN2 * __builtin_amdgcn_logf(1.0f + e);
}
template <typename TS>
__device__ __forceinline__ void stick_tile(f32x16 (&o)[4], float& carry, const bf16* __restrict__ Qw, const TS* __restrict__ Kt, const TS* __restrict__ Vt, int stride, int nvalid, int kpos0, int qpos,
                                           bool need_mask, ALAS char* vbuf, int lane, int r32, int hi) {
#pragma unroll
  for (int bt = 0; bt < 4; ++bt) {
    bf16x8 t[4];
#pragma unroll
    for (int i = 0; i < 4; ++i) { const int id = (bt * 4 + i) * 64 + lane, key = id >> 4, cc = (id & 15) * 8; const int kr = key < nvalid ? key : nvalid - 1;
      t[i] = ld8any(Vt + (size_t)kr * stride + cc); }
#pragma unroll
    for (int i = 0; i < 4; ++i) { const int id = (bt * 4 + i) * 64 + lane, key = id >> 4, cc = (id & 15) * 8;
      *(ALAS bf16x8*)(vbuf + v_st(key, cc)) = t[i]; }
    asm volatile("" ::: "memory");
  }
  f32x16 p0 = {}, p1 = {};
  { const int k0 = r32 < nvalid ? r32 : nvalid - 1, k1 = (32 + r32) < nvalid ? (32 + r32) : nvalid - 1;
    const TS* K0 = Kt + (size_t)k0 * stride + hi * 8; const TS* K1 = Kt + (size_t)k1 * stride + hi * 8;
    bf16x8 kf[8], qr[8];
#pragma unroll
    for (int d0 = 0; d0 < 8; ++d0) qr[d0] = ld8bf(Qw + d0 * 16);
#pragma unroll
    for (int d0 = 0; d0 < 8; ++d0) kf[d0] = ld8any(K0 + d0 * 16);
#pragma unroll
    for (int d0 = 0; d0 < 8; ++d0) p0 = __builtin_amdgcn_mfma_f32_32x32x16_bf16(kf[d0], qr[d0], p0, 0, 0, 0);
    asm volatile("" ::: "memory");
#pragma unroll
    for (int d0 = 0; d0 < 8; ++d0) kf[d0] = ld8any(K1 + d0 * 16);
#pragma unroll
    for (int d0 = 0; d0 < 8; ++d0) p1 = __builtin_amdgcn_mfma_f32_32x32x16_bf16(kf[d0], qr[d0], p1, 0, 0, 0);
  }
  float x0[16], x1[16];
#pragma unroll
  for (int r = 0; r < 16; ++r) {
    const float z0 = p0[r] * SCALE, z1 = p1[r] * SCALE; const float s0 = softplus_f(z0), s1 = softplus_f(z1);
    bool ok0 = true, ok1 = true;
    if (need_mask) { const int kl = crow(r, hi); ok0 = (kpos0 + kl < qpos) && (kl < nvalid); ok1 = (kpos0 + 32 + kl < qpos) && (32 + kl < nvalid); }
    x0[r] = ok0 ? -s0 : 0.f; x1[r] = ok1 ? -s1 : 0.f;
    p0[r] = ok0 ? z0 - s0 : -1e30f; p1[r] = ok1 ? z1 - s1 : -1e30f;
    if ((r & 3) == 3) SBAR();
  }
  float own[8], par[8], T[8], R[8];
#pragma unroll
  for (int g = 0; g < 4; ++g) { own[g] = (x0[4 * g] + x0[4 * g + 1]) + (x0[4 * g + 2] + x0[4 * g + 3]); own[4 + g] = (x1[4 * g] + x1[4 * g + 1]) + (x1[4 * g + 2] + x1[4 * g + 3]); }
#pragma unroll
  for (int g = 0; g < 8; ++g) { par[g] = swap32(own[g], hi); T[g] = own[g] + par[g]; }
  R[7] = 0.f;
#pragma unroll
  for (int g = 6; g >= 0; --g) R[g] = R[g + 1] + T[g + 1];
  const float total = R[0] + T[0];
#pragma unroll
  for (int g = 0; g < 8; ++g) {
    const float E = carry + R[g] + (hi == 0 ? par[g] : 0.f);
    if (g < 4) {
      const float w3 = 0.f, w2 = x0[4 * g + 3], w1 = w2 + x0[4 * g + 2], w0 = w1 + x0[4 * g + 1];
      p0[4 * g + 3] = __builtin_amdgcn_exp2f((p0[4 * g + 3] + E + w3) * LOG2E); p0[4 * g + 2] = __builtin_amdgcn_exp2f((p0[4 * g + 2] + E + w2) * LOG2E);
      p0[4 * g + 1] = __builtin_amdgcn_exp2f((p0[4 * g + 1] + E + w1) * LOG2E); p0[4 * g + 0] = __builtin_amdgcn_exp2f((p0[4 * g + 0] + E + w0) * LOG2E);
    } else {
      const int q = g - 4;
      const float w3 = 0.f, w2 = x1[4 * q + 3], w1 = w2 + x1[4 * q + 2], w0 = w1 + x1[4 * q + 1];
      p1[4 * q + 3] = __builtin_amdgcn_exp2f((p1[4 * q + 3] + E + w3) * LOG2E); p1[4 * q + 2] = __builtin_amdgcn_exp2f((p1[4 * q + 2] + E + w2) * LOG2E);
      p1[4 * q + 1] = __builtin_amdgcn_exp2f((p1[4 * q + 1] + E + w1) * LOG2E); p1[4 * q + 0] = __builtin_amdgcn_exp2f((p1[4 * q + 0] + E + w0) * LOG2E);
    }
    SBAR();
  }
  carry += total;
  bf16x8 pa0, pa1, pa2, pa3;
  PK4(p0, 0, pa0); PK4(p0, 8, pa1); PK4(p1, 0, pa2); PK4(p1, 8, pa3);
  asm volatile("s_waitcnt lgkmcnt(0)" ::: "memory"); SBAR();
  const int vb = (int)(unsigned)(uintptr_t)vbuf + v_rd_base(lane);
  pv_d0(o, vb, pa0, pa1, pa2, pa3);
}
__device__ __forceinline__ void stick_store(const f32x16 (&o)[4], const float* __restrict__ g_sb, bf16* __restrict__ Orow0, int nrows, ALAS char* vbuf, int lane, int r32, int hi) {
  float gs[4];
#pragma unroll
  for (int d0 = 0; d0 < 4; ++d0) gs[d0] = g_sb[d0 * 32 + r32];
  ALAS bf16* stg = (ALAS bf16*)vbuf;
#pragma unroll
  for (int r = 0; r < 16; ++r) {
    float ss = (o[0][r] * o[0][r] + o[1][r] * o[1][r]) + (o[2][r] * o[2][r] + o[3][r] * o[3][r]);
#pragma unroll
    for (int m = 1; m < 32; m <<= 1) ss += __shfl_xor(ss, m);
    const float rs = __builtin_amdgcn_rsqf(ss * (1.0f / 128.0f) + EPS);
    const int q = crow(r, hi);
#pragma unroll
    for (int d0 = 0; d0 < 4; ++d0) stg[q * 128 + d0 * 32 + r32] = (bf16)(cvtpk(o[d0][r] * rs * gs[d0], 0.f) & 0xffffu);
  }
  asm volatile("s_waitcnt lgkmcnt(0)" ::: "memory");
#pragma unroll
  for (int i = 0; i < 8; ++i) { const int id = i * 64 + lane, row = id >> 4, ch = id & 15;
    if (row < nrows) { const u32x4 v = *(const ALAS u32x4*)(stg + row * 128 + ch * 8); *(u32x4*)(Orow0 + (size_t)row * DMODEL + ch * 8) = v; } }
  asm volatile("s_waitcnt lgkmcnt(0)" ::: "memory");
}
__device__ __forceinline__ void stick_prompt_unit(int h, int qt, const bf16* __restrict__ BQ, const bf16* __restrict__ BK, const bf16* __restrict__ BV, const float* __restrict__ g_sb, bf16* __restrict__ O, ALAS char* vbuf) {
  const int lane = threadIdx.x & 63, r32 = lane & 31, hi = lane >> 5; const int t0 = 32 * qt;
  const bf16* Qw = BQ + (size_t)(t0 + r32) * HW + h * 128 + hi * 8;
  f32x16 o[4] = {}; float carry = 0.f; const int qpos = t0 + r32; const int jd = t0 >> 6;
  for (int j = jd; j >= 0; --j) {
    stick_tile<bf16>(o, carry, Qw, BK + (size_t)(64 * j) * HW + h * 128, BV + (size_t)(64 * j) * HW + h * 128, HW, 64, 64 * j, qpos, j == jd, vbuf, lane, r32, hi);
    if (__all(carry < SB_STOP)) break;
  }
  stick_store(o, g_sb, O + (size_t)t0 * DMODEL + 2048 + h * 128, 32, vbuf, lane, r32, hi);
}
__device__ __forceinline__ void stick_sample_unit(int b, int h, const bf16* __restrict__ BQ, const bf16* __restrict__ BK, const bf16* __restrict__ BV, const float* __restrict__ cbk, const float* __restrict__ cbv,
                                                  const float* __restrict__ g_sb, bf16* __restrict__ O, ALAS char* vbuf) {
  const int lane = threadIdx.x & 63, r32 = lane & 31, hi = lane >> 5; const size_t row0 = (size_t)TP + b * 16;
  const bf16* Qw = BQ + (row0 + (r32 & 15)) * HW + h * 128 + hi * 8;
  f32x16 o[4] = {}; float carry = 0.f; const int qpos = 2048 + (r32 & 15);
  stick_tile<bf16>(o, carry, Qw, BK + row0 * HW + h * 128, BV + row0 * HW + h * 128, HW, 16, 2048, qpos, true, vbuf, lane, r32, hi);
  for (int j = 31; j >= 0; --j) {
    if (__all(carry < SB_STOP)) break;
    const size_t ro = ((size_t)(b * 2048 + 64 * j) * 16 + h) * 128;
    stick_tile<float>(o, carry, Qw, cbk + ro, cbv + ro, 2048, 64, 64 * j, qpos, false, vbuf, lane, r32, hi);
  }
  stick_store(o, g_sb, O + row0 * DMODEL + 2048 + h * 128, 16, vbuf, lane, r32, hi);
}
#undef PK4
#undef SBAR
#undef RESC
}
constexpr int NWAVES = 8;
#ifndef MK_N_LAUNCHES
#define MK_N_LAUNCHES 1
#endif
constexpr int N_PHASES = 8;
constexpr int N_LAUNCHES = MK_N_LAUNCHES;
static_assert(N_LAUNCHES == 1 || N_LAUNCHES == N_PHASES, "MK_N_LAUNCHES is 1 or 8");

constexpr int DM = 4096, TP = 8192, TS = 256, MROWS = TP + TS, HW = 2048, NIN = 6 * HW, DFF = 16384;
constexpr int DEC_B = 16, DEC_T = 16, PAST = 2048, A_HEADS = 8, B_HEADS = 16;
constexpr float EPS = 1e-6f, LAM_INIT = 0.2f;
constexpr size_t OUT_Y = 0;
constexpr size_t OUT_KVP = (size_t)MROWS * DM;
constexpr size_t OUT_KVS = OUT_KVP + 4 * (size_t)TP * HW;
constexpr size_t OUT_TOTAL = OUT_KVS + 4 * (size_t)TS * HW;
static_assert(OUT_TOTAL == 103809024ull, "output size");
constexpr size_t MiB = 1u << 20;
constexpr size_t WS_CTL = 0, CTL_ZERO_BYTES = 1 * MiB;
constexpr size_t WS_ROPE = 2 * MiB;
constexpr size_t WS_WIN = 4 * MiB;
constexpr size_t WS_WOUT = WS_WIN + 96 * MiB;
constexpr size_t WS_WUP = WS_WOUT + 32 * MiB;
constexpr size_t WS_WDOWN = WS_WUP + 128 * MiB;
constexpr size_t WS_H0 = WS_WDOWN + 128 * MiB;
constexpr size_t WS_QKV = WS_H0 + 66 * MiB;
constexpr size_t WS_OA = WS_QKV + 198 * MiB;
constexpr size_t WS_O = WS_OA + 128 * MiB;
constexpr size_t WS_X1 = WS_O + 66 * MiB;
constexpr size_t WS_H1 = WS_X1 + 132 * MiB;
constexpr size_t WS_U = WS_H1 + 66 * MiB;
constexpr size_t WS_END = WS_U + 264 * MiB;
static_assert((size_t)MROWS * DM * 2 <= 66 * MiB && (size_t)MROWS * HW * 2 * 6 <= 198 * MiB && (size_t)MROWS * DM * 4 <= 132 * MiB && (size_t)MROWS * DFF * 2 <= 264 * MiB, "ws map");
constexpr int CW_TMO = 0, CW_CODE = 1;
constexpr int CW_BAR = 4096;
constexpr int CW_SSQ1 = 16384, CW_SSQ2 = 32768;
static_assert((CW_SSQ2 + MROWS) * 4 <= (int)CTL_ZERO_BYTES, "CTL words inside the memset region");
constexpr int RING_OFF = 0, RING_BYTES = 135168;
constexpr int LDSCTL_OFF = RING_BYTES, MISC_OFF = LDSCTL_OFF + 320;
constexpr int LDS_BYTES = 147456;
static_assert(MISC_OFF + 128 <= LDS_BYTES && att::SA_LDS <= RING_BYTES && att::SHM_ATTN <= RING_BYTES, "LDS map");

#define GAS __attribute__((address_space(1)))
#define LAS __attribute__((address_space(3)))
typedef unsigned short bf16;
typedef unsigned v4u __attribute__((ext_vector_type(4)));
typedef float f32x4 __attribute__((ext_vector_type(4)));
typedef short bf16x8 __attribute__((ext_vector_type(8)));
typedef GAS unsigned gu32;
typedef GAS unsigned long long gu64;
#define RLX_AGENT __ATOMIC_RELAXED, __HIP_MEMORY_SCOPE_AGENT
#define LDS_WAIT() asm volatile("s_waitcnt lgkmcnt(0)" ::: "memory")
#define VM_WAIT() asm volatile("s_waitcnt vmcnt(0)" ::: "memory")
__device__ __forceinline__ unsigned long long rt() { return __builtin_amdgcn_s_memrealtime(); }
__device__ __forceinline__ unsigned f2bf(float f) { unsigned u = __builtin_bit_cast(unsigned, f); return (u + 0x7fffu + ((u >> 16) & 1u)) >> 16; }
__device__ __forceinline__ unsigned pk2(float lo, float hi) { return f2bf(lo) | (f2bf(hi) << 16); }

#define XB_TMO      128
#define XB_XCNT(j)  (256  + 64 * (j))
#define XB_XSUB(j)  (1280 + 64 * (j))
#define XB_XGEN(j)  (2304 + 64 * (j))
#define XB_TOP      3328
#define XB_TOPGEN   3392
#define XCD_BAR_WORDS 3456
#define XB_SPIN_CAP (1u << 18)

__device__ __forceinline__ unsigned xb_ld(unsigned* p)              { return __hip_atomic_load(p, __ATOMIC_RELAXED, __HIP_MEMORY_SCOPE_AGENT); }
__device__ __forceinline__ unsigned xb_add(unsigned* p, unsigned v) { return __hip_atomic_fetch_add(p, v, __ATOMIC_RELAXED, __HIP_MEMORY_SCOPE_AGENT); }
__device__ __forceinline__ unsigned xb_xcc_id() { return (unsigned)__builtin_amdgcn_s_getreg((3 << 11) | 20) & 0xFu; }
#define XB_SPIN(cond, bar) do { unsigned _sp = 0; while (cond) { __builtin_amdgcn_s_sleep(1); \
    if ((++_sp & 255u) == 0u) { if (xb_ld(&(bar)[XB_TMO])) break; if (_sp > XB_SPIN_CAP) { atomicAdd(&(bar)[XB_TMO], 1u); break; } } } } while (0)

struct XcdBarrier {
    unsigned* bar; unsigned x;
    volatile LAS unsigned* st;
};

__device__ __forceinline__ XcdBarrier xcd_barrier_post(unsigned* bar, volatile LAS unsigned* st) {
    XcdBarrier b; b.bar = bar; b.x = xb_xcc_id(); b.st = st;
    if (threadIdx.x == 0) (void)xb_add(&bar[XB_XCNT(b.x)], 1u);
    return b;
}
__device__ __forceinline__ void xcd_barrier_complete(unsigned* bar, unsigned x, unsigned& nloc, unsigned& nx) {
    const unsigned G = gridDim.x * gridDim.y * gridDim.z;
    unsigned sum, cnt, mine, sp = 0u;
    for (;;) {
        sum = 0u; cnt = 0u; mine = 0u;
#pragma unroll
        for (unsigned j = 0; j < 16; ++j) { const unsigned c = xb_ld(&bar[XB_XCNT(j)]); sum += c; cnt += (c > 0u) ? 1u : 0u; mine = (j == x) ? c : mine; }
        if (sum == G) break;
        __builtin_amdgcn_s_sleep(1);
        if ((++sp & 255u) == 0u) { if (xb_ld(&bar[XB_TMO])) break; if (sp > XB_SPIN_CAP) { atomicAdd(&bar[XB_TMO], 1u); break; } }
    }
    nloc = mine > 0u ? mine : 1u; nx = cnt > 0u ? cnt : 1u;
}

__device__ __forceinline__ void xcd_barrier(const XcdBarrier& b) {
    asm volatile("s_waitcnt vmcnt(0)" ::: "memory");
    __syncthreads();
    if (threadIdx.x == 0) {
        unsigned* bar = b.bar;
        __builtin_amdgcn_s_waitcnt(0);
        unsigned nloc = b.st[0], nx = b.st[1];
        if (nloc == 0u) { xcd_barrier_complete(bar, b.x, nloc, nx); b.st[0] = nloc; b.st[1] = nx; }
        const unsigned old = xb_add(&bar[XB_XSUB(b.x)], 1u);
        const unsigned gen = old / nloc;
        if (old + 1u == (gen + 1u) * nloc) {
            __builtin_amdgcn_fence(__ATOMIC_RELEASE, "agent");
            asm volatile("s_waitcnt vmcnt(0)" ::: "memory");
            const unsigned og = xb_add(&bar[XB_TOP], 1u);
            const unsigned tg = og / nx;
            if (og + 1u == (tg + 1u) * nx) xb_add(&bar[XB_TOPGEN], 1u);
            else XB_SPIN(xb_ld(&bar[XB_TOPGEN]) == tg, bar);
            __builtin_amdgcn_fence(__ATOMIC_ACQUIRE, "agent");
            xb_add(&bar[XB_XGEN(b.x)], 1u);
            asm volatile("s_waitcnt vmcnt(0)" ::: "memory");
        } else {
            XB_SPIN(xb_ld(&bar[XB_XGEN(b.x)]) == gen, bar);
            __builtin_amdgcn_fence(__ATOMIC_ACQUIRE, "agent");
            asm volatile("s_waitcnt vmcnt(0)" ::: "memory");
        }
    }
    __syncthreads();
}


__device__ __forceinline__ int lane_now() { int t = threadIdx.x; asm volatile("" : "+v"(t)); return t & 63; }
struct Frame {
    LAS unsigned char* lds;
    volatile LAS unsigned* MISC;
    gu32* ctl;
    int tid, lane, wave;
    int vcu, G;
};
__device__ __forceinline__ float wave_sum(float v) {
#pragma unroll
    for (int o = 1; o < 64; o <<= 1) v += __shfl_xor(v, o);
    return v;
}
__constant__ double ROPE_INV[16] = {
    1.0, 0.44036660267178046, 0.19392274474868576, 0.08539710028576561, 0.03760603093086393, 0.016560440080994446, 0.007292664737217109, 0.003211445994752591,
    0.001414213562373095, 0.000622772421914596, 0.0002742481756762073, 0.00012076973741146504, 5.318295896944988e-05, 2.341999896140934e-05, 1.031338537721246e-05, 4.5416704806078695e-06 };

__device__ __forceinline__ void p0_transpose_item(const float* W, int K, int N, bf16* WT, LAS float* scr, int item, int lane) {
    const int nblk = N / 32, kb = item / nblk, nb = item % nblk, k0 = 64 * kb, n0 = 32 * nb;
#pragma unroll 8
    for (int i = 0; i < 32; ++i) { const int kk = 2 * i + (lane >> 5); scr[kk * 33 + (lane & 31)] = W[(size_t)(k0 + kk) * N + n0 + (lane & 31)]; }
    LDS_WAIT(); asm volatile("" ::: "memory");
    const int c = lane & 7;
#pragma unroll
    for (int j = 0; j < 4; ++j) { const int n = (lane >> 3) + 8 * j; const LAS float* s = scr + (8 * c) * 33 + n;
        v4u o; o.x = pk2(s[0 * 33], s[1 * 33]); o.y = pk2(s[2 * 33], s[3 * 33]); o.z = pk2(s[4 * 33], s[5 * 33]); o.w = pk2(s[6 * 33], s[7 * 33]);
        *(GAS v4u*)(WT + (size_t)(n0 + n) * K + k0 + 8 * c) = o; }
    LDS_WAIT(); asm volatile("" ::: "memory");
}
__device__ __forceinline__ void rms_row_to_bf16(const float* xrow, const float* g, bf16* orow, int lane) {
    const GAS f32x4* xr = (const GAS f32x4*)xrow + lane; const GAS f32x4* gr = (const GAS f32x4*)g + lane;
    f32x4 v[16]; float s = 0.f;
#pragma unroll
    for (int j = 0; j < 16; ++j) { v[j] = xr[64 * j]; s += (v[j].x * v[j].x + v[j].y * v[j].y) + (v[j].z * v[j].z + v[j].w * v[j].w); }
    const float rstd = 1.0f / sqrtf(wave_sum(s) * (1.f / DM) + EPS);
    GAS unsigned long long* o8 = (GAS unsigned long long*)orow + lane;
#pragma unroll
    for (int j = 0; j < 16; ++j) { const f32x4 gg = gr[64 * j];
        o8[64 * j] = (unsigned long long)pk2(v[j].x * rstd * gg.x, v[j].y * rstd * gg.y) | ((unsigned long long)pk2(v[j].z * rstd * gg.z, v[j].w * rstd * gg.w) << 32); }
}
__device__ __forceinline__ float lambda_of(const float* q1, const float* k1, const float* q2, const float* k2, int lane) {
    const float a = wave_sum(q1[lane] * k1[lane] + q1[64 + lane] * k1[64 + lane]);
    const float b = wave_sum(q2[lane] * k2[lane] + q2[64 + lane] * k2[64 + lane]);
    return expf(a) - expf(b) + LAM_INIT;
}

typedef const __attribute__((address_space(4))) char* kaptr;
__device__ __forceinline__ kaptr karg_base() { kaptr ka = (kaptr)__builtin_amdgcn_kernarg_segment_ptr(); asm volatile("" : "+s"(ka)); return ka; }
__device__ __forceinline__ const float* karg_in(int i) { return *(const float* const __attribute__((address_space(4)))*)(karg_base() + 8 * i); }
__device__ __forceinline__ float* karg_out() { return *(float* const __attribute__((address_space(4)))*)(karg_base() + 152); }
__device__ __forceinline__ unsigned char* karg_ws() { return *(unsigned char* const __attribute__((address_space(4)))*)(karg_base() + 160); }
struct Args { const float* in[19]; float* out; unsigned char* ws; int ph_lo, ph_hi, li, pad; };
static_assert(offsetof(Args, out) == 152 && offsetof(Args, ws) == 160 && sizeof(Args) == 184, "kernarg layout used by karg_*");
__global__ void __launch_bounds__(NWAVES * 64, 2) hybrid_fwd(Args args) {
    extern __shared__ __attribute__((aligned(16))) unsigned char lds[];
    Frame F;
    F.lds = (LAS unsigned char*)lds;
    F.MISC = (volatile LAS unsigned*)(F.lds + MISC_OFF);
    F.tid = threadIdx.x; F.lane = 0; F.wave = __builtin_amdgcn_readfirstlane(F.tid >> 6);
    F.G = gridDim.x; { const int bx = blockIdx.x; F.vcu = (F.G % 8 == 0) ? (bx % 8) * (F.G / 8) + bx / 8 : bx; }
    F.ctl = (gu32*)(karg_ws() + WS_CTL);
    constexpr size_t QS = (size_t)MROWS * HW;
#define KIN(i) karg_in(i)
#define KWS(T, off) ((T*)(karg_ws() + (off)))
#define KSSQ(w) ((float*)(karg_ws() + WS_CTL) + (w))
    for (int u = F.tid; u < (LDS_BYTES - LDSCTL_OFF) / 4; u += NWAVES * 64) ((LAS unsigned*)(F.lds + LDSCTL_OFF))[u] = 0u;
    __syncthreads();
    XcdBarrier bar; bar.bar = (unsigned*)(F.ctl + CW_BAR); bar.x = 0; bar.st = nullptr;
    if (N_LAUNCHES == 1) bar = xcd_barrier_post((unsigned*)(F.ctl + CW_BAR), F.MISC + 8);
#define GRID_BAR() do { if (N_LAUNCHES == 1) xcd_barrier(bar); } while (0)
    const int lo = args.ph_lo, hi = args.ph_hi;
#ifndef PH_MASK
#define PH_MASK 0xff
#endif
#define IN(k) (((PH_MASK >> (k)) & 1) && lo <= (k) && (k) < hi)
#define BOTH(k) (IN(k) && IN((k) + 1))
    const int gw = F.vcu * NWAVES + F.wave, NGW = F.G * NWAVES;

    if (IN(0)) {
        LAS float* scr = (LAS float*)(F.lds + RING_OFF + F.wave * 16384);
        const float* x_prompt = KIN(0); const float* x_sample = KIN(1); const float* g_attn = KIN(6); const float* w_in = KIN(7); const float* w_out = KIN(14); const float* w_up = KIN(16); const float* w_down = KIN(17);
        bf16* Win_t = KWS(bf16, WS_WIN); bf16* Wout_t = KWS(bf16, WS_WOUT); bf16* Wup_t = KWS(bf16, WS_WUP); bf16* Wdown_t = KWS(bf16, WS_WDOWN); bf16* H0 = KWS(bf16, WS_H0); float* ROPE = KWS(float, WS_ROPE);
        constexpr int I_IN = (DM / 64) * (NIN / 32), I_OUT = (DM / 64) * (DM / 32), I_UP = (DM / 64) * (DFF / 32), I_DOWN = (DFF / 64) * (DM / 32);
        constexpr int NITEMS = I_IN + I_OUT + I_UP + I_DOWN;
        for (int it = gw; it < NITEMS; it += NGW) {
            int r = it;
            if (r < I_IN) { p0_transpose_item(w_in, DM, NIN, Win_t, scr, r, lane_now()); continue; } r -= I_IN;
            if (r < I_OUT) { p0_transpose_item(w_out, DM, DM, Wout_t, scr, r, lane_now()); continue; } r -= I_OUT;
            if (r < I_UP) { p0_transpose_item(w_up, DM, DFF, Wup_t, scr, r, lane_now()); continue; } r -= I_UP;
            p0_transpose_item(w_down, DFF, DM, Wdown_t, scr, r, lane_now());
        }
        for (int m = gw; m < MROWS; m += NGW) rms_row_to_bf16(m < TP ? x_prompt + (size_t)m * DM : x_sample + (size_t)(m - TP) * DM, g_attn, H0 + (size_t)m * DM, lane_now());
        for (int e = blockIdx.x * (NWAVES * 64) + F.tid; e < MROWS * 16; e += F.G * NWAVES * 64) {
            const int row = e >> 4, d = e & 15; const int pos = row < TP ? row : PAST + ((row - TP) & 15);
            const double rev = (double)pos * ROPE_INV[d] * 0.15915494309189535; const float fr = (float)(rev - floor(rev));
            ROPE[(size_t)row * 32 + d] = __builtin_amdgcn_cosf(fr); ROPE[(size_t)row * 32 + 16 + d] = __builtin_amdgcn_sinf(fr);
        }
        if (BOTH(0)) GRID_BAR();
    }
    if (IN(1)) {
        float* out = karg_out();
        pg8::Gemm g{KWS(bf16, WS_H0), KWS(bf16, WS_WIN), MROWS, NIN, DM}; pg8::StaticOrder S; S.init(MROWS, NIN, F.G, (int)blockIdx.x);
        pg8::EpiInProj E{KWS(bf16, WS_QKV), out + OUT_KVP, out + OUT_KVS, KWS(float, WS_ROPE)};
        pg8::gemm_phase<pg8::EpiInProj, pg8::StaticOrder, true, true>(F.lds + RING_OFF, g, S, E);
        if (BOTH(1)) GRID_BAR();
    }
    if (IN(2)) {
        LAS char* al = (LAS char*)(F.lds + RING_OFF);
        const bf16* QKV = KWS(bf16, WS_QKV); bf16* OB = KWS(bf16, WS_O);
        const bf16* AQ = QKV; const bf16* AK = QKV + QS; const bf16* AV = QKV + 2 * QS; const bf16* BQ = QKV + 3 * QS; const bf16* BK = QKV + 4 * QS; const bf16* BV = QKV + 5 * QS;
#ifndef P2_MASK
#define P2_MASK 7
#endif
        if ((P2_MASK & 1) && F.G == 256) {
            const int vh = F.vcu >> 3, s = F.vcu & 7;
            for (int i = 0; i < 4; ++i) { const int qb = (i == 0) ? 31 - s : (i == 1) ? 16 + s : (i == 2) ? 15 - s : s; att::attnA_prompt_unit(vh, qb, AQ, AK, AV, KWS(float, WS_OA), al); }
        } else if (P2_MASK & 1) {
            for (int u = blockIdx.x; u < 1024; u += F.G) att::attnA_prompt_unit(u >> 5, u & 31, AQ, AK, AV, KWS(float, WS_OA), al);
        }
        if (P2_MASK & 2) for (int u = F.vcu; u < DEC_B * A_HEADS; u += F.G) {
            const float lam = lambda_of(KIN(8), KIN(9), KIN(10), KIN(11), lane_now());
            att::attnA_sample_unit(u >> 3, u & 7, KIN(2), KIN(3), karg_out() + OUT_KVS, karg_out() + OUT_KVS + (size_t)TS * HW, AQ, lam, KIN(12), 1.0f - LAM_INIT, OB, al); }
        if (P2_MASK & 4) {
            LAS char* vbuf = al + F.wave * 16384; const float* g_sb = KIN(13); const float* cache_b_k = KIN(4); const float* cache_b_v = KIN(5);
            for (int u = gw; u < B_HEADS * (TP / 32) + DEC_B * B_HEADS; u += NGW) {
                if (u < B_HEADS * (TP / 32)) att::stick_prompt_unit(u & 15, (TP / 32 - 1) - (u >> 4), BQ, BK, BV, g_sb, OB, vbuf);
                else { const int v = u - B_HEADS * (TP / 32); att::stick_sample_unit(v >> 4, v & 15, BQ, BK, BV, cache_b_k, cache_b_v, g_sb, OB, vbuf); }
            }
        }
        if (BOTH(2)) GRID_BAR();
    }
    if (IN(3)) {
        const int lane = lane_now();
        const float lam = lambda_of(KIN(8), KIN(9), KIN(10), KIN(11), lane);
        const f32x4 gg = *(const f32x4*)(KIN(12) + 4 * lane); const float* OA = KWS(float, WS_OA); bf16* OB = KWS(bf16, WS_O);
        for (int it = gw; it < TP * A_HEADS; it += NGW) {
            const int t = it >> 3, h = it & 7;
            const float* p = OA + (size_t)t * DM + h * 512 + 4 * lane;
            const f32x4 a = *(const f32x4*)p, b = *(const f32x4*)(p + 256);
            const f32x4 d = a - lam * b;
            const float ss = wave_sum((d.x * d.x + d.y * d.y) + (d.z * d.z + d.w * d.w));
            const float rs = (1.0f - LAM_INIT) / sqrtf(ss * (1.0f / 256.0f) + EPS);
            *(unsigned long long*)(OB + (size_t)t * DM + h * 256 + 4 * lane) = (unsigned long long)pk2(d.x * rs * gg.x, d.y * rs * gg.y) | ((unsigned long long)pk2(d.z * rs * gg.z, d.w * rs * gg.w) << 32);
        }
        if (BOTH(3)) GRID_BAR();
    }
    if (IN(4)) {
        pg8::Gemm g{KWS(bf16, WS_O), KWS(bf16, WS_WOUT), MROWS, DM, DM}; pg8::StaticOrder S; S.init(MROWS, DM, F.G, (int)blockIdx.x);
        pg8::EpiOutProj E{KIN(0), KIN(1), KIN(15), KWS(float, WS_X1), KWS(bf16, WS_H1), KSSQ(CW_SSQ1)};
        pg8::gemm_phase<pg8::EpiOutProj, pg8::StaticOrder, true, true>(F.lds + RING_OFF, g, S, E);
        if (BOTH(4)) GRID_BAR();
    }
    if (IN(5)) {
        pg8::Gemm g{KWS(bf16, WS_H1), KWS(bf16, WS_WUP), MROWS, DFF, DM}; pg8::StaticOrder S; S.init(MROWS, DFF, F.G, (int)blockIdx.x);
        pg8::EpiUp E{KSSQ(CW_SSQ1), KWS(bf16, WS_U)};
        pg8::gemm_phase<pg8::EpiUp, pg8::StaticOrder, true, true>(F.lds + RING_OFF, g, S, E);
        if (BOTH(5)) GRID_BAR();
    }
    if (IN(6)) {
        pg8::Gemm g{KWS(bf16, WS_U), KWS(bf16, WS_WDOWN), MROWS, DM, DFF}; pg8::StaticOrder S; S.init(MROWS, DM, F.G, (int)blockIdx.x);
        pg8::EpiDown E{KWS(float, WS_X1), karg_out() + OUT_Y, KSSQ(CW_SSQ2)};
        pg8::gemm_phase<pg8::EpiDown, pg8::StaticOrder, true, true>(F.lds + RING_OFF, g, S, E);
        if (BOTH(6)) GRID_BAR();
    }
    if (IN(7)) {
        unsigned bad = __hip_atomic_load(F.ctl + CW_BAR + XB_TMO, RLX_AGENT);
        const float poison = bad ? __builtin_nanf("") : 0.f; float* out = karg_out(); const float* g_final = KIN(18); const float* SSQ2 = KSSQ(CW_SSQ2);
        const int lane = lane_now();
        for (int m = gw; m < MROWS; m += NGW) {
            const float rs = 1.0f / sqrtf(SSQ2[m] * (1.f / DM) + EPS) + poison;
            GAS f32x4* yr = (GAS f32x4*)(out + OUT_Y + (size_t)m * DM) + lane; const GAS f32x4* gr = (const GAS f32x4*)g_final + lane;
#pragma unroll
            for (int j = 0; j < 16; ++j) { const f32x4 v = yr[64 * j], gg = gr[64 * j]; yr[64 * j] = v * rs * gg; }
        }
    }
#undef IN
#undef BOTH
#undef GRID_BAR
}

extern "C" void kernel_launch(void* const* d_in, const int* in_sizes, int n_in, void* d_out, int out_size, void* d_ws, size_t ws_size, hipStream_t stream) {
    static int grid = 0;
    if (grid == 0) {
        if (n_in != 19 || in_sizes[0] != TP * DM || (size_t)out_size != OUT_TOTAL || ws_size < WS_END) {
            fprintf(stderr, "kernel_launch: shape mismatch (n_in %d, in0 %d, out %d, ws %zu; need ws >= %zu); nothing launched\n", n_in, n_in > 0 ? in_sizes[0] : -1, out_size, ws_size, (size_t)WS_END); grid = -1; return; }
        int dev = 0, cus = 0, per_cu = 0;
        if (hipGetDevice(&dev) != hipSuccess || hipDeviceGetAttribute(&cus, hipDeviceAttributeMultiprocessorCount, dev) != hipSuccess) { grid = -1; return; }
        if (hipFuncSetAttribute((const void*)hybrid_fwd, hipFuncAttributeMaxDynamicSharedMemorySize, LDS_BYTES) != hipSuccess) { fprintf(stderr, "kernel_launch: hipFuncSetAttribute failed\n"); grid = -1; return; }
        if (hipOccupancyMaxActiveBlocksPerMultiprocessor(&per_cu, (const void*)hybrid_fwd, NWAVES * 64, LDS_BYTES) != hipSuccess || per_cu < 1) { fprintf(stderr, "kernel_launch: occupancy query reports %d blocks per CU\n", per_cu); grid = -1; (void)hipGetLastError(); return; }
        (void)hipGetLastError();
        grid = cus;
    }
    if (grid < 0) return;
    if (hipMemsetAsync((char*)d_ws + WS_CTL, 0, CTL_ZERO_BYTES, stream) != hipSuccess) return;
    Args a{};
    for (int i = 0; i < 19; ++i) a.in[i] = (const float*)d_in[i];
    a.out = (float*)d_out; a.ws = (unsigned char*)d_ws;
    for (int li = 0; li < N_LAUNCHES; ++li) {
        a.ph_lo = (N_LAUNCHES == 1) ? 0 : li; a.ph_hi = (N_LAUNCHES == 1) ? N_PHASES : li + 1; a.li = li; a.pad = 0;
        hipLaunchKernelGGL(hybrid_fwd, dim3(grid), dim3(NWAVES * 64), LDS_BYTES, stream, a);
        const hipError_t le = hipPeekAtLastError();
        if (le != hipSuccess) { fprintf(stderr, "kernel_launch: launch %d failed: %s\n", li, hipGetErrorName(le)); break; }
    }
}
```

```cpp
#ifndef MK_N_LAUNCHES
#define MK_N_LAUNCHES 1
#endif
#include <hip/hip_runtime.h>
#include <cstdio>
#include <cstdint>
#include <cmath>
__device__ __forceinline__ int lane_id() { return (int)__builtin_amdgcn_mbcnt_hi(~0u, __builtin_amdgcn_mbcnt_lo(~0u, 0u)); }
namespace pg8 {
#define PG8_LAS __attribute__((address_space(3)))
typedef unsigned short bf16_t;
typedef short bf16x8 __attribute__((ext_vector_type(8)));
typedef float f32x4 __attribute__((ext_vector_type(4)));
typedef unsigned u32x4 __attribute__((ext_vector_type(4)));
constexpr int BM = 256, BK = 64, HALF = 128, HTB = HALF * BK * 2  , STAGE_BYTES = 8 * HTB, NXCD = 8, WGM = 8;

__host__ __device__ __forceinline__ int lds_byte(int r, int c) { const int st = (r >> 4) * 2 + (c >> 5), rr = r & 15, cc = c & 31, ob = rr * 64 + cc * 2; return st * 1024 + (ob ^ (((ob >> 9) & 1) << 5)); }
__host__ __device__ __forceinline__ void stage_rc(int b, int& R, int& C) { const int st = b / 1024, sb = b % 1024, swz = sb ^ (((sb >> 9) & 1) << 5); R = (st >> 1) * 16 + swz / 64; C = (st & 1) * 32 + (swz % 64) / 2; }
__host__ __device__ __forceinline__ int perm32(int rho) { const int n = rho >> 4, i = rho & 15; return 8 * (i >> 2) + 4 * n + (i & 3); }

struct Unit { int pm, pn, kofs, ks; };
struct Gemm { const bf16_t* A; const bf16_t* Bt; int M, N, K, ld; };

struct StaticOrder {
    int nM, nN, nwg, G, c, wgm;
    __host__ __device__ void init(int M, int N, int G_, int c_, int wgm_ = WGM) { nM = M / BM; nN = N / BM; nwg = nM * nN; G = G_; c = c_; wgm = wgm_; }
    __host__ __device__ bool next(int i, Unit& u) const {
        const long L = (long)i * G + c; if (L >= nwg) return false;
        int wgid = (int)L; { const int q = nwg / NXCD, r = nwg % NXCD, xcd = wgid % NXCD, off = wgid / NXCD; wgid = (xcd < r ? xcd * (q + 1) : r * (q + 1) + (xcd - r) * q) + off; }
        const int nig = wgm * nN, gid = wgid / nig, fm = gid * wgm, gsz = (nM - fm) < wgm ? (nM - fm) : wgm;
        u.pm = fm + ((wgid % nig) % gsz); u.pn = (wgid % nig) / gsz; u.kofs = 0; u.ks = 0; return true;
    }
    __device__ __forceinline__ void a_ready(const Unit&) const {}
    __device__ __forceinline__ void done(const Unit&) const {}
};
struct MiniOrder {
    int nN, nsplit, ksl, G, c, pm;
    __host__ __device__ void init(int N, int nsplit_, int ksl_, int G_, int c_, int pm_) { nN = N / BM; nsplit = nsplit_; ksl = ksl_; G = G_; c = c_; pm = pm_; }
    __host__ __device__ bool next(int i, Unit& u) const {
        const long L = (long)i * G + c; if (L >= (long)nN * nsplit) return false;
        const int m = (int)L; u.pm = pm; u.pn = m / nsplit; u.ks = m % nsplit; u.kofs = u.ks * ksl; return true;
    }
    __device__ __forceinline__ void a_ready(const Unit&) const {}
    __device__ __forceinline__ void done(const Unit&) const {}
};


typedef float f32x2_cv __attribute__((ext_vector_type(2))); typedef __bf16 bf16x2_cv __attribute__((ext_vector_type(2)));
__device__ __forceinline__ unsigned cvt_pk_bf16(float lo, float hi) { f32x2_cv v = {lo, hi}; bf16x2_cv b = __builtin_convertvector(v, bf16x2_cv); return __builtin_bit_cast(unsigned, b); }
typedef float f32x2 __attribute__((ext_vector_type(2)));
constexpr int E_DM = 4096, E_TP = 8192, E_MROWS = 8448, E_HW = 2048, E_DFF = 16384;
constexpr float E_EPS = 1e-6f;
__device__ __forceinline__ float dot4(const f32x4 a) { return (a[0] * a[0] + a[1] * a[1]) + (a[2] * a[2] + a[3] * a[3]); }
__device__ __forceinline__ void ssq_add(float* p, float v) { __hip_atomic_fetch_add(p, v, __ATOMIC_RELAXED, __HIP_MEMORY_SCOPE_AGENT); }

struct EpiInProj {
    static constexpr bool PERM = true, AFTER_DRAIN = false;
    bf16_t* qkv;
    float* out_kvp;
    float* out_kvs;
    const float* rope;
    __device__ __forceinline__ void operator()(const f32x4 (&acc)[2][2][4][2], const Unit& u, int wr, int wc, int fr, int fq) const {
        const int t = u.pn >> 3;
        const int col0 = (u.pn & 7) * BM + wc * 32 + 8 * fq;
        const int row0 = u.pm * BM + wr * 64 + fr;
        bf16_t* base = qkv + (size_t)t * ((size_t)E_MROWS * E_HW);
        float* fo = nullptr;
        if (t == 1 || t == 2 || t == 4 || t == 5) {
            const int idx = (t == 1) ? 0 : (t == 2) ? 1 : (t == 4) ? 2 : 3;
            fo = (u.pm < 32) ? out_kvp + (size_t)idx * ((size_t)E_TP * E_HW) : out_kvs + (size_t)idx * (256 * E_HW) - (size_t)E_TP * E_HW;
        }
        const bool rope_on = (t < 2) && (wc == 0);
        const float sgn = (fq < 2) ? -1.f : 1.f;
#pragma unroll
        for (int ai = 0; ai < 2; ++ai)
#pragma unroll
            for (int m = 0; m < 4; ++m) {
                const int row = row0 + ai * HALF + m * 16;
                f32x4 v[2][2];
#pragma unroll
                for (int bj = 0; bj < 2; ++bj)
#pragma unroll
                    for (int n = 0; n < 2; ++n) v[bj][n] = acc[ai][bj][m][n];
                if (rope_on) {
                    const float* rp = rope + (size_t)row * 32 + 8 * (fq & 1);
                    const f32x4 c0 = *(const f32x4*)(rp), c1 = *(const f32x4*)(rp + 4), s0 = *(const f32x4*)(rp + 16), s1 = *(const f32x4*)(rp + 20);
#pragma unroll
                    for (int bj = 0; bj < 2; ++bj)
#pragma unroll
                        for (int n = 0; n < 2; ++n)
#pragma unroll
                            for (int j = 0; j < 4; ++j) {
                                const float mine = v[bj][n][j], other = __shfl_xor(mine, 32);
                                const float cc = n ? c1[j] : c0[j], ss = n ? s1[j] : s0[j];
                                v[bj][n][j] = mine * cc + sgn * other * ss;
                            }
                }
#pragma unroll
                for (int bj = 0; bj < 2; ++bj) {
                    u32x4 w; w.x = cvt_pk_bf16(v[bj][0][0], v[bj][0][1]); w.y = cvt_pk_bf16(v[bj][0][2], v[bj][0][3]); w.z = cvt_pk_bf16(v[bj][1][0], v[bj][1][1]); w.w = cvt_pk_bf16(v[bj][1][2], v[bj][1][3]);
                    *(u32x4*)(base + (size_t)row * E_HW + col0 + bj * HALF) = w;
                }
                if (fo) {
#pragma unroll
                    for (int bj = 0; bj < 2; ++bj) { float* p = fo + (size_t)row * E_HW + col0 + bj * HALF; *(f32x4*)p = v[bj][0]; *(f32x4*)(p + 4) = v[bj][1]; }
                }
            }
    }
};

struct EpiOutProj {
    static constexpr bool PERM = true, AFTER_DRAIN = false;
    const float* xp; const float* xs; const float* g; bf16_t* x1b; bf16_t* h1; float* ssq;
    __device__ __forceinline__ void operator()(const f32x4 (&acc)[2][2][4][2], const Unit& u, int wr, int wc, int fr, int fq) const {
        const int col0 = u.pn * BM + wc * 32 + 8 * fq;
        const int row0 = u.pm * BM + wr * 64 + fr;
        f32x4 gv[2][2];
#pragma unroll
        for (int bj = 0; bj < 2; ++bj) { gv[bj][0] = *(const f32x4*)(g + col0 + bj * HALF); gv[bj][1] = *(const f32x4*)(g + col0 + bj * HALF + 4); }
#pragma unroll
        for (int ai = 0; ai < 2; ++ai)
#pragma unroll
            for (int m = 0; m < 4; ++m) {
                const int row = row0 + ai * HALF + m * 16;
                const float* xrow = (row < E_TP) ? xp + (size_t)row * E_DM : xs + (size_t)(row - E_TP) * E_DM;
                float s = 0.f;
#pragma unroll
                for (int bj = 0; bj < 2; ++bj) {
                    const f32x4 r0 = *(const f32x4*)(xrow + col0 + bj * HALF), r1 = *(const f32x4*)(xrow + col0 + bj * HALF + 4);
                    const f32x4 v0 = acc[ai][bj][m][0] + r0, v1 = acc[ai][bj][m][1] + r1;
                    { u32x4 w; w.x = cvt_pk_bf16(v0[0], v0[1]); w.y = cvt_pk_bf16(v0[2], v0[3]); w.z = cvt_pk_bf16(v1[0], v1[1]); w.w = cvt_pk_bf16(v1[2], v1[3]); *(u32x4*)(x1b + (size_t)row * E_DM + col0 + bj * HALF) = w; }
                    s += dot4(v0) + dot4(v1);
                    const f32x4 a = v0 * gv[bj][0], b = v1 * gv[bj][1];
                    u32x4 w; w.x = cvt_pk_bf16(a[0], a[1]); w.y = cvt_pk_bf16(a[2], a[3]); w.z = cvt_pk_bf16(b[0], b[1]); w.w = cvt_pk_bf16(b[2], b[3]);
                    *(u32x4*)(h1 + (size_t)row * E_DM + col0 + bj * HALF) = w;
                }
                s += __shfl_xor(s, 16); s += __shfl_xor(s, 32);
                if (fq == 0) ssq_add(ssq + row, s);
                if (m & 1) asm volatile("" ::: "memory");
            }
    }
};

struct EpiUp {
    static constexpr bool PERM = true, AFTER_DRAIN = false;
    const float* ssq; bf16_t* U;
    __device__ __forceinline__ void operator()(const f32x4 (&acc)[2][2][4][2], const Unit& u, int wr, int wc, int fr, int fq) const {
        const int col0 = u.pn * BM + wc * 32 + 8 * fq;
        const int row0 = u.pm * BM + wr * 64 + fr;
#pragma unroll
        for (int ai = 0; ai < 2; ++ai)
#pragma unroll
            for (int m = 0; m < 4; ++m) {
                const int row = row0 + ai * HALF + m * 16;
                const float rs = __builtin_amdgcn_rsqf(ssq[row] * (1.0f / E_DM) + E_EPS);
#pragma unroll
                for (int bj = 0; bj < 2; ++bj) {
                    f32x4 a = acc[ai][bj][m][0] * rs, b = acc[ai][bj][m][1] * rs;
#pragma unroll
                    for (int j = 0; j < 4; ++j) { const float x = fmaxf(a[j], 0.f), y = fmaxf(b[j], 0.f); a[j] = x * x; b[j] = y * y; }
                    u32x4 w; w.x = cvt_pk_bf16(a[0], a[1]); w.y = cvt_pk_bf16(a[2], a[3]); w.z = cvt_pk_bf16(b[0], b[1]); w.w = cvt_pk_bf16(b[2], b[3]);
                    *(u32x4*)(U + (size_t)row * E_DFF + col0 + bj * HALF) = w;
                }
            }
    }
};

__device__ __forceinline__ float bf_lo(unsigned w) { return __uint_as_float(w << 16); }
__device__ __forceinline__ float bf_hi(unsigned w) { return __uint_as_float(w & 0xffff0000u); }
struct EpiDown {
    static constexpr bool PERM = true, AFTER_DRAIN = false;
    const bf16_t* x1b; bf16_t* x2b; float* ssq;
    __device__ __forceinline__ void operator()(const f32x4 (&acc)[2][2][4][2], const Unit& u, int wr, int wc, int fr, int fq) const {
        const int col0 = u.pn * BM + wc * 32 + 8 * fq;
        const int row0 = u.pm * BM + wr * 64 + fr;
#pragma unroll
        for (int ai = 0; ai < 2; ++ai)
#pragma unroll
            for (int m = 0; m < 4; ++m) {
                const int row = row0 + ai * HALF + m * 16;
                float s = 0.f;
#pragma unroll
                for (int bj = 0; bj < 2; ++bj) {
                    const u32x4 r = *(const u32x4*)(x1b + (size_t)row * E_DM + col0 + bj * HALF);
                    const f32x4 v0 = acc[ai][bj][m][0] + (f32x4){bf_lo(r.x), bf_hi(r.x), bf_lo(r.y), bf_hi(r.y)}, v1 = acc[ai][bj][m][1] + (f32x4){bf_lo(r.z), bf_hi(r.z), bf_lo(r.w), bf_hi(r.w)};
                    u32x4 w; w.x = cvt_pk_bf16(v0[0], v0[1]); w.y = cvt_pk_bf16(v0[2], v0[3]); w.z = cvt_pk_bf16(v1[0], v1[1]); w.w = cvt_pk_bf16(v1[2], v1[3]);
                    *(u32x4*)(x2b + (size_t)row * E_DM + col0 + bj * HALF) = w;
                    s += dot4(v0) + dot4(v1);
                }
                s += __shfl_xor(s, 16); s += __shfl_xor(s, 32);
                if (fq == 0) ssq_add(ssq + row, s);
                if (m & 1) asm volatile("" ::: "memory");
            }
    }
};

struct EpiPartial {
    static constexpr bool PERM = true, AFTER_DRAIN = false;
    float* part; int N;
    __device__ __forceinline__ void operator()(const f32x4 (&acc)[2][2][4][2], const Unit& u, int wr, int wc, int fr, int fq) const {
        const int col0 = u.pn * BM + wc * 32 + 8 * fq;
        float* base = part + ((size_t)u.ks * BM + wr * 64 + fr) * N + col0;
#pragma unroll
        for (int ai = 0; ai < 2; ++ai)
#pragma unroll
            for (int m = 0; m < 4; ++m)
#pragma unroll
                for (int bj = 0; bj < 2; ++bj) { float* p = base + (size_t)(ai * HALF + m * 16) * N + bj * HALF; *(f32x4*)p = acc[ai][bj][m][0]; *(f32x4*)(p + 4) = acc[ai][bj][m][1]; }
    }
};

template <class Epi, class Sched, bool ALIGN_EPI = false, bool SP2 = false>
__device__ __forceinline__ void gemm_phase(PG8_LAS unsigned char* lds, const Gemm g, const Sched& S, const Epi& E, const int wv  ) {
    int tid = wv * 64 + lane_id(); asm volatile("" : "+v"(tid));
    const int wid = __builtin_amdgcn_readfirstlane(tid >> 6), lane = tid & 63, wr = wid >> 2, wc = wid & 3, fr = lane & 15, fq = lane >> 4;
    const int K = g.ld, nt = g.K / BK;
    unsigned voffA[2], voffB[2];
#pragma unroll
    for (int i = 0; i < 2; ++i) { int R, C; stage_rc(tid * 16 + i * 8192, R, C); const int Rb = Epi::PERM ? ((R & ~31) + perm32(R & 31)) : R;
        voffA[i] = (unsigned)(R * K + C) * 2u; voffB[i] = (unsigned)(Rb * BK + C) * 2u; }
    const size_t kstep = (size_t)(BK * 2);
    const size_t hstep = (size_t)HALF * K * 2;
    const size_t tstep = 2 * hstep;
    const size_t kstepB = (size_t)BM * BK * 2, hstepB = (size_t)HALF * BK * 2, tstepB = (size_t)(K / BK) * kstepB;
    const unsigned ldsw = (unsigned)wid * 1024u;
    const int aoff = lds_byte(wr * 64 + fr, fq * 8), boff = lds_byte(wc * 32 + fr, fq * 8);
#define PG8_SA(b, h) (((b) * 2 + (h)) * HTB)
#define PG8_SB(b, h) ((4 + (b) * 2 + (h)) * HTB)
#define PG8_STAGE(bufoff, gbase, voff) do { _Pragma("unroll") for (int _i = 0; _i < 2; ++_i) \
        __builtin_amdgcn_global_load_lds((const unsigned*)((const char*)(gbase) + (voff)[_i]), (PG8_LAS unsigned*)(lds + (bufoff) + ldsw + _i * 8192), 16, 0, 0); } while (0)
#define PG8_LDA(dst, b, h) do { _Pragma("unroll") for (int m = 0; m < 4; ++m) _Pragma("unroll") for (int k = 0; k < 2; ++k) dst[m][k] = *(const PG8_LAS bf16x8*)(lds + PG8_SA(b, h) + aoff + m * 2048 + k * 1024); } while (0)
#define PG8_LDB(dst, b, h) do { _Pragma("unroll") for (int n = 0; n < 2; ++n) _Pragma("unroll") for (int k = 0; k < 2; ++k) dst[n][k] = *(const PG8_LAS bf16x8*)(lds + PG8_SB(b, h) + boff + n * 2048 + k * 1024); } while (0)
#define PG8_MMA(ai, bj, At, Bt) do { __builtin_amdgcn_s_setprio(1); _Pragma("unroll") for (int m = 0; m < 4; ++m) _Pragma("unroll") for (int n = 0; n < 2; ++n) _Pragma("unroll") for (int k = 0; k < 2; ++k) \
        acc[ai][bj][m][n] = __builtin_amdgcn_mfma_f32_16x16x32_bf16(Bt[n][k], At[m][k], acc[ai][bj][m][n], 0, 0, 0); __builtin_amdgcn_s_setprio(0); } while (0)
#define PG8_WAIT_V(n) asm volatile("s_waitcnt vmcnt(" #n ")" ::: "memory")
#define PG8_WAIT_L(n) asm volatile("s_waitcnt lgkmcnt(" #n ")" ::: "memory")
#define PG8_BAR __builtin_amdgcn_s_barrier()
#define PG8_SCHED __builtin_amdgcn_sched_barrier(0)
    Unit cur, nxt; int ui = 0;
    if (!S.next(0, cur)) return;
    f32x4 acc[2][2][4][2];
#pragma unroll
    for (int a = 0; a < 2; ++a)
#pragma unroll
        for (int b = 0; b < 2; ++b)
#pragma unroll
            for (int m = 0; m < 4; ++m)
#pragma unroll
                for (int n = 0; n < 2; ++n) acc[a][b][m][n] = (f32x4){0.f, 0.f, 0.f, 0.f};
    bf16x8 At[4][2], B0[2][2], B1[2][2];
    const char* cA = (const char*)g.A + (size_t)cur.pm * tstep + (size_t)cur.kofs * 2; const char* cB = (const char*)g.Bt + (size_t)cur.pn * tstepB + (size_t)(cur.kofs / BK) * kstepB;
    S.a_ready(cur);
    if constexpr (SP2) {
        PG8_STAGE(PG8_SB(0, 0), cB, voffB); PG8_STAGE(PG8_SB(0, 1), cB + hstepB, voffB); PG8_STAGE(PG8_SA(0, 0), cA, voffA); PG8_STAGE(PG8_SA(0, 1), cA + hstep, voffA);
        if (wr == 1) PG8_BAR;
        PG8_WAIT_V(2); PG8_BAR;
        PG8_STAGE(PG8_SB(1, 0), cB + kstepB, voffB); PG8_STAGE(PG8_SA(1, 0), cA + kstep, voffA); PG8_STAGE(PG8_SB(1, 1), cB + hstepB + kstepB, voffB);
        PG8_WAIT_V(6); PG8_BAR;
    } else {
        PG8_STAGE(PG8_SB(0, 0), cB, voffB); PG8_STAGE(PG8_SA(0, 0), cA, voffA); PG8_STAGE(PG8_SB(0, 1), cB + hstepB, voffB); PG8_STAGE(PG8_SA(0, 1), cA + hstep, voffA);
        if (wr == 1) PG8_BAR;
        PG8_WAIT_V(4); PG8_BAR;
        PG8_STAGE(PG8_SB(1, 0), cB + kstepB, voffB); PG8_STAGE(PG8_SA(1, 0), cA + kstep, voffA); PG8_STAGE(PG8_SB(1, 1), cB + hstepB + kstepB, voffB);
        PG8_WAIT_V(6); PG8_BAR;
    }
    for (;;) {
        const bool has_next = S.next(ui + 1, nxt);
        const char* nA = has_next ? (const char*)g.A + (size_t)nxt.pm * tstep + (size_t)nxt.kofs * 2 : cA; const char* nB = has_next ? (const char*)g.Bt + (size_t)nxt.pn * tstepB + (size_t)(nxt.kofs / BK) * kstepB : cB;
        for (int t = 0; t < nt; t += 2) {
            const bool last = (t == nt - 2);
            const char* a1 = cA + (size_t)(t + 1) * kstep;
            const char* a2 = last ? nA : cA + (size_t)(t + 2) * kstep; const char* b2 = last ? nB : cB + (size_t)(t + 2) * kstepB;
            const char* a3 = a2 + kstep; const char* b3 = b2 + kstepB;
            if (last && has_next) S.a_ready(nxt);
            if constexpr (SP2) {
            PG8_LDB(B0, 0, 0); PG8_LDB(B1, 0, 1); PG8_SCHED; PG8_LDA(At, 0, 0); PG8_STAGE(PG8_SA(1, 1), a1 + hstep, voffA);
            PG8_WAIT_V(8); PG8_WAIT_L(0); PG8_BAR; PG8_MMA(0, 0, At, B0); PG8_MMA(0, 1, At, B1); PG8_BAR; PG8_SCHED;
            PG8_LDA(At, 0, 1); PG8_STAGE(PG8_SB(0, 0), b2, voffB); PG8_STAGE(PG8_SB(0, 1), b2 + hstepB, voffB); PG8_STAGE(PG8_SA(0, 0), a2, voffA);
            PG8_WAIT_V(8); PG8_WAIT_L(0); PG8_BAR; PG8_MMA(1, 0, At, B0); PG8_MMA(1, 1, At, B1); PG8_BAR; PG8_SCHED;
            PG8_LDB(B0, 1, 0); PG8_LDB(B1, 1, 1); PG8_SCHED; PG8_LDA(At, 1, 0); PG8_STAGE(PG8_SA(0, 1), a2 + hstep, voffA);
            PG8_WAIT_V(8); PG8_WAIT_L(0); PG8_BAR; PG8_MMA(0, 0, At, B0); PG8_MMA(0, 1, At, B1); PG8_BAR; PG8_SCHED;
            PG8_LDA(At, 1, 1); PG8_STAGE(PG8_SB(1, 0), b3, voffB); PG8_STAGE(PG8_SB(1, 1), b3 + hstepB, voffB); PG8_STAGE(PG8_SA(1, 0), a3, voffA);
            PG8_WAIT_V(8); PG8_WAIT_L(0); PG8_BAR; PG8_MMA(1, 0, At, B0); PG8_MMA(1, 1, At, B1); PG8_BAR; PG8_SCHED;
            } else {
            PG8_LDB(B0, 0, 0); PG8_SCHED; PG8_LDA(At, 0, 0); PG8_STAGE(PG8_SA(1, 1), a1 + hstep, voffA);
            PG8_WAIT_L(8); PG8_BAR; PG8_WAIT_L(0); PG8_MMA(0, 0, At, B0); PG8_BAR; PG8_SCHED;
            PG8_LDB(B1, 0, 1); PG8_STAGE(PG8_SB(0, 0), b2, voffB);
            PG8_BAR; PG8_WAIT_L(0); PG8_MMA(0, 1, At, B1); PG8_BAR;
            PG8_LDA(At, 0, 1); PG8_STAGE(PG8_SA(0, 0), a2, voffA);
            PG8_BAR; PG8_WAIT_L(0); PG8_MMA(1, 0, At, B0); PG8_BAR; PG8_SCHED;
            PG8_STAGE(PG8_SB(0, 1), b2 + hstepB, voffB);
            PG8_WAIT_V(6); PG8_BAR; PG8_MMA(1, 1, At, B1); PG8_BAR;
            PG8_LDB(B0, 1, 0); PG8_SCHED; PG8_LDA(At, 1, 0); PG8_STAGE(PG8_SA(0, 1), a2 + hstep, voffA);
            PG8_WAIT_L(8); PG8_BAR; PG8_WAIT_L(0); PG8_MMA(0, 0, At, B0); PG8_BAR; PG8_SCHED;
            PG8_LDB(B1, 1, 1); PG8_STAGE(PG8_SB(1, 0), b3, voffB);
            PG8_BAR; PG8_WAIT_L(0); PG8_MMA(0, 1, At, B1); PG8_BAR;
            PG8_LDA(At, 1, 1); PG8_STAGE(PG8_SA(1, 0), a3, voffA);
            PG8_BAR; PG8_WAIT_L(0); PG8_MMA(1, 0, At, B0); PG8_BAR; PG8_SCHED;
            PG8_STAGE(PG8_SB(1, 1), b3 + hstepB, voffB);
            PG8_WAIT_V(6); PG8_BAR; PG8_MMA(1, 1, At, B1); PG8_BAR;
            }
        }
        if constexpr (ALIGN_EPI) { if (wr == 0) PG8_BAR; }
        if constexpr (!Epi::AFTER_DRAIN) { E(acc, cur, wr, wc, fr, fq); S.done(cur); }
        if (!has_next) break;
#pragma unroll
        for (int a = 0; a < 2; ++a)
#pragma unroll
            for (int b = 0; b < 2; ++b)
#pragma unroll
                for (int m = 0; m < 4; ++m)
#pragma unroll
                    for (int n = 0; n < 2; ++n) acc[a][b][m][n] = (f32x4){0.f, 0.f, 0.f, 0.f};
        cur = nxt; cA = nA; cB = nB; ++ui;
        if constexpr (ALIGN_EPI) { if (wr == 1) PG8_BAR; }
    }
    PG8_WAIT_V(0);
    if constexpr (!ALIGN_EPI) { if (wr == 0) PG8_BAR; }
    PG8_BAR;
    if constexpr (Epi::AFTER_DRAIN) { E.fused(acc, cur, wr, wc, fr, fq, lds, wid, lane); S.done(cur); }
#undef PG8_SA
#undef PG8_SB
#undef PG8_STAGE
#undef PG8_LDA
#undef PG8_LDB
#undef PG8_MMA
#undef PG8_WAIT_V
#undef PG8_WAIT_L
#undef PG8_BAR
#undef PG8_SCHED
}
}
namespace att {
#define ALAS __attribute__((address_space(3)))
typedef unsigned short bf16;
using bf16x8 = __attribute__((ext_vector_type(8))) short;
using s16x4  = __attribute__((ext_vector_type(4))) short;
using f32x16 = __attribute__((ext_vector_type(16))) float;
using f32x8  = __attribute__((ext_vector_type(8))) float;
using f32x4  = __attribute__((ext_vector_type(4))) float;
using u32x4  = __attribute__((ext_vector_type(4))) unsigned;
constexpr int D = 128, NW = 8, QBLK = 32, KVBLK = 64;
constexpr float SCALE = 0.088388347648318440f;
constexpr float LOG2E = 1.4426950408889634f, LN2 = 0.6931471805599453f;
constexpr float THR = 8.f;
constexpr int HW = 2048;
constexpr int DMODEL = 4096, TP = 8192;
constexpr float EPS = 1e-6f;
constexpr int SHM_V = KVBLK * D * 2, SHM_K = KVBLK * D * 2;
#define KSWZ(row, colB) ((row) * 256 + ((colB) ^ (((row) & 7) << 4)))
#define SBAR() __builtin_amdgcn_sched_barrier(0)
__device__ __forceinline__ int crow(int r, int hi) { return (r & 3) + 8 * (r >> 2) + 4 * hi; }
typedef float f32x2_cv __attribute__((ext_vector_type(2))); typedef __bf16 bf16x2_cv __attribute__((ext_vector_type(2)));
__device__ __forceinline__ unsigned cvtpk(float lo, float hi) { f32x2_cv v = {lo, hi}; bf16x2_cv b = __builtin_convertvector(v, bf16x2_cv); return __builtin_bit_cast(unsigned, b); }
__device__ __forceinline__ bf16x8 ld8bf(const bf16* p) { return *reinterpret_cast<const bf16x8*>(p); }
__device__ __forceinline__ f32x8 ld8f(const float* p) { return *reinterpret_cast<const f32x8*>(p); }
__device__ __forceinline__ bf16x8 tobf(f32x8 x) { u32x4 w = {cvtpk(x[0], x[1]), cvtpk(x[2], x[3]), cvtpk(x[4], x[5]), cvtpk(x[6], x[7])}; return *reinterpret_cast<bf16x8*>(&w); }
__device__ __forceinline__ bf16x8 ld8any(const bf16* p) { return ld8bf(p); }
__device__ __forceinline__ bf16x8 ld8any(const float* p) { return tobf(ld8f(p)); }
__device__ __forceinline__ float swap32(float x, int hi) {
    auto rr = __builtin_amdgcn_permlane32_swap(__float_as_uint(x), __float_as_uint(x), false, false);
    return __uint_as_float(hi ? rr[0] : rr[1]);
}

__device__ __forceinline__ void glds16(const void* gsrc, unsigned lds_dst) { unsigned keep;
  asm volatile("s_mov_b32 %0, m0\n\ts_mov_b32 m0, %2\n\ts_nop 0\n\tglobal_load_lds_dwordx4 %1, off\n\ts_mov_b32 m0, %0" : "=&s"(keep) : "v"(gsrc), "s"(lds_dst) : "memory"); }
__device__ __forceinline__ void partialSM(f32x16& p0, f32x16& p1, float& m_reg, float& mn, float& alpha, float msk = 0.f) {
  constexpr float C = SCALE * LOG2E;
  float pmax = p0[0];
#pragma unroll
  for (int r = 1; r < 16; ++r) pmax = fmaxf(pmax, p0[r]);
#pragma unroll
  for (int r = 0; r < 16; ++r) pmax = fmaxf(pmax, p1[r]);
  { auto rr = __builtin_amdgcn_permlane32_swap(__float_as_uint(pmax), __float_as_uint(pmax), false, false);
    pmax = fmaxf(__uint_as_float(rr[0]), __uint_as_float(rr[1])) + msk; }
  if (__builtin_expect(__all(pmax - m_reg <= THR / SCALE), 1)) { mn = m_reg; alpha = 1.f; }
  else { mn = fmaxf(m_reg, pmax); alpha = __builtin_amdgcn_exp2f((m_reg - mn) * C); m_reg = mn; }
  float mnC = -mn * C + msk;
#pragma unroll
  for (int r = 0; r < 16; ++r) p0[r] = fmaf(p0[r], C, mnC);
#pragma unroll
  for (int r = 0; r < 16; ++r) p1[r] = fmaf(p1[r], C, mnC);
#pragma unroll
  for (int r = 0; r < 16; ++r) p0[r] = __builtin_amdgcn_exp2f(p0[r]);
}
#define PK4(P, BASE, OUT) do { unsigned a0 = cvtpk(P[BASE + 0], P[BASE + 1]), a1 = cvtpk(P[BASE + 2], P[BASE + 3]);   \
    unsigned b0 = cvtpk(P[BASE + 4], P[BASE + 5]), b1 = cvtpk(P[BASE + 6], P[BASE + 7]);                              \
    auto r0 = __builtin_amdgcn_permlane32_swap(a0, b0, false, false); auto r1 = __builtin_amdgcn_permlane32_swap(a1, b1, false, false); \
    u32x4 w = {r0[0], r1[0], r0[1], r1[1]}; OUT = *reinterpret_cast<bf16x8*>(&w); } while (0)
__device__ __forceinline__ void finishSM(f32x16& p0, f32x16& p1, float alpha, float& l_reg, bf16x8& pa0, bf16x8& pa1, bf16x8& pa2, bf16x8& pa3) {
#pragma unroll
  for (int r = 0; r < 16; ++r) p1[r] = __builtin_amdgcn_exp2f(p1[r]);
  float ps = 0;
#pragma unroll
  for (int r = 0; r < 16; ++r) ps += p0[r];
#pragma unroll
  for (int r = 0; r < 16; ++r) ps += p1[r];
  { auto rr = __builtin_amdgcn_permlane32_swap(__float_as_uint(ps), __float_as_uint(ps), false, false);
    ps = __uint_as_float(rr[0]) + __uint_as_float(rr[1]); }
  l_reg = l_reg * alpha + ps;
  PK4(p0, 0, pa0); PK4(p0, 8, pa1); PK4(p1, 0, pa2); PK4(p1, 8, pa3);
}
__device__ __forceinline__ void qkt(f32x16& p0, f32x16& p1, const ALAS char* Ks, const bf16x8* qr, int r32, int hi) {
  p0 = f32x16{}; p1 = f32x16{};
#pragma unroll
  for (int d0 = 0; d0 < 8; ++d0) { int cb = (d0 * 16 + hi * 8) * 2;
    bf16x8 b0 = *reinterpret_cast<const ALAS bf16x8*>(Ks + KSWZ(r32, cb));
    bf16x8 b1 = *reinterpret_cast<const ALAS bf16x8*>(Ks + KSWZ(32 + r32, cb));
    p0 = __builtin_amdgcn_mfma_f32_32x32x16_bf16(b0, qr[d0], p0, 0, 0, 0);
    p1 = __builtin_amdgcn_mfma_f32_32x32x16_bf16(b1, qr[d0], p1, 0, 0, 0); }
}
template <int NQR>
__device__ __forceinline__ void qkt_h(f32x16& p0, f32x16& p1, const ALAS char* Ks, const bf16x8* qr, const ALAS char* Qs, int qrow, int r32, int hi) {
  p0 = f32x16{}; p1 = f32x16{};
#pragma unroll
  for (int d0 = 0; d0 < 8; ++d0) { int cb = (d0 * 16 + hi * 8) * 2;
    bf16x8 b0 = *reinterpret_cast<const ALAS bf16x8*>(Ks + KSWZ(r32, cb));
    bf16x8 b1 = *reinterpret_cast<const ALAS bf16x8*>(Ks + KSWZ(32 + r32, cb));
    bf16x8 q = d0 < NQR ? qr[d0] : *reinterpret_cast<const ALAS bf16x8*>(Qs + KSWZ(qrow, cb));
    p0 = __builtin_amdgcn_mfma_f32_32x32x16_bf16(b0, q, p0, 0, 0, 0);
    p1 = __builtin_amdgcn_mfma_f32_32x32x16_bf16(b1, q, p1, 0, 0, 0); }
}
__device__ __forceinline__ int v_st(int k, int c) { const int kk = (k & ~0xC) | ((k & 4) << 1) | ((k & 8) >> 1); return ((kk >> 3) * 4 + (c >> 5)) * 512 + ((kk & 7) * 32 + (c & 31)) * 2; }
__device__ __forceinline__ int v_rd_base(int lane) { return ((lane & 3) << 3) | (((lane >> 2) & 3) << 6) | (((lane >> 4) & 1) << 5) | (((lane >> 5) & 1) << 8); }
constexpr int v_rd_off(int d0, int ks, int half) { return d0 * 512 + ks * 4096 + half * 2048; }
template <int OFF> __device__ __forceinline__ s16x4 tr_read(int vb) {
  s16x4 r; asm volatile("ds_read_b64_tr_b16 %0, %1 offset:%2" : "=&v"(r) : "v"(vb), "i"(OFF) : "memory"); return r;
}
template <int D0> __device__ __forceinline__ void pv_one(f32x16& od, int vb, bf16x8 pa0, bf16x8 pa1, bf16x8 pa2, bf16x8 pa3) {
  const s16x4 l0 = tr_read<v_rd_off(D0, 0, 0)>(vb), h0 = tr_read<v_rd_off(D0, 0, 1)>(vb), l1 = tr_read<v_rd_off(D0, 1, 0)>(vb), h1 = tr_read<v_rd_off(D0, 1, 1)>(vb);
  const s16x4 l2 = tr_read<v_rd_off(D0, 2, 0)>(vb), h2 = tr_read<v_rd_off(D0, 2, 1)>(vb), l3 = tr_read<v_rd_off(D0, 3, 0)>(vb), h3 = tr_read<v_rd_off(D0, 3, 1)>(vb);
  asm volatile("s_waitcnt lgkmcnt(0)" ::: "memory"); SBAR();
#define PK(L, H) (bf16x8){L[0], L[1], L[2], L[3], H[0], H[1], H[2], H[3]}
  od = __builtin_amdgcn_mfma_f32_32x32x16_bf16(pa0, PK(l0, h0), od, 0, 0, 0);
  od = __builtin_amdgcn_mfma_f32_32x32x16_bf16(pa1, PK(l1, h1), od, 0, 0, 0);
  od = __builtin_amdgcn_mfma_f32_32x32x16_bf16(pa2, PK(l2, h2), od, 0, 0, 0);
  od = __builtin_amdgcn_mfma_f32_32x32x16_bf16(pa3, PK(l3, h3), od, 0, 0, 0);
#undef PK
}
__device__ __forceinline__ void pv_d0(f32x16* o, int vb, bf16x8 pa0, bf16x8 pa1, bf16x8 pa2, bf16x8 pa3) {
  pv_one<0>(o[0], vb, pa0, pa1, pa2, pa3); pv_one<1>(o[1], vb, pa0, pa1, pa2, pa3); pv_one<2>(o[2], vb, pa0, pa1, pa2, pa3); pv_one<3>(o[3], vb, pa0, pa1, pa2, pa3);
}
__device__ __forceinline__ void fill_neg(f32x16& p0, f32x16& p1) {
#pragma unroll
  for (int r = 0; r < 16; ++r) { p0[r] = -1e30f; p1[r] = -1e30f; }
}

constexpr int SHM_QOFF = 2 * SHM_V + 2 * SHM_K + NW * 64 * 4, SHM_ATTN = SHM_QOFF + 256 * 256;
constexpr int NQR = 8;
__device__ __forceinline__ void attnA_prompt_unit(int wv, int vh, int qb, const bf16* __restrict__ AQ, const bf16* __restrict__ AK, const bf16* __restrict__ AV, float* __restrict__ OA, ALAS char* lds) {
  int tid = wv * 64 + lane_id(); asm volatile("" : "+v"(tid));
  const int wid = __builtin_amdgcn_readfirstlane(tid >> 6), lane = tid & 63, r32 = lane & 31, hi = lane >> 5;
  const int h = vh >> 2, c = (vh >> 1) & 1, vhalf = vh & 1;
  const bf16* Qb = AQ + (size_t)(qb * 256) * HW + h * 256 + c * 128;
  const bf16* Kh = AK + h * 256 + c * 128;
  const bf16* Vh = AV + h * 256 + vhalf * 128;
  float* Ob = OA + (size_t)(qb * 256) * DMODEL + h * 512 + c * 256 + vhalf * 128;
  const int NT = 4 * qb + 4, jmax = 4 * qb + (wid >> 1);
  ALAS char* V_lds = lds; ALAS char* K_lds = lds + 2 * SHM_V;
  ALAS float* ws = (ALAS float*)(lds + 2 * SHM_V + 2 * SHM_K) + wid * 64; ALAS float* li_l = ws; ALAS float* al_l = ws + 32;
  float m_reg = -1e30f, l_reg = 0; f32x16 o[4] = {}; bf16x8 qr[NQR];
  const bf16* Qw = Qb + (size_t)(wid * QBLK + r32) * HW + hi * 8;
  ALAS char* Q_lds = lds + SHM_QOFF; const int qrow = wid * QBLK + r32;
#pragma unroll
  for (int d0 = 0; d0 < 8; ++d0) { const bf16x8 q = ld8bf(Qw + d0 * 16); if (d0 < NQR) qr[d0] = q; else *(ALAS bf16x8*)(Q_lds + KSWZ(qrow, (d0 * 16 + hi * 8) * 2)) = q; }
  const int sr = tid >> 4, sc = (tid & 15) * 8, vst0 = v_st(sr, sc), vst1 = v_st(32 + sr, sc);
  const int vb0 = (int)(unsigned)(uintptr_t)V_lds + v_rd_base(lane);
  constexpr int SDEPTH = 1;
  struct { bf16x8 vs0, vs1, ks0, ks1; } sr_[SDEPTH];
  const unsigned lo0 = (unsigned)(sr * HW + sc) * 2u, lo1 = lo0 + 32u * HW * 2u;
#define SLOAD(i, k0) do { const char* kb_ = (const char*)Kh + (size_t)(k0) * (HW * 2); const char* vb_ = (const char*)Vh + (size_t)(k0) * (HW * 2); \
    sr_[i].vs0 = *(const bf16x8*)(vb_ + lo0); sr_[i].vs1 = *(const bf16x8*)(vb_ + lo1); sr_[i].ks0 = *(const bf16x8*)(kb_ + lo0); sr_[i].ks1 = *(const bf16x8*)(kb_ + lo1); } while (0)
#define SWRITE(b, i) do { *(ALAS bf16x8*)(V_lds + (b) * SHM_V + vst0) = sr_[i].vs0;          \
    *(ALAS bf16x8*)(V_lds + (b) * SHM_V + vst1) = sr_[i].vs1; int kc = sc * 2;               \
    *(ALAS bf16x8*)(K_lds + (b) * SHM_K + KSWZ(sr, kc)) = sr_[i].ks0;                       \
    *(ALAS bf16x8*)(K_lds + (b) * SHM_K + KSWZ(32 + sr, kc)) = sr_[i].ks1; } while (0)
#define SWAIT() do { if constexpr (SDEPTH == 2) asm volatile("s_waitcnt vmcnt(4)" ::: "memory"); else asm volatile("s_waitcnt vmcnt(0)" ::: "memory"); } while (0)
#define RESC(a) do { if (__any((a) < 1.f)) { if (hi == 0) al_l[r32] = (a); asm volatile("s_waitcnt lgkmcnt(0)" ::: "memory"); \
    _Pragma("unroll") for (int d = 0; d < 4; ++d) _Pragma("unroll") for (int r = 0; r < 16; ++r) o[d][r] *= al_l[crow(r, hi)]; } } while (0)
#define QKT_M(P0, P1, KS, j) qkt_h<NQR>(P0, P1, KS, qr, Q_lds, qrow, r32, hi)
#define MSK(j) (((j) <= jmax) ? 0.f : -1e30f)
  f32x16 pA0, pA1, pB0, pB1; float mnA, mnB, alA, alB; bf16x8 pa0, pa1, pa2, pa3;
  constexpr int SE = 0, SO = SDEPTH - 1;
  SLOAD(SE, 0); asm volatile("s_waitcnt vmcnt(0)" ::: "memory"); SWRITE(0, SE); __syncthreads();
  QKT_M(pA0, pA1, K_lds, 0); partialSM(pA0, pA1, m_reg, mnA, alA);
  SLOAD(SO, KVBLK); if constexpr (SDEPTH == 2) { if (2 < NT) SLOAD(SE, 2 * KVBLK); }
  SWAIT(); SWRITE(1, SO); __syncthreads();
  for (int j = 1; j + 1 < NT; j += 2) {
    SBAR(); QKT_M(pB0, pB1, K_lds + SHM_K, j);
    finishSM(pA0, pA1, alA, l_reg, pa0, pa1, pa2, pa3); SBAR();
    SLOAD(SO, (j + SDEPTH) * KVBLK); SBAR();
    pv_d0(o, vb0, pa0, pa1, pa2, pa3); partialSM(pB0, pB1, m_reg, mnB, alB, MSK(j));
    __syncthreads(); SWAIT(); SWRITE(0, SE);
    RESC(alB); __syncthreads();
    SBAR(); QKT_M(pA0, pA1, K_lds, j + 1);
    finishSM(pB0, pB1, alB, l_reg, pa0, pa1, pa2, pa3); SBAR();
    if (SDEPTH == 1 || j + 3 < NT) SLOAD(SE, (j + 1 + SDEPTH) * KVBLK); SBAR();
    pv_d0(o, vb0 + SHM_V, pa0, pa1, pa2, pa3); partialSM(pA0, pA1, m_reg, mnA, alA, MSK(j + 1));
    __syncthreads(); SWAIT(); SWRITE(1, SO);
    RESC(alA); __syncthreads();
  }
  SBAR(); QKT_M(pB0, pB1, K_lds + SHM_K, NT - 1);
  finishSM(pA0, pA1, alA, l_reg, pa0, pa1, pa2, pa3); SBAR();
  pv_d0(o, vb0, pa0, pa1, pa2, pa3); partialSM(pB0, pB1, m_reg, mnB, alB, MSK(NT - 1));
  __syncthreads(); RESC(alB);
  finishSM(pB0, pB1, alB, l_reg, pa0, pa1, pa2, pa3); SBAR();
  pv_d0(o, vb0 + SHM_V, pa0, pa1, pa2, pa3);
  if (hi == 0) li_l[r32] = l_reg; asm volatile("s_waitcnt lgkmcnt(0)" ::: "memory");
  float rli[16];
#pragma unroll
  for (int r = 0; r < 16; ++r) rli[r] = __builtin_amdgcn_rcpf(li_l[crow(r, hi)]);
  float* Ow = Ob + (size_t)(wid * QBLK) * DMODEL;
#pragma unroll
  for (int r = 0; r < 16; ++r) { int orow = crow(r, hi);
#pragma unroll
    for (int d0 = 0; d0 < 4; ++d0) Ow[(size_t)orow * DMODEL + d0 * 32 + r32] = o[d0][r] * rli[r]; }
  __syncthreads();
#undef SLOAD
#undef SWRITE
#undef SWAIT
#undef QKT_M
#undef MSK
}

constexpr int X_KB = 0, X_VB = 32768, X_WS = 131072, X_LDS = X_WS + NW * 64 * 4;
__device__ __forceinline__ void attnA_prompt_unit2(int wv, int h, int qb, const bf16* __restrict__ AQ, const bf16* __restrict__ AK, const bf16* __restrict__ AV, float lam, const float* __restrict__ g_subln, float post,
                                                   bf16* __restrict__ O, ALAS char* lds) {
  int tid = wv * 64 + lane_id(); asm volatile("" : "+v"(tid));
  const int wid = __builtin_amdgcn_readfirstlane(tid >> 6), lane = tid & 63, r32 = lane & 31, hi = lane >> 5;
  const int c = wid >> 2, wq = wid & 3;
  const int NT = 4 * qb + 4, jmax = 4 * qb + 2 * (wq >> 1) + 1;
  ALAS float* ws = (ALAS float*)(lds + X_WS) + wid * 64; ALAS float* li_l = ws; ALAS float* al_l = ws + 32;
  bf16x8 qr[8];
  { const bf16* Qw = AQ + (size_t)(qb * 128 + wq * 32) * HW + h * 256 + c * 128; const unsigned qo = (unsigned)(r32 * HW + hi * 8) * 2u;
#pragma unroll
    for (int d0 = 0; d0 < 8; ++d0) qr[d0] = *(const bf16x8*)((const char*)Qw + qo + d0 * 32);
#pragma unroll
    for (int d0 = 0; d0 < 8; ++d0) asm volatile("" : "+v"(qr[d0])); }
  const char* Kg = (const char*)(AK + h * 256); const char* Vg = (const char*)(AV + h * 256);
  unsigned koff, voff;
  { const int row = 4 * wid + (lane >> 4), cs = lane & 15; koff = (unsigned)(row * (HW * 2) + ((cs ^ (row & 7)) * 16));
    const int sub = 2 * wid + (lane >> 5), kk = (sub >> 2) * 8 + ((lane & 31) >> 2), k = (kk & ~0xC) | ((kk & 4) << 1) | ((kk & 8) >> 1), c8 = (sub & 3) * 4 + (lane & 3);
    voff = (unsigned)(k * (HW * 2) + c8 * 16); }
  const unsigned lds0 = (unsigned)(uintptr_t)lds;
#define X_DMA(j) do { const size_t to_ = (size_t)(j) * (32 * HW * 2); const unsigned sl_ = (unsigned)__builtin_amdgcn_readfirstlane((int)(lds0 + ((j) & 3) * 32768 + wid * 1024)); \
    glds16(Kg + to_ + koff, sl_); glds16(Kg + to_ + 256 + koff, sl_ + 8192); glds16(Vg + to_ + voff, sl_ + 16384); glds16(Vg + to_ + 256 + voff, sl_ + 24576); } while (0)
  float m_reg = -1e30f, l_reg = 0.f; f32x16 o[8] = {};
  constexpr float C = SCALE * LOG2E;
  bf16x8 pa0, pa1;
#define X_BAR() asm volatile("s_waitcnt lgkmcnt(0)\n\ts_barrier" ::: "memory")
#define X_QK(j) \
    f32x16 p = {}; \
    { const ALAS char* Ks = lds + ((j) & 3) * 32768 + c * 8192; f32x16 p2 = {}; \
      _Pragma("unroll") for (int d0 = 0; d0 < 8; d0 += 2) { const bf16x8 kf = *reinterpret_cast<const ALAS bf16x8*>(Ks + KSWZ(r32, (d0 * 16 + hi * 8) * 2)); const bf16x8 kg = *reinterpret_cast<const ALAS bf16x8*>(Ks + KSWZ(r32, ((d0 + 1) * 16 + hi * 8) * 2)); \
        p = __builtin_amdgcn_mfma_f32_32x32x16_bf16(kf, qr[d0], p, 0, 0, 0); p2 = __builtin_amdgcn_mfma_f32_32x32x16_bf16(kg, qr[d0 + 1], p2, 0, 0, 0); } \
      _Pragma("unroll") for (int r = 0; r < 16; ++r) p[r] += p2[r]; } \
    const float msk = ((j) <= jmax) ? 0.f : -1e30f; \
    float pmax = p[0]; \
    _Pragma("unroll") for (int r = 1; r < 16; ++r) pmax = fmaxf(pmax, p[r]); \
    { auto rr = __builtin_amdgcn_permlane32_swap(__float_as_uint(pmax), __float_as_uint(pmax), false, false); pmax = fmaxf(__uint_as_float(rr[0]), __uint_as_float(rr[1])) + msk; } \
    float mn, alpha; bool resc = false; \
    if (__builtin_expect(__all(pmax - m_reg <= THR / SCALE), 1)) { mn = m_reg; alpha = 1.f; } \
    else { mn = fmaxf(m_reg, pmax); alpha = __builtin_amdgcn_exp2f((m_reg - mn) * C); m_reg = mn; resc = true; } \
    const float mnC = -mn * C + msk; float ps = 0.f;
#define X_EXP2(r0) do { p[r0] = __builtin_amdgcn_exp2f(fmaf(p[r0], C, mnC)); p[(r0) + 1] = __builtin_amdgcn_exp2f(fmaf(p[(r0) + 1], C, mnC)); ps += p[r0]; ps += p[(r0) + 1]; } while (0)
#define X_FIN() do { \
    { auto rr = __builtin_amdgcn_permlane32_swap(__float_as_uint(ps), __float_as_uint(ps), false, false); ps = __uint_as_float(rr[0]) + __uint_as_float(rr[1]); } \
    l_reg = l_reg * alpha + ps; \
    if (resc) { if (hi == 0) al_l[r32] = alpha; asm volatile("s_waitcnt lgkmcnt(0)" ::: "memory"); \
      _Pragma("unroll") for (int d = 0; d < 8; ++d) _Pragma("unroll") for (int r = 0; r < 16; ++r) o[d][r] *= al_l[crow(r, hi)]; } \
    PK4(p, 0, pa0); PK4(p, 8, pa1); } while (0)
#define X_RD4(A, IMG, D0) do { A[0] = tr_read<(IMG) * 8192 + v_rd_off(D0, 0, 0)>(vb); A[1] = tr_read<(IMG) * 8192 + v_rd_off(D0, 0, 1)>(vb); A[2] = tr_read<(IMG) * 8192 + v_rd_off(D0, 1, 0)>(vb); A[3] = tr_read<(IMG) * 8192 + v_rd_off(D0, 1, 1)>(vb); } while (0)
#define X_MM2(D8, A) do { o[D8] = __builtin_amdgcn_mfma_f32_32x32x16_bf16(pa0, (bf16x8){A[0][0], A[0][1], A[0][2], A[0][3], A[1][0], A[1][1], A[1][2], A[1][3]}, o[D8], 0, 0, 0); \
        o[D8] = __builtin_amdgcn_mfma_f32_32x32x16_bf16(pa1, (bf16x8){A[2][0], A[2][1], A[2][2], A[2][3], A[3][0], A[3][1], A[3][2], A[3][3]}, o[D8], 0, 0, 0); } while (0)
#define X_W(n) do { asm volatile("s_waitcnt lgkmcnt(" #n ")" ::: "memory"); SBAR(); } while (0)
  X_DMA(0); X_DMA(1);
  {
    asm volatile("s_waitcnt vmcnt(4)" ::: "memory"); X_BAR(); X_DMA(2);
    X_QK(0)
    X_EXP2(0); X_EXP2(2); X_EXP2(4); X_EXP2(6); X_EXP2(8); X_EXP2(10); X_EXP2(12); X_EXP2(14);
    X_FIN(); }
  for (int j = 1; j < NT; ++j) {
    if (j + 1 < NT) asm volatile("s_waitcnt vmcnt(4)" ::: "memory"); else asm volatile("s_waitcnt vmcnt(0)" ::: "memory");
    X_BAR();
    if (j + 2 < NT) X_DMA(j + 2);
    X_QK(j)
    SBAR();
    { const int vb = (int)(unsigned)(uintptr_t)(lds + ((j - 1) & 3) * 32768 + 16384) + v_rd_base(lane);
      s16x4 va[4], vc[4];
      X_RD4(va, 0, 0); X_RD4(vc, 0, 1); X_W(4); X_MM2(0, va); X_EXP2(0); SBAR();
      X_RD4(va, 0, 2); X_W(4); X_MM2(1, vc); X_EXP2(2); SBAR();
      X_RD4(vc, 0, 3); X_W(4); X_MM2(2, va); X_EXP2(4); SBAR();
      X_RD4(va, 1, 0); X_W(4); X_MM2(3, vc); X_EXP2(6); SBAR();
      X_RD4(vc, 1, 1); X_W(4); X_MM2(4, va); X_EXP2(8); SBAR();
      X_RD4(va, 1, 2); X_W(4); X_MM2(5, vc); X_EXP2(10); SBAR();
      X_RD4(vc, 1, 3); X_W(4); X_MM2(6, va); X_EXP2(12); SBAR();
      X_W(0); X_MM2(7, vc); X_EXP2(14); SBAR(); }
    X_FIN();
  }
  {
    const int vb = (int)(unsigned)(uintptr_t)(lds + ((NT - 1) & 3) * 32768 + 16384) + v_rd_base(lane);
    s16x4 va[4], vc[4];
    X_RD4(va, 0, 0); X_RD4(vc, 0, 1); X_W(4); X_MM2(0, va); SBAR();
    X_RD4(va, 0, 2); X_W(4); X_MM2(1, vc); SBAR();
    X_RD4(vc, 0, 3); X_W(4); X_MM2(2, va); SBAR();
    X_RD4(va, 1, 0); X_W(4); X_MM2(3, vc); SBAR();
    X_RD4(vc, 1, 1); X_W(4); X_MM2(4, va); SBAR();
    X_RD4(va, 1, 2); X_W(4); X_MM2(5, vc); SBAR();
    X_RD4(vc, 1, 3); X_W(4); X_MM2(6, va); SBAR();
    X_W(0); X_MM2(7, vc); SBAR(); }
#undef X_BAR
#undef X_QK
#undef X_EXP2
#undef X_FIN
#undef X_RD4
#undef X_MM2
#undef X_W
  __syncthreads();
  if (hi == 0) li_l[r32] = l_reg; asm volatile("s_waitcnt lgkmcnt(0)" ::: "memory");
  float rli[16];
#pragma unroll
  for (int r = 0; r < 16; ++r) rli[r] = __builtin_amdgcn_rcpf(li_l[crow(r, hi)]);
  ALAS float* XL = (ALAS float*)(lds) + wq * 8192;
  if (c == 1) {
#pragma unroll
    for (int r = 0; r < 16; ++r) { const float f = rli[r] * lam;
#pragma unroll
      for (int d = 0; d < 8; ++d) XL[crow(r, hi) * 256 + d * 32 + r32] = o[d][r] * f; }
  }
  __syncthreads();
  if (c == 0) {
    float gs[8];
#pragma unroll
    for (int d = 0; d < 8; ++d) gs[d] = g_subln[d * 32 + r32] * post;
#pragma unroll
    for (int r = 0; r < 16; ++r) { const int q = crow(r, hi); float ss = 0.f;
#pragma unroll
      for (int d = 0; d < 8; ++d) { const float v = o[d][r] * rli[r] - XL[q * 256 + d * 32 + r32]; o[d][r] = v; ss += v * v; }
#pragma unroll
      for (int m = 1; m < 32; m <<= 1) ss += __shfl_xor(ss, m);
      const float rs = __builtin_amdgcn_rsqf(ss * (1.0f / 256.0f) + EPS);
#pragma unroll
      for (int d = 0; d < 8; ++d) o[d][r] *= rs * gs[d]; }
    asm volatile("s_waitcnt lgkmcnt(0)" ::: "memory");
    ALAS bf16* stg = (ALAS bf16*)XL;
#pragma unroll
    for (int r = 0; r < 16; ++r) { const int q = crow(r, hi);
#pragma unroll
      for (int d = 0; d < 8; ++d) stg[q * 256 + d * 32 + r32] = (bf16)(cvtpk(o[d][r], 0.f) & 0xffffu); }
    asm volatile("s_waitcnt lgkmcnt(0)" ::: "memory");
    bf16* Ow = O + (size_t)(qb * 128 + wq * 32) * DMODEL + h * 256;
#pragma unroll
    for (int i = 0; i < 16; ++i) { const int id = i * 64 + lane, row = id >> 5, ch = id & 31; const u32x4 v = *(const ALAS u32x4*)(stg + row * 256 + ch * 8); *(u32x4*)(Ow + (size_t)row * DMODEL + ch * 8) = v; }
    asm volatile("s_waitcnt lgkmcnt(0)" ::: "memory");
  }
  __syncthreads();
#undef X_DMA
}

constexpr int SA_KB = 0, SA_VB = 65536, SA_WS = 131072, SA_LDS = SA_WS + NW * 64 * 4;
__device__ __forceinline__ void attnA_sample_unit(int wv, int b, int h, const float* __restrict__ cak, const float* __restrict__ cav, const float* __restrict__ nak, const float* __restrict__ nav,
                                                  const bf16* __restrict__ AQ, float lam, const float* __restrict__ g_subln, float post, bf16* __restrict__ O, ALAS char* lds) {
  int tid = wv * 64 + lane_id(); asm volatile("" : "+v"(tid));
  const int wid = __builtin_amdgcn_readfirstlane(tid >> 6), lane = tid & 63, r32 = lane & 31, hi = lane >> 5;
  const int c = wid & 1, vq = wid >> 1;
  ALAS float* ws = (ALAS float*)(lds + SA_WS) + wid * 64; ALAS float* li_l = ws; ALAS float* al_l = ws + 32;
  bf16x8 qr[8];
  { const bf16* Qw = AQ + (size_t)(TP + b * 16 + (r32 & 15)) * HW + h * 256 + c * 128 + hi * 8;
#pragma unroll
    for (int d0 = 0; d0 < 8; ++d0) qr[d0] = ld8bf(Qw + d0 * 16); }
  const int sr = tid >> 3, sk = (tid & 7) * 16, sv = (tid & 7) * 32;
  f32x8 kreg[4], vreg[4];
#define SA_LOAD(j) do { if ((j) < 32) { const size_t ro = ((size_t)(b * 2048 + (j) * 64 + sr) * 8 + h) * 256; \
      kreg[0] = ld8f(cak + ro + sk); kreg[1] = ld8f(cak + ro + sk + 8); kreg[2] = ld8f(cak + ro + 128 + sk); kreg[3] = ld8f(cak + ro + 128 + sk + 8); \
      vreg[0] = ld8f(cav + ro + sv); vreg[1] = ld8f(cav + ro + sv + 8); vreg[2] = ld8f(cav + ro + sv + 16); vreg[3] = ld8f(cav + ro + sv + 24); } \
    else if (sr < 16) { const size_t ro = ((size_t)(b * 16 + sr) * 8 + h) * 256; \
      kreg[0] = ld8f(nak + ro + sk); kreg[1] = ld8f(nak + ro + sk + 8); kreg[2] = ld8f(nak + ro + 128 + sk); kreg[3] = ld8f(nak + ro + 128 + sk + 8); \
      vreg[0] = ld8f(nav + ro + sv); vreg[1] = ld8f(nav + ro + sv + 8); vreg[2] = ld8f(nav + ro + sv + 16); vreg[3] = ld8f(nav + ro + sv + 24); } \
    else { _Pragma("unroll") for (int i_ = 0; i_ < 4; ++i_) { kreg[i_] = f32x8{}; vreg[i_] = f32x8{}; } } } while (0)
#define SA_WRITE(buf) do { ALAS char* kb_ = lds + SA_KB + (buf) * 32768; ALAS char* vb_ = lds + SA_VB + (buf) * 32768 + (sv >> 7) * 16384; const int cv_ = sv & 127; \
    *(ALAS bf16x8*)(kb_ + KSWZ(sr, sk * 2)) = tobf(kreg[0]); *(ALAS bf16x8*)(kb_ + KSWZ(sr, (sk + 8) * 2)) = tobf(kreg[1]); \
    *(ALAS bf16x8*)(kb_ + 16384 + KSWZ(sr, sk * 2)) = tobf(kreg[2]); *(ALAS bf16x8*)(kb_ + 16384 + KSWZ(sr, (sk + 8) * 2)) = tobf(kreg[3]); \
    *(ALAS bf16x8*)(vb_ + v_st(sr, cv_)) = tobf(vreg[0]); *(ALAS bf16x8*)(vb_ + v_st(sr, cv_ + 8)) = tobf(vreg[1]); \
    *(ALAS bf16x8*)(vb_ + v_st(sr, cv_ + 16)) = tobf(vreg[2]); *(ALAS bf16x8*)(vb_ + v_st(sr, cv_ + 24)) = tobf(vreg[3]); } while (0)
  float m_reg = -1e30f, l_reg = 0.f; f32x16 o[2] = {};
  SA_LOAD(0); asm volatile("s_waitcnt vmcnt(0)" ::: "memory"); SA_WRITE(0); __syncthreads();
  for (int j = 0; j <= 32; ++j) {
    const int buf = j & 1;
    if (j < 32) SA_LOAD(j + 1);
    f32x16 p0, p1; float mn, alpha; bf16x8 pa0, pa1, pa2, pa3;
    qkt(p0, p1, lds + SA_KB + buf * 32768 + c * 16384, qr, r32, hi);
    if (j == 32) {
#pragma unroll
      for (int r = 0; r < 16; ++r) { if (crow(r, hi) >= 16) p0[r] = -1e30f; p1[r] = -1e30f; }
    }
    partialSM(p0, p1, m_reg, mn, alpha);
    if (__any(alpha < 1.f)) { if (hi == 0) al_l[r32] = alpha; asm volatile("s_waitcnt lgkmcnt(0)" ::: "memory");
#pragma unroll
      for (int d = 0; d < 2; ++d)
#pragma unroll
        for (int r = 0; r < 16; ++r) o[d][r] *= al_l[crow(r, hi)]; }
    finishSM(p0, p1, alpha, l_reg, pa0, pa1, pa2, pa3); SBAR();
    const int vb = (int)(unsigned)(uintptr_t)(lds + SA_VB + buf * 32768 + (vq >> 1) * 16384) + v_rd_base(lane);
    if (vq & 1) { pv_one<2>(o[0], vb, pa0, pa1, pa2, pa3); pv_one<3>(o[1], vb, pa0, pa1, pa2, pa3); }
    else        { pv_one<0>(o[0], vb, pa0, pa1, pa2, pa3); pv_one<1>(o[1], vb, pa0, pa1, pa2, pa3); }
    if (j < 32) { asm volatile("s_waitcnt vmcnt(0)" ::: "memory"); SA_WRITE(buf ^ 1); }
    __syncthreads();
  }
  if (hi == 0) li_l[r32] = l_reg; asm volatile("s_waitcnt lgkmcnt(0)" ::: "memory");
  ALAS float* OL = (ALAS float*)(lds + SA_KB);
#pragma unroll
  for (int r = 0; r < 8; ++r) { const int q = crow(r, hi); const float rl = __builtin_amdgcn_rcpf(li_l[q]);
#pragma unroll
    for (int dd = 0; dd < 2; ++dd) OL[(c * 16 + q) * 256 + vq * 64 + dd * 32 + r32] = o[dd][r] * rl; }
  __syncthreads();
  { const int q = tid >> 5, e0 = (tid & 31) * 8; float dv[8]; float ss = 0.f;
#pragma unroll
    for (int i = 0; i < 8; ++i) { dv[i] = OL[q * 256 + e0 + i] - lam * OL[(16 + q) * 256 + e0 + i]; ss += dv[i] * dv[i]; }
#pragma unroll
    for (int m = 1; m < 32; m <<= 1) ss += __shfl_xor(ss, m);
    const float rs = __builtin_amdgcn_rsqf(ss * (1.0f / 256.0f) + EPS) * post;
    u32x4 w; w.x = cvtpk(dv[0] * rs * g_subln[e0 + 0], dv[1] * rs * g_subln[e0 + 1]); w.y = cvtpk(dv[2] * rs * g_subln[e0 + 2], dv[3] * rs * g_subln[e0 + 3]);
    w.z = cvtpk(dv[4] * rs * g_subln[e0 + 4], dv[5] * rs * g_subln[e0 + 5]); w.w = cvtpk(dv[6] * rs * g_subln[e0 + 6], dv[7] * rs * g_subln[e0 + 7]);
    *(u32x4*)(O + (size_t)(TP + b * 16 + q) * DMODEL + h * 256 + e0) = w; }
  __syncthreads();
#undef SA_LOAD
#undef SA_WRITE
}

constexpr float SB_STOP = -104.0f;
__device__ __forceinline__ float softplus_f(float z) {
  const float e = __builtin_amdgcn_exp2f(-fabsf(z) * LOG2E);
  return fmaxf(z, 0.f) + LN2 * __builtin_amdgcn_logf(1.0f + e);
}
__device__ __forceinline__ void stick_half(f32x16& p, float& carry, int kbase, int kpos0, int qpos, int nvalid, bool need_mask, int hi) {
  float x[16];
#pragma unroll
  for (int r = 0; r < 16; ++r) {
    const float z = p[r] * SCALE; const float sp = softplus_f(z);
    bool ok = true;
    if (need_mask) { const int kl = kbase + crow(r, hi); ok = (kpos0 + kl < qpos) && (kl < nvalid); }
    x[r] = ok ? -sp : 0.f;
    p[r] = ok ? z - sp : -1e30f;
    if ((r & 3) == 3) SBAR();
  }
  float own[4], par[4], T[4], R[4];
#pragma unroll
  for (int g = 0; g < 4; ++g) { own[g] = (x[4 * g] + x[4 * g + 1]) + (x[4 * g + 2] + x[4 * g + 3]); par[g] = swap32(own[g], hi); T[g] = own[g] + par[g]; }
  R[3] = 0.f; R[2] = T[3]; R[1] = R[2] + T[2]; R[0] = R[1] + T[1];
#pragma unroll
  for (int g = 0; g < 4; ++g) {
    const float E = carry + R[g] + (hi == 0 ? par[g] : 0.f);
    const float w2 = x[4 * g + 3], w1 = w2 + x[4 * g + 2], w0 = w1 + x[4 * g + 1];
    p[4 * g + 3] = __builtin_amdgcn_exp2f((p[4 * g + 3] + E) * LOG2E); p[4 * g + 2] = __builtin_amdgcn_exp2f((p[4 * g + 2] + E + w2) * LOG2E);
    p[4 * g + 1] = __builtin_amdgcn_exp2f((p[4 * g + 1] + E + w1) * LOG2E); p[4 * g + 0] = __builtin_amdgcn_exp2f((p[4 * g + 0] + E + w0) * LOG2E);
    SBAR();
  }
  carry += R[0] + T[0];
}
template <typename TS>
__device__ __forceinline__ void stick_tile(f32x16 (&o)[4], float& carry, const bf16* __restrict__ Qw, const TS* __restrict__ Kt, const TS* __restrict__ Vt, int stride, int nvalid, int kpos0, int qpos,
                                           bool need_mask, ALAS char* vbuf, int lane, int r32, int hi) {
  constexpr bool SRC16 = sizeof(TS) == 2;
  f32x16 p0 = {}, p1 = {};
  { const int k0 = r32 < nvalid ? r32 : nvalid - 1, k1 = (32 + r32) < nvalid ? (32 + r32) : nvalid - 1;
    const TS* K0 = Kt + (size_t)k0 * stride + hi * 8; const TS* K1 = Kt + (size_t)k1 * stride + hi * 8;
    bf16x8 kf0[8], kf1[8], qr[8];
#pragma unroll
    for (int d0 = 0; d0 < 8; ++d0) qr[d0] = ld8bf(Qw + d0 * 16);
#pragma unroll
    for (int d0 = 0; d0 < 8; ++d0) kf0[d0] = ld8any(K0 + d0 * 16);
    if constexpr (SRC16) {
#pragma unroll
      for (int d0 = 0; d0 < 8; ++d0) kf1[d0] = ld8any(K1 + d0 * 16);
    }
#pragma unroll
    for (int d0 = 0; d0 < 8; ++d0) p0 = __builtin_amdgcn_mfma_f32_32x32x16_bf16(kf0[d0], qr[d0], p0, 0, 0, 0);
    if constexpr (!SRC16) {
      asm volatile("" ::: "memory");
#pragma unroll
      for (int d0 = 0; d0 < 8; ++d0) kf1[d0] = ld8any(K1 + d0 * 16);
    }
#pragma unroll
    for (int d0 = 0; d0 < 8; ++d0) p1 = __builtin_amdgcn_mfma_f32_32x32x16_bf16(kf1[d0], qr[d0], p1, 0, 0, 0);
  }
  asm volatile("" ::: "memory"); SBAR();
  const unsigned vsrc_off = (unsigned)(((lane >> 4) * stride + (lane & 15) * 8) * (int)sizeof(TS));
  const int vdst_off = (((lane & 15) * 8) >> 5) * 512 + ((lane >> 4) * 32 + (((lane & 15) * 8) & 31)) * 2;
  const int nvc = nvalid >> 2;
#define VSRC(i) ((const char*)Vt + (size_t)(((i) < nvc ? (i) : nvc - 1) * 4) * stride * sizeof(TS) + vsrc_off)
#define VDST(i) (vbuf + vdst_off + ((((i) & 1) + 2 * ((i) >> 2)) * 2048 + (((i) >> 1) & 1) * 256))
  bf16x8 vtb[16]; f32x8 vtf[4];
  if constexpr (SRC16) {
#pragma unroll
    for (int i = 0; i < 16; ++i) vtb[i] = *(const bf16x8*)VSRC(i);
  } else {
#pragma unroll
    for (int i = 0; i < 4; ++i) vtf[i] = *(const f32x8*)VSRC(i);
  }
  SBAR();
  bf16x8 pa0, pa1, pa2, pa3;
  stick_half(p1, carry, 32, kpos0, qpos, nvalid, need_mask, hi);
  PK4(p1, 0, pa2); PK4(p1, 8, pa3);
  stick_half(p0, carry, 0, kpos0, qpos, nvalid, need_mask, hi);
  PK4(p0, 0, pa0); PK4(p0, 8, pa1);
  if constexpr (SRC16) {
#pragma unroll
    for (int i = 0; i < 16; ++i) *(ALAS bf16x8*)VDST(i) = vtb[i];
  } else {
#pragma unroll
    for (int i = 0; i < 4; ++i) *(ALAS bf16x8*)VDST(i) = tobf(vtf[i]);
#pragma unroll
    for (int bt = 1; bt < 4; ++bt) {
#pragma unroll
      for (int i = 0; i < 4; ++i) vtf[i] = *(const f32x8*)VSRC(4 * bt + i);
#pragma unroll
      for (int i = 0; i < 4; ++i) *(ALAS bf16x8*)VDST(4 * bt + i) = tobf(vtf[i]);
    }
  }
#undef VSRC
#undef VDST
  asm volatile("s_waitcnt lgkmcnt(0)" ::: "memory"); SBAR();
  const int vb = (int)(unsigned)(uintptr_t)vbuf + v_rd_base(lane);
  pv_d0(o, vb, pa0, pa1, pa2, pa3);
}
__device__ __forceinline__ void stick_store(const f32x16 (&o)[4], const float* __restrict__ g_sb, bf16* __restrict__ Orow0, int nrows, ALAS char* vbuf, int lane, int r32, int hi) {
  float gs[4];
#pragma unroll
  for (int d0 = 0; d0 < 4; ++d0) gs[d0] = g_sb[d0 * 32 + r32];
  ALAS bf16* stg = (ALAS bf16*)vbuf;
#pragma unroll
  for (int r = 0; r < 16; ++r) {
    float ss = (o[0][r] * o[0][r] + o[1][r] * o[1][r]) + (o[2][r] * o[2][r] + o[3][r] * o[3][r]);
#pragma unroll
    for (int m = 1; m < 32; m <<= 1) ss += __shfl_xor(ss, m);
    const float rs = __builtin_amdgcn_rsqf(ss * (1.0f / 128.0f) + EPS);
    const int q = crow(r, hi);
#pragma unroll
    for (int d0 = 0; d0 < 4; ++d0) stg[q * 128 + d0 * 32 + r32] = (bf16)(cvtpk(o[d0][r] * rs * gs[d0], 0.f) & 0xffffu);
  }
  asm volatile("s_waitcnt lgkmcnt(0)" ::: "memory");
#pragma unroll
  for (int i = 0; i < 8; ++i) { const int id = i * 64 + lane, row = id >> 4, ch = id & 15;
    if (row < nrows) { const u32x4 v = *(const ALAS u32x4*)(stg + row * 128 + ch * 8); *(u32x4*)(Orow0 + (size_t)row * DMODEL + ch * 8) = v; } }
  asm volatile("s_waitcnt lgkmcnt(0)" ::: "memory");
}
__device__ __forceinline__ void stick_prompt_unit(int h, int qt, const bf16* __restrict__ BQ, const bf16* __restrict__ BK, const bf16* __restrict__ BV, const float* __restrict__ g_sb, bf16* __restrict__ O, ALAS char* vbuf) {
  int lane = lane_id(); asm volatile("" : "+v"(lane)); const int r32 = lane & 31, hi = lane >> 5; const int t0 = 32 * qt;
  const bf16* Qw = BQ + (size_t)(t0 + r32) * HW + h * 128 + hi * 8;
  f32x16 o[4] = {}; float carry = 0.f; const int qpos = t0 + r32; const int jd = t0 >> 6;
  for (int j = jd; j >= 0; --j) {
    stick_tile<bf16>(o, carry, Qw, BK + (size_t)(64 * j) * HW + h * 128, BV + (size_t)(64 * j) * HW + h * 128, HW, 64, 64 * j, qpos, j == jd, vbuf, lane, r32, hi);
    if (__all(carry < SB_STOP)) break;
  }
  stick_store(o, g_sb, O + (size_t)t0 * DMODEL + 2048 + h * 128, 32, vbuf, lane, r32, hi);
}
__device__ __forceinline__ void stick_sample_unit(int b, int h, const bf16* __restrict__ BQ, const bf16* __restrict__ BK, const bf16* __restrict__ BV, const float* __restrict__ cbk, const float* __restrict__ cbv,
                                                  const float* __restrict__ g_sb, bf16* __restrict__ O, ALAS char* vbuf) {
  int lane = lane_id(); asm volatile("" : "+v"(lane)); const int r32 = lane & 31, hi = lane >> 5; const size_t row0 = (size_t)TP + b * 16;
  const bf16* Qw = BQ + (row0 + (r32 & 15)) * HW + h * 128 + hi * 8;
  f32x16 o[4] = {}; float carry = 0.f; const int qpos = 2048 + (r32 & 15);
  stick_tile<bf16>(o, carry, Qw, BK + row0 * HW + h * 128, BV + row0 * HW + h * 128, HW, 16, 2048, qpos, true, vbuf, lane, r32, hi);
  for (int j = 31; j >= 0; --j) {
    if (__all(carry < SB_STOP)) break;
    const size_t ro = ((size_t)(b * 2048 + 64 * j) * 16 + h) * 128;
    stick_tile<float>(o, carry, Qw, cbk + ro, cbv + ro, 2048, 64, 64 * j, qpos, false, vbuf, lane, r32, hi);
  }
  stick_store(o, g_sb, O + row0 * DMODEL + 2048 + h * 128, 16, vbuf, lane, r32, hi);
}
#undef PK4
#undef SBAR
#undef RESC
}
namespace sk {
#define SLAS __attribute__((address_space(3)))
typedef unsigned short bf16;
using bf16x8 = __attribute__((ext_vector_type(8))) short;
using f32x16 = __attribute__((ext_vector_type(16))) float;
constexpr int SLOT = 40960, A_BYTES = 32768;
__device__ __forceinline__ int crow(int r, int hi) { return (r & 3) + 8 * (r >> 2) + 4 * hi; }
__device__ __forceinline__ void glds16(const void* gsrc, unsigned lds_dst) { unsigned keep;
  asm volatile("s_mov_b32 %0, m0\n\ts_mov_b32 m0, %2\n\ts_nop 0\n\tglobal_load_lds_dwordx4 %1, off\n\ts_mov_b32 m0, %0" : "=&s"(keep) : "v"(gsrc), "s"(lds_dst) : "memory"); }
struct Item { int t; int kt0; int nkt; int ks; };
template <class Epi>
__device__ __forceinline__ void skinny_item(const Item it, const bf16* __restrict__ A, int lda, const bf16* __restrict__ Wt, int KT  , const Epi& E, SLAS char* lds, const int wv) {
  int tid = wv * 64 + lane_id(); asm volatile("" : "+v"(tid));
  const int wid = __builtin_amdgcn_readfirstlane(tid >> 6), lane = tid & 63, r32 = lane & 31, hi = lane >> 5;
  const int arow0 = 32 * wid + (lane >> 3), cs = lane & 7;
  unsigned aoff[4];
#pragma unroll
  for (int q = 0; q < 4; ++q) { const int row = arow0 + 8 * q; aoff[q] = (unsigned)row * (unsigned)(lda * 2) + (unsigned)((cs ^ ((row >> 1) & 7)) * 16); }
  const int brow = 8 * wid + (lane >> 3); const unsigned boff = (unsigned)(brow * 128 + ((cs ^ ((brow >> 1) & 7)) * 16));
  const char* Ag = (const char*)A + (size_t)it.kt0 * 128;
  const char* Wg = (const char*)Wt + ((size_t)(it.t >> 2) * KT + it.kt0) * 32768 + (size_t)(it.t & 3) * 8192;
  const unsigned lds0 = (unsigned)(uintptr_t)lds;
#define SK_DMA(kt, slot) do { const unsigned sl_ = (unsigned)__builtin_amdgcn_readfirstlane((int)(lds0 + (slot) * SLOT)); const char* ag_ = Ag + (size_t)(kt) * 128; \
    glds16(ag_ + aoff[0], sl_ + (unsigned)(wid * 4096)); glds16(ag_ + aoff[1], sl_ + (unsigned)(wid * 4096 + 1024)); glds16(ag_ + aoff[2], sl_ + (unsigned)(wid * 4096 + 2048)); glds16(ag_ + aoff[3], sl_ + (unsigned)(wid * 4096 + 3072)); \
    glds16(Wg + (size_t)(kt) * 32768 + boff, sl_ + (unsigned)(A_BYTES + wid * 1024)); } while (0)
  const int ar = 32 * wid + r32, asw = (ar >> 1) & 7, b0sw = (r32 >> 1) & 7, b1sw = ((32 + r32) >> 1) & 7;
  f32x16 acc[2] = {};
  const int nkt = it.nkt;
  SK_DMA(0, 0); if (nkt > 1) SK_DMA(1, 1);
  int slot = 0, slot2 = 2;
  for (int kt = 0; kt < nkt; ++kt) {
    if (kt + 1 < nkt) asm volatile("s_waitcnt vmcnt(5)" ::: "memory"); else asm volatile("s_waitcnt vmcnt(0)" ::: "memory");
    asm volatile("s_waitcnt lgkmcnt(0)\n\ts_barrier" ::: "memory");
    if (kt + 2 < nkt) SK_DMA(kt + 2, slot2);
    const SLAS char* sa = lds + slot * SLOT + ar * 128; const SLAS char* sb = lds + slot * SLOT + A_BYTES;
#pragma unroll
    for (int s = 0; s < 4; ++s) { const int c = 2 * s + hi;
      const bf16x8 a = *reinterpret_cast<const SLAS bf16x8*>(sa + ((c ^ asw) * 16));
      const bf16x8 w0 = *reinterpret_cast<const SLAS bf16x8*>(sb + r32 * 128 + ((c ^ b0sw) * 16));
      const bf16x8 w1 = *reinterpret_cast<const SLAS bf16x8*>(sb + (32 + r32) * 128 + ((c ^ b1sw) * 16));
      acc[0] = __builtin_amdgcn_mfma_f32_32x32x16_bf16(a, w0, acc[0], 0, 0, 0);
      acc[1] = __builtin_amdgcn_mfma_f32_32x32x16_bf16(a, w1, acc[1], 0, 0, 0); }
    slot = (slot == 2) ? 0 : slot + 1; slot2 = (slot2 == 2) ? 0 : slot2 + 1;
  }
#undef SK_DMA
  E(acc, it, wid, r32, hi);
  asm volatile("s_waitcnt lgkmcnt(0)" ::: "memory"); __syncthreads();
}
#undef SLAS
}
constexpr int NWAVES = 8;
#ifndef MK_N_LAUNCHES
#define MK_N_LAUNCHES 1
#endif
constexpr int N_PHASES = 8;
constexpr int N_LAUNCHES = MK_N_LAUNCHES;
static_assert(N_LAUNCHES == 1 || N_LAUNCHES == N_PHASES, "MK_N_LAUNCHES is 1 or 8");

constexpr int DM = 4096, TP = 8192, TS = 256, MROWS = TP + TS, HW = 2048, NIN = 6 * HW, DFF = 16384;
constexpr int DEC_B = 16, DEC_T = 16, PAST = 2048, A_HEADS = 8, B_HEADS = 16;
constexpr float EPS = 1e-6f, LAM_INIT = 0.2f;
constexpr size_t OUT_Y = 0;
constexpr size_t OUT_KVP = (size_t)MROWS * DM;
constexpr size_t OUT_KVS = OUT_KVP + 4 * (size_t)TP * HW;
constexpr size_t OUT_TOTAL = OUT_KVS + 4 * (size_t)TS * HW;
static_assert(OUT_TOTAL == 103809024ull, "output size");
constexpr size_t MiB = 1u << 20;
constexpr size_t WS_CTL = 0, CTL_ZERO_BYTES = 1 * MiB;
constexpr size_t WS_ROPE = 2 * MiB;
constexpr size_t WS_WIN = 4 * MiB;
constexpr size_t WS_WOUT = WS_WIN + 96 * MiB;
constexpr size_t WS_WUP = WS_WOUT + 32 * MiB;
constexpr size_t WS_WDOWN = WS_WUP + 128 * MiB;
constexpr size_t WS_H0 = WS_WDOWN + 128 * MiB;
constexpr size_t WS_QKV = WS_H0 + 66 * MiB;
constexpr size_t WS_OA = WS_QKV + 198 * MiB;
constexpr size_t WS_O = WS_OA + 128 * MiB;
constexpr size_t WS_X1 = WS_O + 66 * MiB;
constexpr size_t WS_X1S = WS_X1 + 66 * MiB, WS_X2B = WS_OA;
constexpr size_t WS_H1 = WS_X1 + 132 * MiB;
constexpr size_t WS_U = WS_H1 + 66 * MiB;
constexpr size_t WS_PART1 = WS_U + 264 * MiB;
constexpr size_t WS_PART2 = WS_PART1 + 48 * MiB;
constexpr size_t WS_PART3 = WS_PART2 + 32 * MiB;
constexpr size_t WS_PART4 = WS_PART3 + 64 * MiB;
constexpr size_t WS_END = WS_PART4 + 64 * MiB;
#ifndef WGMS
#define WGMS 4, 4, 4, 4
#endif
constexpr int WGM_TAB[4] = {WGMS}; constexpr int WGM_P1 = WGM_TAB[0], WGM_P4 = WGM_TAB[1], WGM_P5 = WGM_TAB[2], WGM_P6 = WGM_TAB[3];
constexpr int SPL2 = 4, SPL4 = 4;
static_assert((size_t)MROWS * DM * 2 <= 66 * MiB && (size_t)MROWS * HW * 2 * 6 <= 198 * MiB && (size_t)MROWS * DM * 4 <= 132 * MiB && (size_t)MROWS * DFF * 2 <= 264 * MiB, "ws map");
constexpr int CW_TMO = 0, CW_CODE = 1;
constexpr int CW_BAR = 4096;
constexpr int CW_BQ = 8192, CW_AQ = 8704;
constexpr int CW_SSQ1 = 16384, CW_SSQ2 = 32768;
static_assert((CW_SSQ2 + MROWS) * 4 <= (int)CTL_ZERO_BYTES, "CTL words inside the memset region");
constexpr int RING_OFF = 0, RING_BYTES = 135168;
constexpr int LDSCTL_OFF = RING_BYTES, MISC_OFF = LDSCTL_OFF + 320;
constexpr int LDS_BYTES = 147456;
static_assert(MISC_OFF + 128 <= LDS_BYTES && 8 * 64 * 65 * 4 <= RING_BYTES && att::SA_LDS <= RING_BYTES && att::X_LDS <= RING_BYTES, "LDS map");

#define GAS __attribute__((address_space(1)))
#define LAS __attribute__((address_space(3)))
typedef unsigned short bf16;
typedef unsigned v4u __attribute__((ext_vector_type(4)));
typedef float f32x4 __attribute__((ext_vector_type(4)));
typedef short bf16x8 __attribute__((ext_vector_type(8)));
typedef GAS unsigned gu32;
typedef GAS unsigned long long gu64;
#define RLX_AGENT __ATOMIC_RELAXED, __HIP_MEMORY_SCOPE_AGENT
#define LDS_WAIT() asm volatile("s_waitcnt lgkmcnt(0)" ::: "memory")
#define VM_WAIT() asm volatile("s_waitcnt vmcnt(0)" ::: "memory")
__device__ __forceinline__ unsigned long long rt() { return __builtin_amdgcn_s_memrealtime(); }
__device__ __forceinline__ unsigned f2bf(float f) { unsigned u = __builtin_bit_cast(unsigned, f); return (u + 0x7fffu + ((u >> 16) & 1u)) >> 16; }
__device__ __forceinline__ unsigned pk2(float lo, float hi) { return f2bf(lo) | (f2bf(hi) << 16); }

#define XB_TMO      128
#define XB_XCNT(j)  (256  + 64 * (j))
#define XB_XSUB(j)  (1280 + 64 * (j))
#define XB_XGEN(j)  (2304 + 64 * (j))
#define XB_TOP      3328
#define XB_TOPGEN   3392
#define XCD_BAR_WORDS 3456
#define XB_SPIN_CAP (1u << 18)

__device__ __forceinline__ unsigned xb_ld(unsigned* p)              { return __hip_atomic_load(p, __ATOMIC_RELAXED, __HIP_MEMORY_SCOPE_AGENT); }
__device__ __forceinline__ unsigned xb_add(unsigned* p, unsigned v) { return __hip_atomic_fetch_add(p, v, __ATOMIC_RELAXED, __HIP_MEMORY_SCOPE_AGENT); }
__device__ __forceinline__ unsigned xb_xcc_id() { return (unsigned)__builtin_amdgcn_s_getreg((3 << 11) | 20) & 0xFu; }
#define XB_SPIN(cond, bar) do { unsigned _sp = 0; while (cond) { __builtin_amdgcn_s_sleep(1); \
    if ((++_sp & 255u) == 0u) { if (xb_ld(&(bar)[XB_TMO])) break; if (_sp > XB_SPIN_CAP) { atomicAdd(&(bar)[XB_TMO], 1u); break; } } } } while (0)

struct XcdBarrier {
    unsigned* bar; unsigned x;
    volatile LAS unsigned* st;
};

__device__ __forceinline__ XcdBarrier xcd_barrier_post(unsigned* bar, volatile LAS unsigned* st, const bool t0  ) {
    XcdBarrier b; b.bar = bar; b.x = xb_xcc_id(); b.st = st;
    if (t0) (void)xb_add(&bar[XB_XCNT(b.x)], 1u);
    return b;
}
__device__ __forceinline__ void xcd_barrier_complete(unsigned* bar, unsigned x, unsigned& nloc, unsigned& nx) {
    const unsigned G = gridDim.x * gridDim.y * gridDim.z;
    unsigned sum, cnt, mine, sp = 0u;
    for (;;) {
        sum = 0u; cnt = 0u; mine = 0u;
#pragma unroll
        for (unsigned j = 0; j < 16; ++j) { const unsigned c = xb_ld(&bar[XB_XCNT(j)]); sum += c; cnt += (c > 0u) ? 1u : 0u; mine = (j == x) ? c : mine; }
        if (sum == G) break;
        __builtin_amdgcn_s_sleep(1);
        if ((++sp & 255u) == 0u) { if (xb_ld(&bar[XB_TMO])) break; if (sp > XB_SPIN_CAP) { atomicAdd(&bar[XB_TMO], 1u); break; } }
    }
    nloc = mine > 0u ? mine : 1u; nx = cnt > 0u ? cnt : 1u;
}

__device__ __forceinline__ void xcd_barrier(const XcdBarrier& b, const bool t0  ) {
    asm volatile("s_waitcnt vmcnt(0)" ::: "memory");
    __syncthreads();
    if (t0) {
        unsigned* bar = b.bar;
        __builtin_amdgcn_s_waitcnt(0);
        unsigned nloc = b.st[0], nx = b.st[1];
        if (nloc == 0u) { xcd_barrier_complete(bar, b.x, nloc, nx); b.st[0] = nloc; b.st[1] = nx; }
        const unsigned old = xb_add(&bar[XB_XSUB(b.x)], 1u);
        const unsigned gen = old / nloc;
        if (old + 1u == (gen + 1u) * nloc) {
            __builtin_amdgcn_fence(__ATOMIC_RELEASE, "agent");
            asm volatile("s_waitcnt vmcnt(0)" ::: "memory");
            const unsigned og = xb_add(&bar[XB_TOP], 1u);
            const unsigned tg = og / nx;
            if (og + 1u == (tg + 1u) * nx) xb_add(&bar[XB_TOPGEN], 1u);
            else XB_SPIN(xb_ld(&bar[XB_TOPGEN]) == tg, bar);
            __builtin_amdgcn_fence(__ATOMIC_ACQUIRE, "agent");
            xb_add(&bar[XB_XGEN(b.x)], 1u);
            asm volatile("s_waitcnt vmcnt(0)" ::: "memory");
        } else {
            XB_SPIN(xb_ld(&bar[XB_XGEN(b.x)]) == gen, bar);
            __builtin_amdgcn_fence(__ATOMIC_ACQUIRE, "agent");
            asm volatile("s_waitcnt vmcnt(0)" ::: "memory");
        }
    }
    __syncthreads();
}


__device__ __forceinline__ int lane_now() { int t = lane_id(); asm volatile("" : "+v"(t)); return t; }
struct Frame {
    LAS unsigned char* lds;
    volatile LAS unsigned* MISC;
    gu32* ctl;
    int tid, lane, wave;
    int vcu, G;
};
__device__ __forceinline__ float wave_sum(float v) {
#pragma unroll
    for (int o = 1; o < 64; o <<= 1) v += __shfl_xor(v, o);
    return v;
}
__constant__ double ROPE_INV[16] = {
    1.0, 0.44036660267178046, 0.19392274474868576, 0.08539710028576561, 0.03760603093086393, 0.016560440080994446, 0.007292664737217109, 0.003211445994752591,
    0.001414213562373095, 0.000622772421914596, 0.0002742481756762073, 0.00012076973741146504, 5.318295896944988e-05, 2.341999896140934e-05, 1.031338537721246e-05, 4.5416704806078695e-06 };

__device__ __forceinline__ void p0_transpose_item(const float* W, int K, int N, bf16* WT, LAS float* scr, int item, int lane) {
    const int nblk = N / 32, kb = item / nblk, nb = item % nblk, k0 = 64 * kb, n0 = 32 * nb;
#pragma unroll 8
    for (int i = 0; i < 32; ++i) { const int kk = 2 * i + (lane >> 5); scr[kk * 33 + (lane & 31)] = W[(size_t)(k0 + kk) * N + n0 + (lane & 31)]; }
    LDS_WAIT(); asm volatile("" ::: "memory");
    const int c = lane & 7;
#pragma unroll
    for (int j = 0; j < 4; ++j) { const int n = (lane >> 3) + 8 * j; const LAS float* s = scr + (8 * c) * 33 + n;
        v4u o; o.x = pk2(s[0 * 33], s[1 * 33]); o.y = pk2(s[2 * 33], s[3 * 33]); o.z = pk2(s[4 * 33], s[5 * 33]); o.w = pk2(s[6 * 33], s[7 * 33]);
        *(GAS v4u*)(WT + (size_t)(n0 + n) * K + k0 + 8 * c) = o; }
    LDS_WAIT(); asm volatile("" ::: "memory");
}
constexpr int CONV_SCR = 64 * 65 * 4;
__device__ __forceinline__ void conv_item64(const float* W, int K, int N, bf16* WT, LAS float* scr, int item, int lane) {
    const int nblk = N >> 6, kb = item / nblk, nb = item - kb * nblk, k0 = kb << 6, n0 = nb << 6;
    const float* src = W + (size_t)(k0 + (lane >> 4)) * N + n0 + 4 * (lane & 15);
    f32x4 v[16];
#pragma unroll
    for (int i = 0; i < 16; ++i) v[i] = *(const f32x4*)(src + (size_t)(4 * i) * N);
    LAS float* d = scr + (lane >> 4) * 65 + 4 * (lane & 15);
#pragma unroll
    for (int i = 0; i < 16; ++i) { LAS float* p = d + i * (4 * 65); p[0] = v[i].x; p[1] = v[i].y; p[2] = v[i].z; p[3] = v[i].w; }
    LDS_WAIT(); asm volatile("" ::: "memory");
    const int c = lane & 7;
#pragma unroll
    for (int j = 0; j < 8; ++j) { const int n = (lane >> 3) + 8 * j; const LAS float* s = scr + (8 * c) * 65 + n;
        v4u o; o.x = pk2(s[0 * 65], s[1 * 65]); o.y = pk2(s[2 * 65], s[3 * 65]); o.z = pk2(s[4 * 65], s[5 * 65]); o.w = pk2(s[6 * 65], s[7 * 65]);
        const int ng = n0 + n;
        *(GAS v4u*)(WT + ((size_t)(ng >> 8) * (K >> 6) + kb) * 16384 + (size_t)(ng & 255) * 64 + 8 * c) = o; }
    LDS_WAIT(); asm volatile("" ::: "memory");
}
__device__ __forceinline__ void rms_row_to_bf16(const float* xrow, const float* g, bf16* orow, int lane) {
    const GAS f32x4* xr = (const GAS f32x4*)xrow + lane; const GAS f32x4* gr = (const GAS f32x4*)g + lane;
    f32x4 v[16]; float s = 0.f;
#pragma unroll
    for (int j = 0; j < 16; ++j) { v[j] = xr[64 * j]; s += (v[j].x * v[j].x + v[j].y * v[j].y) + (v[j].z * v[j].z + v[j].w * v[j].w); }
    const float rstd = 1.0f / sqrtf(wave_sum(s) * (1.f / DM) + EPS);
    GAS unsigned long long* o8 = (GAS unsigned long long*)orow + lane;
#pragma unroll
    for (int j = 0; j < 16; ++j) { const f32x4 gg = gr[64 * j];
        o8[64 * j] = (unsigned long long)pk2(v[j].x * rstd * gg.x, v[j].y * rstd * gg.y) | ((unsigned long long)pk2(v[j].z * rstd * gg.z, v[j].w * rstd * gg.w) << 32); }
}
__device__ __forceinline__ float lambda_of(const float* q1, const float* k1, const float* q2, const float* k2, int lane) {
    const float a = wave_sum(q1[lane] * k1[lane] + q1[64 + lane] * k1[64 + lane]);
    const float b = wave_sum(q2[lane] * k2[lane] + q2[64 + lane] * k2[64 + lane]);
    return expf(a) - expf(b) + LAM_INIT;
}

typedef const __attribute__((address_space(4))) char* kaptr;
__device__ __forceinline__ kaptr karg_base() { kaptr ka = (kaptr)__builtin_amdgcn_kernarg_segment_ptr(); asm volatile("" : "+s"(ka)); return ka; }
__device__ __forceinline__ const float* karg_in(int i) { return *(const float* const __attribute__((address_space(4)))*)(karg_base() + 8 * i); }
__device__ __forceinline__ float* karg_out() { return *(float* const __attribute__((address_space(4)))*)(karg_base() + 152); }
__device__ __forceinline__ unsigned char* karg_ws() { return *(unsigned char* const __attribute__((address_space(4)))*)(karg_base() + 160); }
struct SkInProj {
    bf16* qkv; float* out_kvs; const float* rope;
    __device__ __forceinline__ void operator()(const sk::f32x16 (&acc)[2], const sk::Item& it, int wid, int r32, int hi) const {
        const int col0 = it.t * 64, tt = col0 >> 11, ct0 = col0 & 2047;
        const bool rot = (tt < 2) && ((col0 & 127) == 0);
        const int d = r32 & 15; const float sgn = (r32 < 16) ? -1.f : 1.f;
        const int idx = (tt == 1) ? 0 : (tt == 2) ? 1 : (tt == 4) ? 2 : 3; const bool f32out = (tt == 1 || tt == 2 || tt == 4 || tt == 5);
        bf16* qb = qkv + (size_t)tt * ((size_t)MROWS * HW) + (size_t)TP * HW; float* fo = out_kvs + (size_t)idx * (TS * HW);
#pragma unroll
        for (int r = 0; r < 16; ++r) { const int row = 32 * wid + sk::crow(r, hi);
            float v0 = acc[0][r]; const float v1 = acc[1][r];
            const float other = __shfl_xor(v0, 16);
            if (rot) { const float cc = rope[(size_t)(TP + row) * 32 + d], ss = rope[(size_t)(TP + row) * 32 + 16 + d]; v0 = v0 * cc + sgn * other * ss; }
            qb[(size_t)row * HW + ct0 + r32] = (bf16)f2bf(v0); qb[(size_t)row * HW + ct0 + 32 + r32] = (bf16)f2bf(v1);
            if (f32out) { fo[(size_t)row * HW + ct0 + r32] = v0; fo[(size_t)row * HW + ct0 + 32 + r32] = v1; } }
    }
};
struct SkPartial {
    float* part; int N;
    __device__ __forceinline__ void operator()(const sk::f32x16 (&acc)[2], const sk::Item& it, int wid, int r32, int hi) const {
#pragma unroll
        for (int r = 0; r < 16; ++r) { float* p = part + ((size_t)it.ks * TS + 32 * wid + sk::crow(r, hi)) * N + it.t * 64 + r32; p[0] = acc[0][r]; p[32] = acc[1][r]; }
    }
};
struct SkUp {
    const float* ssq; bf16* U;
    __device__ __forceinline__ void operator()(const sk::f32x16 (&acc)[2], const sk::Item& it, int wid, int r32, int hi) const {
#pragma unroll
        for (int r = 0; r < 16; ++r) { const int row = 32 * wid + sk::crow(r, hi); const float rs = 1.0f / sqrtf(ssq[TP + row] * (1.f / DM) + EPS);
            const float a = fmaxf(acc[0][r] * rs, 0.f), b = fmaxf(acc[1][r] * rs, 0.f);
            bf16* p = U + (size_t)(TP + row) * DFF + it.t * 64 + r32; p[0] = (bf16)f2bf(a * a); p[32] = (bf16)f2bf(b * b); }
    }
};
struct Args { const float* in[19]; float* out; unsigned char* ws; int ph_lo, ph_hi, li, pad; };
static_assert(offsetof(Args, out) == 152 && offsetof(Args, ws) == 160 && sizeof(Args) == 184, "kernarg layout used by karg_*");
__global__ void __launch_bounds__(NWAVES * 64, 2) hybrid_fwd(Args args) {
    extern __shared__ __attribute__((aligned(16))) unsigned char lds[];
    Frame F;
    F.lds = (LAS unsigned char*)lds;
    F.MISC = (volatile LAS unsigned*)(F.lds + MISC_OFF);
    F.wave = __builtin_amdgcn_readfirstlane((int)threadIdx.x >> 6); F.lane = 0; { int t = F.wave * 64 + lane_id(); asm volatile("" : "+v"(t)); F.tid = t; }
    F.G = gridDim.x; { const int bx = blockIdx.x; F.vcu = (F.G % 8 == 0) ? (bx % 8) * (F.G / 8) + bx / 8 : bx; }
    F.ctl = (gu32*)(karg_ws() + WS_CTL);
    constexpr size_t QS = (size_t)MROWS * HW;
#define KIN(i) karg_in(i)
#define KWS(T, off) ((T*)(karg_ws() + (off)))
#define KSSQ(w) ((float*)(karg_ws() + WS_CTL) + (w))
    for (int u = F.tid; u < (LDS_BYTES - LDSCTL_OFF) / 4; u += NWAVES * 64) ((LAS unsigned*)(F.lds + LDSCTL_OFF))[u] = 0u;
    __syncthreads();
    XcdBarrier bar; bar.bar = (unsigned*)(F.ctl + CW_BAR); bar.x = 0; bar.st = nullptr;
    if (N_LAUNCHES == 1) bar = xcd_barrier_post((unsigned*)(F.ctl + CW_BAR), F.MISC + 8, F.wave == 0 && lane_id() == 0);
#define GRID_BAR() do { if (N_LAUNCHES == 1) xcd_barrier(bar, F.wave == 0 && lane_id() == 0); } while (0)
    const int lo = args.ph_lo, hi = args.ph_hi;
#ifndef PH_MASK
#define PH_MASK 0xff
#endif
#define IN(k) (((PH_MASK >> (k)) & 1) && lo <= (k) && (k) < hi)
#define BOTH(k) (IN(k) && IN((k) + 1))
    const int gw = F.vcu * NWAVES + F.wave, NGW = F.G * NWAVES;

    if (IN(0)) {
        LAS float* scr = (LAS float*)(F.lds + RING_OFF + F.wave * CONV_SCR);
        const float* x_prompt = KIN(0); const float* x_sample = KIN(1); const float* g_attn = KIN(6); const float* w_in = KIN(7);
        bf16* Win_t = KWS(bf16, WS_WIN); bf16* H0 = KWS(bf16, WS_H0); float* ROPE = KWS(float, WS_ROPE);
        for (int it = gw; it < (DM / 64) * (NIN / 64); it += NGW) conv_item64(w_in, DM, NIN, Win_t, scr, it, lane_now());
        for (int m = gw; m < MROWS; m += NGW) rms_row_to_bf16(m < TP ? x_prompt + (size_t)m * DM : x_sample + (size_t)(m - TP) * DM, g_attn, H0 + (size_t)m * DM, lane_now());
        for (int e = blockIdx.x * (NWAVES * 64) + F.tid; e < MROWS * 16; e += F.G * NWAVES * 64) {
            const int row = e >> 4, d = e & 15; const int pos = row < TP ? row : PAST + ((row - TP) & 15);
            const double rev = (double)pos * ROPE_INV[d] * 0.15915494309189535; const float fr = (float)(rev - floor(rev));
            ROPE[(size_t)row * 32 + d] = __builtin_amdgcn_cosf(fr); ROPE[(size_t)row * 32 + 16 + d] = __builtin_amdgcn_sinf(fr);
        }
        if (BOTH(0)) GRID_BAR();
    }
    if (IN(1)) {
        float* out = karg_out();
        { pg8::Gemm g{KWS(bf16, WS_H0), KWS(bf16, WS_WIN), TP, NIN, DM, DM}; pg8::StaticOrder S; S.init(TP, NIN, F.G, (int)blockIdx.x, WGM_P1);
          pg8::EpiInProj E{KWS(bf16, WS_QKV), out + OUT_KVP, out + OUT_KVS, KWS(float, WS_ROPE)};
          if (!(args.pad & 32)) pg8::gemm_phase<pg8::EpiInProj, pg8::StaticOrder, true, true>(F.lds + RING_OFF, g, S, E, F.wave); }
        if (!(args.pad & 16)) {
            const SkInProj E{KWS(bf16, WS_QKV), out + OUT_KVS, KWS(float, WS_ROPE)};
            for (int i = (int)blockIdx.x; i < NIN / 64; i += F.G) sk::skinny_item(sk::Item{i, 0, DM / 64, 0}, KWS(bf16, WS_H0) + (size_t)TP * DM, DM, KWS(bf16, WS_WIN), DM / 64, E, (LAS char*)(F.lds + RING_OFF), F.wave);
        }
        if (BOTH(1)) GRID_BAR();
    }
    if (IN(2)) {
        LAS char* al = (LAS char*)(F.lds + RING_OFF);
        const bf16* QKV = KWS(bf16, WS_QKV); bf16* OB = KWS(bf16, WS_O);
        const bf16* AQ = QKV; const bf16* AK = QKV + QS; const bf16* AV = QKV + 2 * QS; const bf16* BQ = QKV + 3 * QS; const bf16* BK = QKV + 4 * QS; const bf16* BV = QKV + 5 * QS;
#ifndef P2_MASK
#define P2_MASK 7
#endif
        const int sub = args.pad ? args.pad : 15;
        if ((P2_MASK & 3) && (sub & 11)) {
            constexpr int NQE = 64 + DEC_B + 32;
            constexpr int CI_OUT = (DM / 64) * (DM / 64), CI_UP = (DM / 64) * (DFF / 64), CI_DOWN = (DFF / 64) * (DM / 64), CI_PER_UNIT = (CI_OUT + CI_UP + CI_DOWN) / 256;
            static_assert((CI_OUT + CI_UP + CI_DOWN) % 256 == 0 && CI_PER_UNIT % NWAVES == 0, "conversion items divide over 256 units x 8 waves");
            const int qx0 = (int)(xb_xcc_id() & 7u);
            for (int pass = 0; pass < 8; ++pass) {
                const int x = (qx0 + pass) & 7;
                for (;;) {
                    __syncthreads();
                    if (F.wave == 0 && lane_id() == 0) F.MISC[0] = __hip_atomic_fetch_add(F.ctl + CW_AQ + 64 * x, 1u, RLX_AGENT);
                    __syncthreads();
                    const int e = (int)F.MISC[0];
                    if (e >= NQE) break;
                    const int blk = e / 7, r = e - blk * 7;
                    if (r == 3 || r == 6) {
                        if (sub & 8) {
                            const int u = 32 * x + 2 * blk + (r == 6 ? 1 : 0); LAS float* scr = (LAS float*)(F.lds + RING_OFF + F.wave * CONV_SCR); const int lane = lane_now();
                            for (int t = 0; t < CI_PER_UNIT / NWAVES; ++t) {
                                int g = u * CI_PER_UNIT + t * NWAVES + F.wave;
                                if (g < CI_OUT) conv_item64(KIN(14), DM, DM, KWS(bf16, WS_WOUT), scr, g, lane);
                                else if (g < CI_OUT + CI_UP) conv_item64(KIN(16), DM, DFF, KWS(bf16, WS_WUP), scr, g - CI_OUT, lane);
                                else conv_item64(KIN(17), DFF, DM, KWS(bf16, WS_WDOWN), scr, g - CI_OUT - CI_UP, lane);
                            }
                        }
                        continue;
                    }
                    const int a = blk * 5 + (r < 3 ? r : r - 1);
                    const float lam = lambda_of(KIN(8), KIN(9), KIN(10), KIN(11), lane_now());
                    if (a >= 42 && a < 58) { if (sub & 2) att::attnA_sample_unit(F.wave, a - 42, x, KIN(2), KIN(3), karg_out() + OUT_KVS, karg_out() + OUT_KVS + (size_t)TS * HW, AQ, lam, KIN(12), 1.0f - LAM_INIT, OB, al); }
                    else if (sub & 1) att::attnA_prompt_unit2(F.wave, x, a < 42 ? 63 - a : 79 - a, AQ, AK, AV, lam, KIN(12), 1.0f - LAM_INIT, OB, al);
                }
            }
        }
        if ((P2_MASK & 4) && (sub & 4)) {
            LAS char* vbuf = al + F.wave * 16384; const float* g_sb = KIN(13); const float* cache_b_k = KIN(4); const float* cache_b_v = KIN(5);
            constexpr unsigned NBU = DEC_B * B_HEADS + B_HEADS * (TP / 32);
            for (;;) {
                unsigned u = 0;
                if (lane_now() == 0) u = __hip_atomic_fetch_add(F.ctl + CW_BQ, 1u, RLX_AGENT);
                u = (unsigned)__builtin_amdgcn_readfirstlane((int)u);
                if (u >= NBU) break;
                if (u < DEC_B * B_HEADS) att::stick_sample_unit((int)(u >> 4), (int)(u & 15), BQ, BK, BV, cache_b_k, cache_b_v, g_sb, OB, vbuf);
                else { const int idx = (int)u - DEC_B * B_HEADS; const int h = (idx >> 3) & 15, qt = (TP / 32 - 1) - ((idx & 7) | ((idx >> 7) << 3)); att::stick_prompt_unit(h, qt, BQ, BK, BV, g_sb, OB, vbuf); }
            }
        }
        if (BOTH(2)) GRID_BAR();
    }
    if (IN(3)) {
        { pg8::Gemm g{KWS(bf16, WS_O), KWS(bf16, WS_WOUT), TP, DM, DM, DM}; pg8::StaticOrder S; S.init(TP, DM, F.G, (int)blockIdx.x, WGM_P4);
          pg8::EpiOutProj E{KIN(0), KIN(1), KIN(15), KWS(bf16, WS_X1), KWS(bf16, WS_H1), KSSQ(CW_SSQ1)};
          if (!(args.pad & 32)) pg8::gemm_phase<pg8::EpiOutProj, pg8::StaticOrder, true, true>(F.lds + RING_OFF, g, S, E, F.wave); }
        if (!(args.pad & 16)) {
            const SkPartial E{KWS(float, WS_PART2), DM};
            for (int i = (int)blockIdx.x; i < (DM / 64) * SPL2; i += F.G) sk::skinny_item(sk::Item{i >> 2, (i & 3) * (DM / 64 / SPL2), DM / 64 / SPL2, i & 3}, KWS(bf16, WS_O) + (size_t)TP * DM, DM, KWS(bf16, WS_WOUT), DM / 64, E, (LAS char*)(F.lds + RING_OFF), F.wave);
        }
        if (BOTH(3)) GRID_BAR();
    }
    if (IN(4)) {
        const int lane = lane_now(); const float* PART = KWS(float, WS_PART2); const float* xs = KIN(1); const float* g = KIN(15); float* X1S = KWS(float, WS_X1S); bf16* H1 = KWS(bf16, WS_H1); float* SSQ1 = KSSQ(CW_SSQ1);
        for (int it = gw; it < TS * (DM / 512); it += NGW) {
            const int row = it / (DM / 512), col = (it % (DM / 512)) * 512 + lane * 8;
            f32x4 a0 = *(const f32x4*)(xs + (size_t)row * DM + col), a1 = *(const f32x4*)(xs + (size_t)row * DM + col + 4);
#pragma unroll
            for (int ks = 0; ks < SPL2; ++ks) { const float* p = PART + ((size_t)ks * TS + row) * DM + col; a0 += *(const f32x4*)p; a1 += *(const f32x4*)(p + 4); }
            float* xo = X1S + (size_t)row * DM + col; *(f32x4*)xo = a0; *(f32x4*)(xo + 4) = a1;
            const float ss = wave_sum((a0.x * a0.x + a0.y * a0.y) + (a0.z * a0.z + a0.w * a0.w) + (a1.x * a1.x + a1.y * a1.y) + (a1.z * a1.z + a1.w * a1.w));
            if (lane == 0) pg8::ssq_add(SSQ1 + TP + row, ss);
            const f32x4 g0 = *(const f32x4*)(g + col), g1 = *(const f32x4*)(g + col + 4);
            v4u w; w.x = pk2(a0.x * g0.x, a0.y * g0.y); w.y = pk2(a0.z * g0.z, a0.w * g0.w); w.z = pk2(a1.x * g1.x, a1.y * g1.y); w.w = pk2(a1.z * g1.z, a1.w * g1.w);
            *(v4u*)(H1 + (size_t)(TP + row) * DM + col) = w;
        }
        if (BOTH(4)) GRID_BAR();
    }
    if (IN(5)) {
        { pg8::Gemm g{KWS(bf16, WS_H1), KWS(bf16, WS_WUP), TP, DFF, DM, DM}; pg8::StaticOrder S; S.init(TP, DFF, F.G, (int)blockIdx.x, WGM_P5);
          pg8::EpiUp E{KSSQ(CW_SSQ1), KWS(bf16, WS_U)};
          if (!(args.pad & 32)) pg8::gemm_phase<pg8::EpiUp, pg8::StaticOrder, true, true>(F.lds + RING_OFF, g, S, E, F.wave); }
        if (!(args.pad & 16)) {
            const SkUp E{KSSQ(CW_SSQ1), KWS(bf16, WS_U)};
            for (int i = (int)blockIdx.x; i < DFF / 64; i += F.G) sk::skinny_item(sk::Item{i, 0, DM / 64, 0}, KWS(bf16, WS_H1) + (size_t)TP * DM, DM, KWS(bf16, WS_WUP), DM / 64, E, (LAS char*)(F.lds + RING_OFF), F.wave);
        }
        if (BOTH(5)) GRID_BAR();
    }
    if (IN(6)) {
        { pg8::Gemm g{KWS(bf16, WS_U), KWS(bf16, WS_WDOWN), TP, DM, DFF, DFF}; pg8::StaticOrder S; S.init(TP, DM, F.G, (int)blockIdx.x, WGM_P6);
          pg8::EpiDown E{KWS(bf16, WS_X1), KWS(bf16, WS_X2B), KSSQ(CW_SSQ2)};
          if (!(args.pad & 32)) pg8::gemm_phase<pg8::EpiDown, pg8::StaticOrder, true, true>(F.lds + RING_OFF, g, S, E, F.wave); }
        if (!(args.pad & 16)) {
            const SkPartial E{KWS(float, WS_PART4), DM};
            for (int i = (int)blockIdx.x; i < (DM / 64) * SPL4; i += F.G) sk::skinny_item(sk::Item{i >> 2, (i & 3) * (DFF / 64 / SPL4), DFF / 64 / SPL4, i & 3}, KWS(bf16, WS_U) + (size_t)TP * DFF, DFF, KWS(bf16, WS_WDOWN), DFF / 64, E, (LAS char*)(F.lds + RING_OFF), F.wave);
        }
        if (BOTH(6)) GRID_BAR();
    }
    if (IN(7)) {
        unsigned bad = __hip_atomic_load(F.ctl + CW_BAR + XB_TMO, RLX_AGENT);
        const float poison = bad ? __builtin_nanf("") : 0.f; float* out = karg_out(); const float* g_final = KIN(18); const float* SSQ2 = KSSQ(CW_SSQ2);
        const int lane = lane_now();
        for (int m = gw; m < TS; m += NGW) {
            const float* PART = KWS(float, WS_PART4); const GAS f32x4* xr = (const GAS f32x4*)(KWS(float, WS_X1S) + (size_t)m * DM) + lane;
            f32x4 v[16]; float s = 0.f;
#pragma unroll
            for (int j = 0; j < 16; ++j) v[j] = xr[64 * j];
#pragma unroll 1
            for (int ks = 0; ks < SPL4; ++ks) { const GAS f32x4* pr = (const GAS f32x4*)(PART + ((size_t)ks * TS + m) * DM) + lane;
#pragma unroll
                for (int j = 0; j < 16; ++j) v[j] += pr[64 * j]; }
#pragma unroll
            for (int j = 0; j < 16; ++j) s += (v[j].x * v[j].x + v[j].y * v[j].y) + (v[j].z * v[j].z + v[j].w * v[j].w);
            const float rs = 1.0f / sqrtf(wave_sum(s) * (1.f / DM) + EPS) + poison;
            GAS f32x4* yr = (GAS f32x4*)(out + OUT_Y + (size_t)(TP + m) * DM) + lane; const GAS f32x4* gr = (const GAS f32x4*)g_final + lane;
#pragma unroll
            for (int j = 0; j < 16; ++j) yr[64 * j] = v[j] * rs * gr[64 * j];
        }
        const bf16* X2B = KWS(bf16, WS_X2B);
        for (int m = gw; m < TP; m += NGW) {
            const float rs = 1.0f / sqrtf(SSQ2[m] * (1.f / DM) + EPS) + poison;
            const GAS v4u* xr = (const GAS v4u*)(X2B + (size_t)m * DM) + lane; GAS f32x4* yr = (GAS f32x4*)(out + OUT_Y + (size_t)m * DM) + 2 * lane; const GAS f32x4* gr = (const GAS f32x4*)g_final + 2 * lane;
#pragma unroll
            for (int j = 0; j < 8; ++j) { const v4u w = xr[64 * j]; const f32x4 g0 = gr[128 * j], g1 = gr[128 * j + 1];
                yr[128 * j] = (f32x4){pg8::bf_lo(w.x), pg8::bf_hi(w.x), pg8::bf_lo(w.y), pg8::bf_hi(w.y)} * rs * g0; yr[128 * j + 1] = (f32x4){pg8::bf_lo(w.z), pg8::bf_hi(w.z), pg8::bf_lo(w.w), pg8::bf_hi(w.w)} * rs * g1; }
        }
    }
#undef IN
#undef BOTH
#undef GRID_BAR
}

extern "C" void kernel_launch(void* const* d_in, const int* in_sizes, int n_in, void* d_out, int out_size, void* d_ws, size_t ws_size, hipStream_t stream) {
    static int grid = 0;
    if (grid == 0) {
        if (n_in != 19 || in_sizes[0] != TP * DM || (size_t)out_size != OUT_TOTAL || ws_size < WS_END) {
            fprintf(stderr, "kernel_launch: shape mismatch (n_in %d, in0 %d, out %d, ws %zu; need ws >= %zu); nothing launched\n", n_in, n_in > 0 ? in_sizes[0] : -1, out_size, ws_size, (size_t)WS_END); grid = -1; return; }
        int dev = 0, cus = 0, per_cu = 0;
        if (hipGetDevice(&dev) != hipSuccess || hipDeviceGetAttribute(&cus, hipDeviceAttributeMultiprocessorCount, dev) != hipSuccess) { grid = -1; return; }
        if (hipFuncSetAttribute((const void*)hybrid_fwd, hipFuncAttributeMaxDynamicSharedMemorySize, LDS_BYTES) != hipSuccess) { fprintf(stderr, "kernel_launch: hipFuncSetAttribute failed\n"); grid = -1; return; }
        if (hipOccupancyMaxActiveBlocksPerMultiprocessor(&per_cu, (const void*)hybrid_fwd, NWAVES * 64, LDS_BYTES) != hipSuccess || per_cu < 1) { fprintf(stderr, "kernel_launch: occupancy query reports %d blocks per CU\n", per_cu); grid = -1; (void)hipGetLastError(); return; }
        (void)hipGetLastError();
        grid = cus;
    }
    if (grid < 0) return;
    if (hipMemsetAsync((char*)d_ws + WS_CTL, 0, CTL_ZERO_BYTES, stream) != hipSuccess) return;
    Args a{};
    for (int i = 0; i < 19; ++i) a.in[i] = (const float*)d_in[i];
    a.out = (float*)d_out; a.ws = (unsigned char*)d_ws;
#ifndef DUP_MASK
#define DUP_MASK 0
#endif
    for (int li = 0; li < N_LAUNCHES; ++li) {
        a.ph_lo = (N_LAUNCHES == 1) ? 0 : li; a.ph_hi = (N_LAUNCHES == 1) ? N_PHASES : li + 1; a.li = li; a.pad = 0;
        if (N_LAUNCHES != 1 && ((DUP_MASK >> li) & 1)) hipLaunchKernelGGL(hybrid_fwd, dim3(grid), dim3(NWAVES * 64), LDS_BYTES, stream, a);
#ifdef DUP_SUB
#ifndef DUP_PH
#define DUP_PH 2
#endif
        if (N_LAUNCHES != 1 && li == DUP_PH) { a.pad = DUP_SUB; hipLaunchKernelGGL(hybrid_fwd, dim3(grid), dim3(NWAVES * 64), LDS_BYTES, stream, a); a.pad = 0;
            (void)hipMemsetAsync((char*)d_ws + WS_CTL + CW_BQ * 4, 0, (CW_AQ + 64 * 8 - CW_BQ) * 4, stream); }
#endif
        hipLaunchKernelGGL(hybrid_fwd, dim3(grid), dim3(NWAVES * 64), LDS_BYTES, stream, a);
        const hipError_t le = hipPeekAtLastError();
        if (le != hipSuccess) { fprintf(stderr, "kernel_launch: launch %d failed: %s\n", li, hipGetErrorName(le)); break; }
    }
}
```

```cpp
#ifndef MK_N_LAUNCHES
#define MK_N_LAUNCHES 1
#endif
#include <hip/hip_runtime.h>
#include <cstdio>
#include <cstdint>
#include <cmath>
namespace pg8 {
#define PG8_LAS __attribute__((address_space(3)))
typedef unsigned short bf16_t;
typedef short bf16x8 __attribute__((ext_vector_type(8)));
typedef float f32x4 __attribute__((ext_vector_type(4)));
typedef unsigned u32x4 __attribute__((ext_vector_type(4)));
constexpr int BM = 256, BK = 64, HALF = 128, HTB = HALF * BK * 2  , STAGE_BYTES = 8 * HTB, NXCD = 8, WGM = 8;

__host__ __device__ __forceinline__ int lds_byte(int r, int c) { const int st = (r >> 4) * 2 + (c >> 5), rr = r & 15, cc = c & 31, ob = rr * 64 + cc * 2; return st * 1024 + (ob ^ (((ob >> 9) & 1) << 5)); }
__host__ __device__ __forceinline__ void stage_rc(int b, int& R, int& C) { const int st = b / 1024, sb = b % 1024, swz = sb ^ (((sb >> 9) & 1) << 5); R = (st >> 1) * 16 + swz / 64; C = (st & 1) * 32 + (swz % 64) / 2; }
__host__ __device__ __forceinline__ int perm32(int rho) { const int n = rho >> 4, i = rho & 15; return 8 * (i >> 2) + 4 * n + (i & 3); }

struct Unit { int pm, pn, kofs, ks; };
struct Gemm { const bf16_t* A; const bf16_t* Bt; int M, N, K, ld; };

struct StaticOrder {
    int nM, nN, nwg, G, c, wgm;
    __host__ __device__ void init(int M, int N, int G_, int c_, int wgm_ = WGM) { nM = M / BM; nN = N / BM; nwg = nM * nN; G = G_; c = c_; wgm = wgm_; }
    __host__ __device__ bool next(int i, Unit& u) const {
        const long L = (long)i * G + c; if (L >= nwg) return false;
        int wgid = (int)L; { const int q = nwg / NXCD, r = nwg % NXCD, xcd = wgid % NXCD, off = wgid / NXCD; wgid = (xcd < r ? xcd * (q + 1) : r * (q + 1) + (xcd - r) * q) + off; }
        const int nig = wgm * nN, gid = wgid / nig, fm = gid * wgm, gsz = (nM - fm) < wgm ? (nM - fm) : wgm;
        u.pm = fm + ((wgid % nig) % gsz); u.pn = (wgid % nig) / gsz; u.kofs = 0; u.ks = 0; return true;
    }
    __device__ __forceinline__ void a_ready(const Unit&) const {}
    __device__ __forceinline__ void done(const Unit&) const {}
};
struct MiniOrder {
    int nN, nsplit, ksl, G, c, pm;
    __host__ __device__ void init(int N, int nsplit_, int ksl_, int G_, int c_, int pm_) { nN = N / BM; nsplit = nsplit_; ksl = ksl_; G = G_; c = c_; pm = pm_; }
    __host__ __device__ bool next(int i, Unit& u) const {
        const long L = (long)i * G + c; if (L >= (long)nN * nsplit) return false;
        const int m = (int)L; u.pm = pm; u.pn = m / nsplit; u.ks = m % nsplit; u.kofs = u.ks * ksl; return true;
    }
    __device__ __forceinline__ void a_ready(const Unit&) const {}
    __device__ __forceinline__ void done(const Unit&) const {}
};


typedef float f32x2_cv __attribute__((ext_vector_type(2))); typedef __bf16 bf16x2_cv __attribute__((ext_vector_type(2)));
__device__ __forceinline__ unsigned cvt_pk_bf16(float lo, float hi) { f32x2_cv v = {lo, hi}; bf16x2_cv b = __builtin_convertvector(v, bf16x2_cv); return __builtin_bit_cast(unsigned, b); }
typedef float f32x2 __attribute__((ext_vector_type(2)));
constexpr int E_DM = 4096, E_TP = 8192, E_MROWS = 8448, E_HW = 2048, E_DFF = 16384;
constexpr float E_EPS = 1e-6f;
__device__ __forceinline__ float dot4(const f32x4 a) { return (a[0] * a[0] + a[1] * a[1]) + (a[2] * a[2] + a[3] * a[3]); }
__device__ __forceinline__ void ssq_add(float* p, float v) { __hip_atomic_fetch_add(p, v, __ATOMIC_RELAXED, __HIP_MEMORY_SCOPE_AGENT); }

struct EpiInProj {
    static constexpr bool PERM = true, AFTER_DRAIN = false;
    bf16_t* qkv;
    float* out_kvp;
    float* out_kvs;
    const float* rope;
    __device__ __forceinline__ void operator()(f32x4 (&acc)[2][2][4][2], const Unit& u, int wr, int wc, int fr, int fq) const {
        const int t = u.pn >> 3;
        const int col0 = (u.pn & 7) * BM + wc * 32 + 8 * fq;
        const int row0 = u.pm * BM + wr * 64 + fr;
        bf16_t* base = qkv + (size_t)t * ((size_t)E_MROWS * E_HW);
        float* fo = nullptr;
        if (t == 1 || t == 2 || t == 4 || t == 5) {
            const int idx = (t == 1) ? 0 : (t == 2) ? 1 : (t == 4) ? 2 : 3;
            fo = (u.pm < 32) ? out_kvp + (size_t)idx * ((size_t)E_TP * E_HW) : out_kvs + (size_t)idx * (256 * E_HW) - (size_t)E_TP * E_HW;
        }
        if ((t < 2) && (wc == 0)) {
            const float sgn = (fq < 2) ? -1.f : 1.f;
#pragma unroll
            for (int ai = 0; ai < 2; ++ai)
#pragma unroll
                for (int m = 0; m < 4; ++m) {
                    const float* rp = rope + (size_t)(row0 + ai * HALF + m * 16) * 32 + 8 * (fq & 1);
                    const f32x4 c0 = *(const f32x4*)(rp), c1 = *(const f32x4*)(rp + 4), s0 = *(const f32x4*)(rp + 16), s1 = *(const f32x4*)(rp + 20);
#pragma unroll
                    for (int bj = 0; bj < 2; ++bj)
#pragma unroll
                        for (int n = 0; n < 2; ++n)
#pragma unroll
                            for (int j = 0; j < 4; ++j) {
                                const float mine = acc[ai][bj][m][n][j], other = __shfl_xor(mine, 32);
                                const float cc = n ? c1[j] : c0[j], ss = n ? s1[j] : s0[j];
                                acc[ai][bj][m][n][j] = mine * cc + sgn * other * ss;
                            }
                }
            asm volatile("" ::: "memory");
        }
#pragma unroll
        for (int ai = 0; ai < 2; ++ai)
#pragma unroll
            for (int m = 0; m < 4; ++m) {
                const int row = row0 + ai * HALF + m * 16;
#pragma unroll
                for (int bj = 0; bj < 2; ++bj) {
                    const f32x4 v0 = acc[ai][bj][m][0], v1 = acc[ai][bj][m][1];
                    u32x4 w; w.x = cvt_pk_bf16(v0[0], v0[1]); w.y = cvt_pk_bf16(v0[2], v0[3]); w.z = cvt_pk_bf16(v1[0], v1[1]); w.w = cvt_pk_bf16(v1[2], v1[3]);
                    *(u32x4*)(base + (size_t)row * E_HW + col0 + bj * HALF) = w;
                }
                if (fo) {
#pragma unroll
                    for (int bj = 0; bj < 2; ++bj) { float* p = fo + (size_t)row * E_HW + col0 + bj * HALF; *(f32x4*)p = acc[ai][bj][m][0]; *(f32x4*)(p + 4) = acc[ai][bj][m][1]; }
                }
            }
    }
};

struct EpiOutProj {
    static constexpr bool PERM = true, AFTER_DRAIN = false;
    const float* xp; const float* xs; const float* g; bf16_t* x1b; bf16_t* h1; float* ssq;
    __device__ __forceinline__ void operator()(f32x4 (&acc)[2][2][4][2], const Unit& u, int wr, int wc, int fr, int fq) const {
        const int col0 = u.pn * BM + wc * 32 + 8 * fq;
        const int row0 = u.pm * BM + wr * 64 + fr;
        f32x4 gv[2][2];
#pragma unroll
        for (int bj = 0; bj < 2; ++bj) { gv[bj][0] = *(const f32x4*)(g + col0 + bj * HALF); gv[bj][1] = *(const f32x4*)(g + col0 + bj * HALF + 4); }
#pragma unroll
        for (int ai = 0; ai < 2; ++ai) {
            f32x4 r[4][2][2];
#pragma unroll
            for (int m = 0; m < 4; ++m) {
                const int row = row0 + ai * HALF + m * 16;
                const float* xrow = (row < E_TP) ? xp + (size_t)row * E_DM : xs + (size_t)(row - E_TP) * E_DM;
#pragma unroll
                for (int bj = 0; bj < 2; ++bj) { r[m][bj][0] = *(const f32x4*)(xrow + col0 + bj * HALF); r[m][bj][1] = *(const f32x4*)(xrow + col0 + bj * HALF + 4); }
            }
#pragma unroll
            for (int m = 0; m < 4; ++m)
#pragma unroll
                for (int bj = 0; bj < 2; ++bj) { acc[ai][bj][m][0] += r[m][bj][0]; acc[ai][bj][m][1] += r[m][bj][1]; }
#pragma unroll
            for (int m = 0; m < 4; ++m)
#pragma unroll
                for (int bj = 0; bj < 2; ++bj) asm volatile("" : "+v"(acc[ai][bj][m][0]), "+v"(acc[ai][bj][m][1]));
            asm volatile("" ::: "memory");
        }
#pragma unroll
        for (int ai = 0; ai < 2; ++ai)
#pragma unroll
            for (int m = 0; m < 4; ++m) {
                const int row = row0 + ai * HALF + m * 16;
                float s = 0.f;
#pragma unroll
                for (int bj = 0; bj < 2; ++bj) {
                    const f32x4 v0 = acc[ai][bj][m][0], v1 = acc[ai][bj][m][1];
                    { u32x4 w; w.x = cvt_pk_bf16(v0[0], v0[1]); w.y = cvt_pk_bf16(v0[2], v0[3]); w.z = cvt_pk_bf16(v1[0], v1[1]); w.w = cvt_pk_bf16(v1[2], v1[3]); *(u32x4*)(x1b + (size_t)row * E_DM + col0 + bj * HALF) = w; }
                    s += dot4(v0) + dot4(v1);
                    const f32x4 a = v0 * gv[bj][0], b = v1 * gv[bj][1];
                    u32x4 w; w.x = cvt_pk_bf16(a[0], a[1]); w.y = cvt_pk_bf16(a[2], a[3]); w.z = cvt_pk_bf16(b[0], b[1]); w.w = cvt_pk_bf16(b[2], b[3]);
                    *(u32x4*)(h1 + (size_t)row * E_DM + col0 + bj * HALF) = w;
                }
                s += __shfl_xor(s, 16); s += __shfl_xor(s, 32);
                if (fq == 0) ssq_add(ssq + row, s);
                if (m & 1) asm volatile("" ::: "memory");
            }
    }
};

struct EpiUp {
    static constexpr bool PERM = true, AFTER_DRAIN = false;
    const float* ssq; bf16_t* U;
    __device__ __forceinline__ void operator()(const f32x4 (&acc)[2][2][4][2], const Unit& u, int wr, int wc, int fr, int fq) const {
        const int col0 = u.pn * BM + wc * 32 + 8 * fq;
        const int row0 = u.pm * BM + wr * 64 + fr;
        float rs[2][4];
#pragma unroll
        for (int ai = 0; ai < 2; ++ai)
#pragma unroll
            for (int m = 0; m < 4; ++m) rs[ai][m] = ssq[row0 + ai * HALF + m * 16];
        asm volatile("" ::: "memory");
#pragma unroll
        for (int ai = 0; ai < 2; ++ai)
#pragma unroll
            for (int m = 0; m < 4; ++m) {
                const int row = row0 + ai * HALF + m * 16;
                const float r = __builtin_amdgcn_rsqf(rs[ai][m] * (1.0f / E_DM) + E_EPS);
#pragma unroll
                for (int bj = 0; bj < 2; ++bj) {
                    f32x4 a = acc[ai][bj][m][0] * r, b = acc[ai][bj][m][1] * r;
#pragma unroll
                    for (int j = 0; j < 4; ++j) { const float x = fmaxf(a[j], 0.f), y = fmaxf(b[j], 0.f); a[j] = x * x; b[j] = y * y; }
                    u32x4 w; w.x = cvt_pk_bf16(a[0], a[1]); w.y = cvt_pk_bf16(a[2], a[3]); w.z = cvt_pk_bf16(b[0], b[1]); w.w = cvt_pk_bf16(b[2], b[3]);
                    *(u32x4*)(U + (size_t)row * E_DFF + col0 + bj * HALF) = w;
                }
            }
    }
};

__device__ __forceinline__ float bf_lo(unsigned w) { return __uint_as_float(w << 16); }
__device__ __forceinline__ float bf_hi(unsigned w) { return __uint_as_float(w & 0xffff0000u); }
struct EpiDown {
    static constexpr bool PERM = true, AFTER_DRAIN = false;
    const bf16_t* x1b; bf16_t* x2b; float* ssq;
    __device__ __forceinline__ void operator()(f32x4 (&acc)[2][2][4][2], const Unit& u, int wr, int wc, int fr, int fq) const {
        const int col0 = u.pn * BM + wc * 32 + 8 * fq;
        const int row0 = u.pm * BM + wr * 64 + fr;
#pragma unroll
        for (int ai = 0; ai < 2; ++ai)
#pragma unroll
            for (int m = 0; m < 4; ++m) {
                const int row = row0 + ai * HALF + m * 16;
#pragma unroll
                for (int bj = 0; bj < 2; ++bj) {
                    const u32x4 r = *(const u32x4*)(x1b + (size_t)row * E_DM + col0 + bj * HALF);
                    acc[ai][bj][m][0] += (f32x4){bf_lo(r.x), bf_hi(r.x), bf_lo(r.y), bf_hi(r.y)}; acc[ai][bj][m][1] += (f32x4){bf_lo(r.z), bf_hi(r.z), bf_lo(r.w), bf_hi(r.w)};
                }
            }
        asm volatile("" ::: "memory");
#pragma unroll
        for (int ai = 0; ai < 2; ++ai)
#pragma unroll
            for (int m = 0; m < 4; ++m) {
                const int row = row0 + ai * HALF + m * 16;
                float s = 0.f;
#pragma unroll
                for (int bj = 0; bj < 2; ++bj) {
                    const f32x4 v0 = acc[ai][bj][m][0], v1 = acc[ai][bj][m][1];
                    u32x4 w; w.x = cvt_pk_bf16(v0[0], v0[1]); w.y = cvt_pk_bf16(v0[2], v0[3]); w.z = cvt_pk_bf16(v1[0], v1[1]); w.w = cvt_pk_bf16(v1[2], v1[3]);
                    *(u32x4*)(x2b + (size_t)row * E_DM + col0 + bj * HALF) = w;
                    s += dot4(v0) + dot4(v1);
                }
                s += __shfl_xor(s, 16); s += __shfl_xor(s, 32);
                if (fq == 0) ssq_add(ssq + row, s);
                if (m & 1) asm volatile("" ::: "memory");
            }
    }
};

struct EpiPartial {
    static constexpr bool PERM = true, AFTER_DRAIN = false;
    float* part; int N;
    __device__ __forceinline__ void operator()(const f32x4 (&acc)[2][2][4][2], const Unit& u, int wr, int wc, int fr, int fq) const {
        const int col0 = u.pn * BM + wc * 32 + 8 * fq;
        float* base = part + ((size_t)u.ks * BM + wr * 64 + fr) * N + col0;
#pragma unroll
        for (int ai = 0; ai < 2; ++ai)
#pragma unroll
            for (int m = 0; m < 4; ++m)
#pragma unroll
                for (int bj = 0; bj < 2; ++bj) { float* p = base + (size_t)(ai * HALF + m * 16) * N + bj * HALF; *(f32x4*)p = acc[ai][bj][m][0]; *(f32x4*)(p + 4) = acc[ai][bj][m][1]; }
    }
};

template <class Epi, class Sched, bool ALIGN_EPI = false, bool SP2 = false>
__device__ __forceinline__ void gemm_phase(PG8_LAS unsigned char* lds, const Gemm g, const Sched& S, const Epi& E) {
    int tid = threadIdx.x; asm volatile("" : "+v"(tid));
    const int wid = __builtin_amdgcn_readfirstlane(tid >> 6), lane = tid & 63, wr = wid >> 2, wc = wid & 3, fr = lane & 15, fq = lane >> 4;
    const int K = g.ld, nt = g.K / BK;
    unsigned voffA[2], voffB[2];
#pragma unroll
    for (int i = 0; i < 2; ++i) { int R, C; stage_rc(tid * 16 + i * 8192, R, C); const int Rb = Epi::PERM ? ((R & ~31) + perm32(R & 31)) : R;
        voffA[i] = (unsigned)(R * K + C) * 2u; voffB[i] = (unsigned)(Rb * BK + C) * 2u; }
    const size_t kstep = (size_t)(BK * 2);
    const size_t hstep = (size_t)HALF * K * 2;
    const size_t tstep = 2 * hstep;
    const size_t kstepB = (size_t)BM * BK * 2, hstepB = (size_t)HALF * BK * 2, tstepB = (size_t)(K / BK) * kstepB;
    const unsigned ldsw = (unsigned)wid * 1024u;
    const int aoff = lds_byte(wr * 64 + fr, fq * 8), boff = lds_byte(wc * 32 + fr, fq * 8);
#define PG8_SA(b, h) (((b) * 2 + (h)) * HTB)
#define PG8_SB(b, h) ((4 + (b) * 2 + (h)) * HTB)
#define PG8_STAGE(bufoff, gbase, voff) do { _Pragma("unroll") for (int _i = 0; _i < 2; ++_i) \
        __builtin_amdgcn_global_load_lds((const unsigned*)((const char*)(gbase) + (voff)[_i]), (PG8_LAS unsigned*)(lds + (bufoff) + ldsw + _i * 8192), 16, 0, 0); } while (0)
#define PG8_LDA(dst, b, h) do { _Pragma("unroll") for (int m = 0; m < 4; ++m) _Pragma("unroll") for (int k = 0; k < 2; ++k) dst[m][k] = *(const PG8_LAS bf16x8*)(lds + PG8_SA(b, h) + aoff + m * 2048 + k * 1024); } while (0)
#define PG8_LDB(dst, b, h) do { _Pragma("unroll") for (int n = 0; n < 2; ++n) _Pragma("unroll") for (int k = 0; k < 2; ++k) dst[n][k] = *(const PG8_LAS bf16x8*)(lds + PG8_SB(b, h) + boff + n * 2048 + k * 1024); } while (0)
#define PG8_MMA(ai, bj, At, Bt) do { __builtin_amdgcn_s_setprio(1); _Pragma("unroll") for (int m = 0; m < 4; ++m) _Pragma("unroll") for (int n = 0; n < 2; ++n) _Pragma("unroll") for (int k = 0; k < 2; ++k) \
        acc[ai][bj][m][n] = __builtin_amdgcn_mfma_f32_16x16x32_bf16(Bt[n][k], At[m][k], acc[ai][bj][m][n], 0, 0, 0); __builtin_amdgcn_s_setprio(0); } while (0)
#define PG8_WAIT_V(n) asm volatile("s_waitcnt vmcnt(" #n ")" ::: "memory")
#define PG8_WAIT_L(n) asm volatile("s_waitcnt lgkmcnt(" #n ")" ::: "memory")
#define PG8_BAR __builtin_amdgcn_s_barrier()
#define PG8_SCHED __builtin_amdgcn_sched_barrier(0)
    Unit cur, nxt; int ui = 0;
    if (!S.next(0, cur)) return;
    f32x4 acc[2][2][4][2];
#pragma unroll
    for (int a = 0; a < 2; ++a)
#pragma unroll
        for (int b = 0; b < 2; ++b)
#pragma unroll
            for (int m = 0; m < 4; ++m)
#pragma unroll
                for (int n = 0; n < 2; ++n) acc[a][b][m][n] = (f32x4){0.f, 0.f, 0.f, 0.f};
    bf16x8 At[4][2], B0[2][2], B1[2][2];
    const char* cA = (const char*)g.A + (size_t)cur.pm * tstep + (size_t)cur.kofs * 2; const char* cB = (const char*)g.Bt + (size_t)cur.pn * tstepB + (size_t)(cur.kofs / BK) * kstepB;
    S.a_ready(cur);
    if constexpr (SP2) {
        PG8_STAGE(PG8_SB(0, 0), cB, voffB); PG8_STAGE(PG8_SB(0, 1), cB + hstepB, voffB); PG8_STAGE(PG8_SA(0, 0), cA, voffA); PG8_STAGE(PG8_SA(0, 1), cA + hstep, voffA);
        if (wr == 1) PG8_BAR;
        PG8_WAIT_V(2); PG8_BAR;
        PG8_STAGE(PG8_SB(1, 0), cB + kstepB, voffB); PG8_STAGE(PG8_SA(1, 0), cA + kstep, voffA); PG8_STAGE(PG8_SB(1, 1), cB + hstepB + kstepB, voffB);
        PG8_WAIT_V(6); PG8_BAR;
    } else {
        PG8_STAGE(PG8_SB(0, 0), cB, voffB); PG8_STAGE(PG8_SA(0, 0), cA, voffA); PG8_STAGE(PG8_SB(0, 1), cB + hstepB, voffB); PG8_STAGE(PG8_SA(0, 1), cA + hstep, voffA);
        if (wr == 1) PG8_BAR;
        PG8_WAIT_V(4); PG8_BAR;
        PG8_STAGE(PG8_SB(1, 0), cB + kstepB, voffB); PG8_STAGE(PG8_SA(1, 0), cA + kstep, voffA); PG8_STAGE(PG8_SB(1, 1), cB + hstepB + kstepB, voffB);
        PG8_WAIT_V(6); PG8_BAR;
    }
    for (;;) {
        const bool has_next = S.next(ui + 1, nxt);
        const char* nA = has_next ? (const char*)g.A + (size_t)nxt.pm * tstep + (size_t)nxt.kofs * 2 : cA; const char* nB = has_next ? (const char*)g.Bt + (size_t)nxt.pn * tstepB + (size_t)(nxt.kofs / BK) * kstepB : cB;
        for (int t = 0; t < nt; t += 2) {
            const bool last = (t == nt - 2);
            const char* a1 = cA + (size_t)(t + 1) * kstep;
            const char* a2 = last ? nA : cA + (size_t)(t + 2) * kstep; const char* b2 = last ? nB : cB + (size_t)(t + 2) * kstepB;
            const char* a3 = a2 + kstep; const char* b3 = b2 + kstepB;
            if (last && has_next) S.a_ready(nxt);
            if constexpr (SP2) {
            PG8_LDB(B0, 0, 0); PG8_LDB(B1, 0, 1); PG8_SCHED; PG8_LDA(At, 0, 0); PG8_STAGE(PG8_SA(1, 1), a1 + hstep, voffA);
            PG8_WAIT_V(8); PG8_WAIT_L(0); PG8_BAR; PG8_MMA(0, 0, At, B0); PG8_MMA(0, 1, At, B1); PG8_BAR; PG8_SCHED;
            PG8_LDA(At, 0, 1); PG8_STAGE(PG8_SB(0, 0), b2, voffB); PG8_STAGE(PG8_SB(0, 1), b2 + hstepB, voffB); PG8_STAGE(PG8_SA(0, 0), a2, voffA);
            PG8_WAIT_V(8); PG8_WAIT_L(0); PG8_BAR; PG8_MMA(1, 0, At, B0); PG8_MMA(1, 1, At, B1); PG8_BAR; PG8_SCHED;
            PG8_LDB(B0, 1, 0); PG8_LDB(B1, 1, 1); PG8_SCHED; PG8_LDA(At, 1, 0); PG8_STAGE(PG8_SA(0, 1), a2 + hstep, voffA);
            PG8_WAIT_V(8); PG8_WAIT_L(0); PG8_BAR; PG8_MMA(0, 0, At, B0); PG8_MMA(0, 1, At, B1); PG8_BAR; PG8_SCHED;
            PG8_LDA(At, 1, 1); PG8_STAGE(PG8_SB(1, 0), b3, voffB); PG8_STAGE(PG8_SB(1, 1), b3 + hstepB, voffB); PG8_STAGE(PG8_SA(1, 0), a3, voffA);
            PG8_WAIT_V(8); PG8_WAIT_L(0); PG8_BAR; PG8_MMA(1, 0, At, B0); PG8_MMA(1, 1, At, B1); PG8_BAR; PG8_SCHED;
            } else {
            PG8_LDB(B0, 0, 0); PG8_SCHED; PG8_LDA(At, 0, 0); PG8_STAGE(PG8_SA(1, 1), a1 + hstep, voffA);
            PG8_WAIT_L(8); PG8_BAR; PG8_WAIT_L(0); PG8_MMA(0, 0, At, B0); PG8_BAR; PG8_SCHED;
            PG8_LDB(B1, 0, 1); PG8_STAGE(PG8_SB(0, 0), b2, voffB);
            PG8_BAR; PG8_WAIT_L(0); PG8_MMA(0, 1, At, B1); PG8_BAR;
            PG8_LDA(At, 0, 1); PG8_STAGE(PG8_SA(0, 0), a2, voffA);
            PG8_BAR; PG8_WAIT_L(0); PG8_MMA(1, 0, At, B0); PG8_BAR; PG8_SCHED;
            PG8_STAGE(PG8_SB(0, 1), b2 + hstepB, voffB);
            PG8_WAIT_V(6); PG8_BAR; PG8_MMA(1, 1, At, B1); PG8_BAR;
            PG8_LDB(B0, 1, 0); PG8_SCHED; PG8_LDA(At, 1, 0); PG8_STAGE(PG8_SA(0, 1), a2 + hstep, voffA);
            PG8_WAIT_L(8); PG8_BAR; PG8_WAIT_L(0); PG8_MMA(0, 0, At, B0); PG8_BAR; PG8_SCHED;
            PG8_LDB(B1, 1, 1); PG8_STAGE(PG8_SB(1, 0), b3, voffB);
            PG8_BAR; PG8_WAIT_L(0); PG8_MMA(0, 1, At, B1); PG8_BAR;
            PG8_LDA(At, 1, 1); PG8_STAGE(PG8_SA(1, 0), a3, voffA);
            PG8_BAR; PG8_WAIT_L(0); PG8_MMA(1, 0, At, B0); PG8_BAR; PG8_SCHED;
            PG8_STAGE(PG8_SB(1, 1), b3 + hstepB, voffB);
            PG8_WAIT_V(6); PG8_BAR; PG8_MMA(1, 1, At, B1); PG8_BAR;
            }
        }
        if constexpr (ALIGN_EPI) { if (wr == 0) PG8_BAR; }
        if constexpr (!Epi::AFTER_DRAIN) { E(acc, cur, wr, wc, fr, fq); S.done(cur); }
        if (!has_next) break;
#pragma unroll
        for (int a = 0; a < 2; ++a)
#pragma unroll
            for (int b = 0; b < 2; ++b)
#pragma unroll
                for (int m = 0; m < 4; ++m)
#pragma unroll
                    for (int n = 0; n < 2; ++n) acc[a][b][m][n] = (f32x4){0.f, 0.f, 0.f, 0.f};
        cur = nxt; cA = nA; cB = nB; ++ui;
        if constexpr (ALIGN_EPI) { if (wr == 1) PG8_BAR; }
    }
    PG8_WAIT_V(0);
    if constexpr (!ALIGN_EPI) { if (wr == 0) PG8_BAR; }
    PG8_BAR;
    if constexpr (Epi::AFTER_DRAIN) { E.fused(acc, cur, wr, wc, fr, fq, lds, wid, lane); S.done(cur); }
#undef PG8_SA
#undef PG8_SB
#undef PG8_STAGE
#undef PG8_LDA
#undef PG8_LDB
#undef PG8_MMA
#undef PG8_WAIT_V
#undef PG8_WAIT_L
#undef PG8_BAR
#undef PG8_SCHED
}
}
namespace att {
#define ALAS __attribute__((address_space(3)))
typedef unsigned short bf16;
using bf16x8 = __attribute__((ext_vector_type(8))) short;
using s16x4  = __attribute__((ext_vector_type(4))) short;
using f32x16 = __attribute__((ext_vector_type(16))) float;
using f32x8  = __attribute__((ext_vector_type(8))) float;
using f32x4  = __attribute__((ext_vector_type(4))) float;
using u32x4  = __attribute__((ext_vector_type(4))) unsigned;
constexpr int D = 128, NW = 8, QBLK = 32, KVBLK = 64;
constexpr float SCALE = 0.088388347648318440f;
constexpr float LOG2E = 1.4426950408889634f, LN2 = 0.6931471805599453f;
constexpr float THR = 8.f;
constexpr int HW = 2048;
constexpr int DMODEL = 4096, TP = 8192;
constexpr float EPS = 1e-6f;
constexpr int SHM_V = KVBLK * D * 2, SHM_K = KVBLK * D * 2;
#define KSWZ(row, colB) ((row) * 256 + ((colB) ^ (((row) & 7) << 4)))
#define SBAR() __builtin_amdgcn_sched_barrier(0)
__device__ __forceinline__ int crow(int r, int hi) { return (r & 3) + 8 * (r >> 2) + 4 * hi; }
typedef float f32x2_cv __attribute__((ext_vector_type(2))); typedef __bf16 bf16x2_cv __attribute__((ext_vector_type(2)));
__device__ __forceinline__ unsigned cvtpk(float lo, float hi) { f32x2_cv v = {lo, hi}; bf16x2_cv b = __builtin_convertvector(v, bf16x2_cv); return __builtin_bit_cast(unsigned, b); }
__device__ __forceinline__ bf16x8 ld8bf(const bf16* p) { return *reinterpret_cast<const bf16x8*>(p); }
__device__ __forceinline__ f32x8 ld8f(const float* p) { return *reinterpret_cast<const f32x8*>(p); }
__device__ __forceinline__ bf16x8 tobf(f32x8 x) { u32x4 w = {cvtpk(x[0], x[1]), cvtpk(x[2], x[3]), cvtpk(x[4], x[5]), cvtpk(x[6], x[7])}; return *reinterpret_cast<bf16x8*>(&w); }
__device__ __forceinline__ bf16x8 ld8any(const bf16* p) { return ld8bf(p); }
__device__ __forceinline__ bf16x8 ld8any(const float* p) { return tobf(ld8f(p)); }
__device__ __forceinline__ float swap32(float x, int hi) {
    auto rr = __builtin_amdgcn_permlane32_swap(__float_as_uint(x), __float_as_uint(x), false, false);
    return __uint_as_float(hi ? rr[0] : rr[1]);
}

__device__ __forceinline__ void glds16(const void* gsrc, unsigned lds_dst) { unsigned keep;
  asm volatile("s_mov_b32 %0, m0\n\ts_mov_b32 m0, %2\n\ts_nop 0\n\tglobal_load_lds_dwordx4 %1, off\n\ts_mov_b32 m0, %0" : "=&s"(keep) : "v"(gsrc), "s"(lds_dst) : "memory"); }
__device__ __forceinline__ void partialSM(f32x16& p0, f32x16& p1, float& m_reg, float& mn, float& alpha, float msk = 0.f) {
  constexpr float C = SCALE * LOG2E;
  float pmax = p0[0];
#pragma unroll
  for (int r = 1; r < 16; ++r) pmax = fmaxf(pmax, p0[r]);
#pragma unroll
  for (int r = 0; r < 16; ++r) pmax = fmaxf(pmax, p1[r]);
  { auto rr = __builtin_amdgcn_permlane32_swap(__float_as_uint(pmax), __float_as_uint(pmax), false, false);
    pmax = fmaxf(__uint_as_float(rr[0]), __uint_as_float(rr[1])) + msk; }
  if (__builtin_expect(__all(pmax - m_reg <= THR / SCALE), 1)) { mn = m_reg; alpha = 1.f; }
  else { mn = fmaxf(m_reg, pmax); alpha = __builtin_amdgcn_exp2f((m_reg - mn) * C); m_reg = mn; }
  float mnC = -mn * C + msk;
#pragma unroll
  for (int r = 0; r < 16; ++r) p0[r] = fmaf(p0[r], C, mnC);
#pragma unroll
  for (int r = 0; r < 16; ++r) p1[r] = fmaf(p1[r], C, mnC);
#pragma unroll
  for (int r = 0; r < 16; ++r) p0[r] = __builtin_amdgcn_exp2f(p0[r]);
}
#define PK4(P, BASE, OUT) do { unsigned a0 = cvtpk(P[BASE + 0], P[BASE + 1]), a1 = cvtpk(P[BASE + 2], P[BASE + 3]);   \
    unsigned b0 = cvtpk(P[BASE + 4], P[BASE + 5]), b1 = cvtpk(P[BASE + 6], P[BASE + 7]);                              \
    auto r0 = __builtin_amdgcn_permlane32_swap(a0, b0, false, false); auto r1 = __builtin_amdgcn_permlane32_swap(a1, b1, false, false); \
    u32x4 w = {r0[0], r1[0], r0[1], r1[1]}; OUT = *reinterpret_cast<bf16x8*>(&w); } while (0)
__device__ __forceinline__ void finishSM(f32x16& p0, f32x16& p1, float alpha, float& l_reg, bf16x8& pa0, bf16x8& pa1, bf16x8& pa2, bf16x8& pa3) {
#pragma unroll
  for (int r = 0; r < 16; ++r) p1[r] = __builtin_amdgcn_exp2f(p1[r]);
  float ps = 0;
#pragma unroll
  for (int r = 0; r < 16; ++r) ps += p0[r];
#pragma unroll
  for (int r = 0; r < 16; ++r) ps += p1[r];
  { auto rr = __builtin_amdgcn_permlane32_swap(__float_as_uint(ps), __float_as_uint(ps), false, false);
    ps = __uint_as_float(rr[0]) + __uint_as_float(rr[1]); }
  l_reg = l_reg * alpha + ps;
  PK4(p0, 0, pa0); PK4(p0, 8, pa1); PK4(p1, 0, pa2); PK4(p1, 8, pa3);
}
__device__ __forceinline__ void qkt(f32x16& p0, f32x16& p1, const ALAS char* Ks, const bf16x8* qr, int r32, int hi) {
  p0 = f32x16{}; p1 = f32x16{};
#pragma unroll
  for (int d0 = 0; d0 < 8; ++d0) { int cb = (d0 * 16 + hi * 8) * 2;
    bf16x8 b0 = *reinterpret_cast<const ALAS bf16x8*>(Ks + KSWZ(r32, cb));
    bf16x8 b1 = *reinterpret_cast<const ALAS bf16x8*>(Ks + KSWZ(32 + r32, cb));
    p0 = __builtin_amdgcn_mfma_f32_32x32x16_bf16(b0, qr[d0], p0, 0, 0, 0);
    p1 = __builtin_amdgcn_mfma_f32_32x32x16_bf16(b1, qr[d0], p1, 0, 0, 0); }
}
template <int NQR>
__device__ __forceinline__ void qkt_h(f32x16& p0, f32x16& p1, const ALAS char* Ks, const bf16x8* qr, const ALAS char* Qs, int qrow, int r32, int hi) {
  p0 = f32x16{}; p1 = f32x16{};
#pragma unroll
  for (int d0 = 0; d0 < 8; ++d0) { int cb = (d0 * 16 + hi * 8) * 2;
    bf16x8 b0 = *reinterpret_cast<const ALAS bf16x8*>(Ks + KSWZ(r32, cb));
    bf16x8 b1 = *reinterpret_cast<const ALAS bf16x8*>(Ks + KSWZ(32 + r32, cb));
    bf16x8 q = d0 < NQR ? qr[d0] : *reinterpret_cast<const ALAS bf16x8*>(Qs + KSWZ(qrow, cb));
    p0 = __builtin_amdgcn_mfma_f32_32x32x16_bf16(b0, q, p0, 0, 0, 0);
    p1 = __builtin_amdgcn_mfma_f32_32x32x16_bf16(b1, q, p1, 0, 0, 0); }
}
__device__ __forceinline__ int v_st(int k, int c) { const int kk = (k & ~0xC) | ((k & 4) << 1) | ((k & 8) >> 1); return ((kk >> 3) * 4 + (c >> 5)) * 512 + ((kk & 7) * 32 + (c & 31)) * 2; }
__device__ __forceinline__ int v_rd_base(int lane) { return ((lane & 3) << 3) | (((lane >> 2) & 3) << 6) | (((lane >> 4) & 1) << 5) | (((lane >> 5) & 1) << 8); }
constexpr int v_rd_off(int d0, int ks, int half) { return d0 * 512 + ks * 4096 + half * 2048; }
template <int OFF> __device__ __forceinline__ s16x4 tr_read(int vb) {
  s16x4 r; asm volatile("ds_read_b64_tr_b16 %0, %1 offset:%2" : "=&v"(r) : "v"(vb), "i"(OFF) : "memory"); return r;
}
template <int D0> __device__ __forceinline__ void pv_one(f32x16& od, int vb, bf16x8 pa0, bf16x8 pa1, bf16x8 pa2, bf16x8 pa3) {
  const s16x4 l0 = tr_read<v_rd_off(D0, 0, 0)>(vb), h0 = tr_read<v_rd_off(D0, 0, 1)>(vb), l1 = tr_read<v_rd_off(D0, 1, 0)>(vb), h1 = tr_read<v_rd_off(D0, 1, 1)>(vb);
  const s16x4 l2 = tr_read<v_rd_off(D0, 2, 0)>(vb), h2 = tr_read<v_rd_off(D0, 2, 1)>(vb), l3 = tr_read<v_rd_off(D0, 3, 0)>(vb), h3 = tr_read<v_rd_off(D0, 3, 1)>(vb);
  asm volatile("s_waitcnt lgkmcnt(0)" ::: "memory"); SBAR();
#define PK(L, H) (bf16x8){L[0], L[1], L[2], L[3], H[0], H[1], H[2], H[3]}
  od = __builtin_amdgcn_mfma_f32_32x32x16_bf16(pa0, PK(l0, h0), od, 0, 0, 0);
  od = __builtin_amdgcn_mfma_f32_32x32x16_bf16(pa1, PK(l1, h1), od, 0, 0, 0);
  od = __builtin_amdgcn_mfma_f32_32x32x16_bf16(pa2, PK(l2, h2), od, 0, 0, 0);
  od = __builtin_amdgcn_mfma_f32_32x32x16_bf16(pa3, PK(l3, h3), od, 0, 0, 0);
#undef PK
}
__device__ __forceinline__ void pv_d0(f32x16* o, int vb, bf16x8 pa0, bf16x8 pa1, bf16x8 pa2, bf16x8 pa3) {
  pv_one<0>(o[0], vb, pa0, pa1, pa2, pa3); pv_one<1>(o[1], vb, pa0, pa1, pa2, pa3); pv_one<2>(o[2], vb, pa0, pa1, pa2, pa3); pv_one<3>(o[3], vb, pa0, pa1, pa2, pa3);
}
__device__ __forceinline__ void fill_neg(f32x16& p0, f32x16& p1) {
#pragma unroll
  for (int r = 0; r < 16; ++r) { p0[r] = -1e30f; p1[r] = -1e30f; }
}

constexpr int SHM_QOFF = 2 * SHM_V + 2 * SHM_K + NW * 64 * 4, SHM_ATTN = SHM_QOFF + 256 * 256;
constexpr int NQR = 8;
__device__ __forceinline__ void attnA_prompt_unit(int vh, int qb, const bf16* __restrict__ AQ, const bf16* __restrict__ AK, const bf16* __restrict__ AV, float* __restrict__ OA, ALAS char* lds) {
  int tid = threadIdx.x; asm volatile("" : "+v"(tid));
  const int wid = __builtin_amdgcn_readfirstlane(tid >> 6), lane = tid & 63, r32 = lane & 31, hi = lane >> 5;
  const int h = vh >> 2, c = (vh >> 1) & 1, vhalf = vh & 1;
  const bf16* Qb = AQ + (size_t)(qb * 256) * HW + h * 256 + c * 128;
  const bf16* Kh = AK + h * 256 + c * 128;
  const bf16* Vh = AV + h * 256 + vhalf * 128;
  float* Ob = OA + (size_t)(qb * 256) * DMODEL + h * 512 + c * 256 + vhalf * 128;
  const int NT = 4 * qb + 4, jmax = 4 * qb + (wid >> 1);
  ALAS char* V_lds = lds; ALAS char* K_lds = lds + 2 * SHM_V;
  ALAS float* ws = (ALAS float*)(lds + 2 * SHM_V + 2 * SHM_K) + wid * 64; ALAS float* li_l = ws; ALAS float* al_l = ws + 32;
  float m_reg = -1e30f, l_reg = 0; f32x16 o[4] = {}; bf16x8 qr[NQR];
  const bf16* Qw = Qb + (size_t)(wid * QBLK + r32) * HW + hi * 8;
  ALAS char* Q_lds = lds + SHM_QOFF; const int qrow = wid * QBLK + r32;
#pragma unroll
  for (int d0 = 0; d0 < 8; ++d0) { const bf16x8 q = ld8bf(Qw + d0 * 16); if (d0 < NQR) qr[d0] = q; else *(ALAS bf16x8*)(Q_lds + KSWZ(qrow, (d0 * 16 + hi * 8) * 2)) = q; }
  const int sr = tid >> 4, sc = (tid & 15) * 8, vst0 = v_st(sr, sc), vst1 = v_st(32 + sr, sc);
  const int vb0 = (int)(unsigned)(uintptr_t)V_lds + v_rd_base(lane);
  constexpr int SDEPTH = 1;
  struct { bf16x8 vs0, vs1, ks0, ks1; } sr_[SDEPTH];
  const unsigned lo0 = (unsigned)(sr * HW + sc) * 2u, lo1 = lo0 + 32u * HW * 2u;
#define SLOAD(i, k0) do { const char* kb_ = (const char*)Kh + (size_t)(k0) * (HW * 2); const char* vb_ = (const char*)Vh + (size_t)(k0) * (HW * 2); \
    sr_[i].vs0 = *(const bf16x8*)(vb_ + lo0); sr_[i].vs1 = *(const bf16x8*)(vb_ + lo1); sr_[i].ks0 = *(const bf16x8*)(kb_ + lo0); sr_[i].ks1 = *(const bf16x8*)(kb_ + lo1); } while (0)
#define SWRITE(b, i) do { *(ALAS bf16x8*)(V_lds + (b) * SHM_V + vst0) = sr_[i].vs0;          \
    *(ALAS bf16x8*)(V_lds + (b) * SHM_V + vst1) = sr_[i].vs1; int kc = sc * 2;               \
    *(ALAS bf16x8*)(K_lds + (b) * SHM_K + KSWZ(sr, kc)) = sr_[i].ks0;                       \
    *(ALAS bf16x8*)(K_lds + (b) * SHM_K + KSWZ(32 + sr, kc)) = sr_[i].ks1; } while (0)
#define SWAIT() do { if constexpr (SDEPTH == 2) asm volatile("s_waitcnt vmcnt(4)" ::: "memory"); else asm volatile("s_waitcnt vmcnt(0)" ::: "memory"); } while (0)
#define RESC(a) do { if (__any((a) < 1.f)) { if (hi == 0) al_l[r32] = (a); asm volatile("s_waitcnt lgkmcnt(0)" ::: "memory"); \
    _Pragma("unroll") for (int d = 0; d < 4; ++d) _Pragma("unroll") for (int r = 0; r < 16; ++r) o[d][r] *= al_l[crow(r, hi)]; } } while (0)
#define QKT_M(P0, P1, KS, j) qkt_h<NQR>(P0, P1, KS, qr, Q_lds, qrow, r32, hi)
#define MSK(j) (((j) <= jmax) ? 0.f : -1e30f)
  f32x16 pA0, pA1, pB0, pB1; float mnA, mnB, alA, alB; bf16x8 pa0, pa1, pa2, pa3;
  constexpr int SE = 0, SO = SDEPTH - 1;
  SLOAD(SE, 0); asm volatile("s_waitcnt vmcnt(0)" ::: "memory"); SWRITE(0, SE); __syncthreads();
  QKT_M(pA0, pA1, K_lds, 0); partialSM(pA0, pA1, m_reg, mnA, alA);
  SLOAD(SO, KVBLK); if constexpr (SDEPTH == 2) { if (2 < NT) SLOAD(SE, 2 * KVBLK); }
  SWAIT(); SWRITE(1, SO); __syncthreads();
  for (int j = 1; j + 1 < NT; j += 2) {
    SBAR(); QKT_M(pB0, pB1, K_lds + SHM_K, j);
    finishSM(pA0, pA1, alA, l_reg, pa0, pa1, pa2, pa3); SBAR();
    SLOAD(SO, (j + SDEPTH) * KVBLK); SBAR();
    pv_d0(o, vb0, pa0, pa1, pa2, pa3); partialSM(pB0, pB1, m_reg, mnB, alB, MSK(j));
    __syncthreads(); SWAIT(); SWRITE(0, SE);
    RESC(alB); __syncthreads();
    SBAR(); QKT_M(pA0, pA1, K_lds, j + 1);
    finishSM(pB0, pB1, alB, l_reg, pa0, pa1, pa2, pa3); SBAR();
    if (SDEPTH == 1 || j + 3 < NT) SLOAD(SE, (j + 1 + SDEPTH) * KVBLK); SBAR();
    pv_d0(o, vb0 + SHM_V, pa0, pa1, pa2, pa3); partialSM(pA0, pA1, m_reg, mnA, alA, MSK(j + 1));
    __syncthreads(); SWAIT(); SWRITE(1, SO);
    RESC(alA); __syncthreads();
  }
  SBAR(); QKT_M(pB0, pB1, K_lds + SHM_K, NT - 1);
  finishSM(pA0, pA1, alA, l_reg, pa0, pa1, pa2, pa3); SBAR();
  pv_d0(o, vb0, pa0, pa1, pa2, pa3); partialSM(pB0, pB1, m_reg, mnB, alB, MSK(NT - 1));
  __syncthreads(); RESC(alB);
  finishSM(pB0, pB1, alB, l_reg, pa0, pa1, pa2, pa3); SBAR();
  pv_d0(o, vb0 + SHM_V, pa0, pa1, pa2, pa3);
  if (hi == 0) li_l[r32] = l_reg; asm volatile("s_waitcnt lgkmcnt(0)" ::: "memory");
  float rli[16];
#pragma unroll
  for (int r = 0; r < 16; ++r) rli[r] = __builtin_amdgcn_rcpf(li_l[crow(r, hi)]);
  float* Ow = Ob + (size_t)(wid * QBLK) * DMODEL;
#pragma unroll
  for (int r = 0; r < 16; ++r) { int orow = crow(r, hi);
#pragma unroll
    for (int d0 = 0; d0 < 4; ++d0) Ow[(size_t)orow * DMODEL + d0 * 32 + r32] = o[d0][r] * rli[r]; }
  __syncthreads();
#undef SLOAD
#undef SWRITE
#undef SWAIT
#undef QKT_M
#undef MSK
}

constexpr int X_KB = 0, X_VB = 32768, X_WS = 131072, X_LDS = X_WS + NW * 64 * 4;
__device__ __forceinline__ void attnA_prompt_unit2(int h, int qb, const bf16* __restrict__ AQ, const bf16* __restrict__ AK, const bf16* __restrict__ AV, float lam, const float* __restrict__ g_subln, float post,
                                                   bf16* __restrict__ O, ALAS char* lds) {
  int tid = threadIdx.x; asm volatile("" : "+v"(tid));
  const int wid = __builtin_amdgcn_readfirstlane(tid >> 6), lane = tid & 63, r32 = lane & 31, hi = lane >> 5;
  const int c = wid >> 2, wq = wid & 3;
  const int NT = 4 * qb + 4, jmax = 4 * qb + 2 * (wq >> 1) + 1;
  ALAS float* ws = (ALAS float*)(lds + X_WS) + wid * 64; ALAS float* li_l = ws; ALAS float* al_l = ws + 32;
  bf16x8 qr[8];
  { const bf16* Qw = AQ + (size_t)(qb * 128 + wq * 32) * HW + h * 256 + c * 128; const unsigned qo = (unsigned)(r32 * HW + hi * 8) * 2u;
#pragma unroll
    for (int d0 = 0; d0 < 8; ++d0) qr[d0] = *(const bf16x8*)((const char*)Qw + qo + d0 * 32);
#pragma unroll
    for (int d0 = 0; d0 < 8; ++d0) asm volatile("" : "+v"(qr[d0])); }
  const char* Kg = (const char*)(AK + h * 256); const char* Vg = (const char*)(AV + h * 256);
  unsigned koff, voff;
  { const int row = 4 * wid + (lane >> 4), cs = lane & 15; koff = (unsigned)(row * (HW * 2) + ((cs ^ (row & 7)) * 16));
    const int sub = 2 * wid + (lane >> 5), kk = (sub >> 2) * 8 + ((lane & 31) >> 2), k = (kk & ~0xC) | ((kk & 4) << 1) | ((kk & 8) >> 1), c8 = (sub & 3) * 4 + (lane & 3);
    voff = (unsigned)(k * (HW * 2) + c8 * 16); }
  const unsigned lds0 = (unsigned)(uintptr_t)lds;
#define X_DMA(j) do { const size_t to_ = (size_t)(j) * (32 * HW * 2); const unsigned sl_ = (unsigned)__builtin_amdgcn_readfirstlane((int)(lds0 + ((j) & 3) * 32768 + wid * 1024)); \
    glds16(Kg + to_ + koff, sl_); glds16(Kg + to_ + 256 + koff, sl_ + 8192); glds16(Vg + to_ + voff, sl_ + 16384); glds16(Vg + to_ + 256 + voff, sl_ + 24576); } while (0)
  float m_reg = -1e30f, l_reg = 0.f; f32x16 o[8] = {};
  constexpr float C = SCALE * LOG2E;
  bf16x8 pa0, pa1;
#define X_BAR() asm volatile("s_waitcnt lgkmcnt(0)\n\ts_barrier" ::: "memory")
#define X_QK(j) \
    f32x16 p = {}; \
    { const ALAS char* Ks = lds + ((j) & 3) * 32768 + c * 8192; f32x16 p2 = {}; \
      _Pragma("unroll") for (int d0 = 0; d0 < 8; d0 += 2) { const bf16x8 kf = *reinterpret_cast<const ALAS bf16x8*>(Ks + KSWZ(r32, (d0 * 16 + hi * 8) * 2)); const bf16x8 kg = *reinterpret_cast<const ALAS bf16x8*>(Ks + KSWZ(r32, ((d0 + 1) * 16 + hi * 8) * 2)); \
        p = __builtin_amdgcn_mfma_f32_32x32x16_bf16(kf, qr[d0], p, 0, 0, 0); p2 = __builtin_amdgcn_mfma_f32_32x32x16_bf16(kg, qr[d0 + 1], p2, 0, 0, 0); } \
      _Pragma("unroll") for (int r = 0; r < 16; ++r) p[r] += p2[r]; } \
    const float msk = ((j) <= jmax) ? 0.f : -1e30f; \
    float pmax = p[0]; \
    _Pragma("unroll") for (int r = 1; r < 16; ++r) pmax = fmaxf(pmax, p[r]); \
    { auto rr = __builtin_amdgcn_permlane32_swap(__float_as_uint(pmax), __float_as_uint(pmax), false, false); pmax = fmaxf(__uint_as_float(rr[0]), __uint_as_float(rr[1])) + msk; } \
    float mn, alpha; bool resc = false; \
    if (__builtin_expect(__all(pmax - m_reg <= THR / SCALE), 1)) { mn = m_reg; alpha = 1.f; } \
    else { mn = fmaxf(m_reg, pmax); alpha = __builtin_amdgcn_exp2f((m_reg - mn) * C); m_reg = mn; resc = true; } \
    const float mnC = -mn * C + msk; float ps = 0.f;
#define X_EXP2(r0) do { p[r0] = __builtin_amdgcn_exp2f(fmaf(p[r0], C, mnC)); p[(r0) + 1] = __builtin_amdgcn_exp2f(fmaf(p[(r0) + 1], C, mnC)); ps += p[r0]; ps += p[(r0) + 1]; } while (0)
#define X_FIN() do { \
    { auto rr = __builtin_amdgcn_permlane32_swap(__float_as_uint(ps), __float_as_uint(ps), false, false); ps = __uint_as_float(rr[0]) + __uint_as_float(rr[1]); } \
    l_reg = l_reg * alpha + ps; \
    if (resc) { if (hi == 0) al_l[r32] = alpha; asm volatile("s_waitcnt lgkmcnt(0)" ::: "memory"); \
      _Pragma("unroll") for (int d = 0; d < 8; ++d) _Pragma("unroll") for (int r = 0; r < 16; ++r) o[d][r] *= al_l[crow(r, hi)]; } \
    PK4(p, 0, pa0); PK4(p, 8, pa1); } while (0)
#define X_RD4(A, IMG, D0) do { A[0] = tr_read<(IMG) * 8192 + v_rd_off(D0, 0, 0)>(vb); A[1] = tr_read<(IMG) * 8192 + v_rd_off(D0, 0, 1)>(vb); A[2] = tr_read<(IMG) * 8192 + v_rd_off(D0, 1, 0)>(vb); A[3] = tr_read<(IMG) * 8192 + v_rd_off(D0, 1, 1)>(vb); } while (0)
#define X_MM2(D8, A) do { o[D8] = __builtin_amdgcn_mfma_f32_32x32x16_bf16(pa0, (bf16x8){A[0][0], A[0][1], A[0][2], A[0][3], A[1][0], A[1][1], A[1][2], A[1][3]}, o[D8], 0, 0, 0); \
        o[D8] = __builtin_amdgcn_mfma_f32_32x32x16_bf16(pa1, (bf16x8){A[2][0], A[2][1], A[2][2], A[2][3], A[3][0], A[3][1], A[3][2], A[3][3]}, o[D8], 0, 0, 0); } while (0)
#define X_W(n) do { asm volatile("s_waitcnt lgkmcnt(" #n ")" ::: "memory"); SBAR(); } while (0)
  X_DMA(0); X_DMA(1);
  {
    asm volatile("s_waitcnt vmcnt(4)" ::: "memory"); X_BAR(); X_DMA(2);
    X_QK(0)
    X_EXP2(0); X_EXP2(2); X_EXP2(4); X_EXP2(6); X_EXP2(8); X_EXP2(10); X_EXP2(12); X_EXP2(14);
    X_FIN(); }
  for (int j = 1; j < NT; ++j) {
    if (j + 1 < NT) asm volatile("s_waitcnt vmcnt(4)" ::: "memory"); else asm volatile("s_waitcnt vmcnt(0)" ::: "memory");
    X_BAR();
    if (j + 2 < NT) X_DMA(j + 2);
    X_QK(j)
    SBAR();
    { const int vb = (int)(unsigned)(uintptr_t)(lds + ((j - 1) & 3) * 32768 + 16384) + v_rd_base(lane);
      s16x4 va[4], vc[4];
      X_RD4(va, 0, 0); X_RD4(vc, 0, 1); X_W(4); X_MM2(0, va); X_EXP2(0); SBAR();
      X_RD4(va, 0, 2); X_W(4); X_MM2(1, vc); X_EXP2(2); SBAR();
      X_RD4(vc, 0, 3); X_W(4); X_MM2(2, va); X_EXP2(4); SBAR();
      X_RD4(va, 1, 0); X_W(4); X_MM2(3, vc); X_EXP2(6); SBAR();
      X_RD4(vc, 1, 1); X_W(4); X_MM2(4, va); X_EXP2(8); SBAR();
      X_RD4(va, 1, 2); X_W(4); X_MM2(5, vc); X_EXP2(10); SBAR();
      X_RD4(vc, 1, 3); X_W(4); X_MM2(6, va); X_EXP2(12); SBAR();
      X_W(0); X_MM2(7, vc); X_EXP2(14); SBAR(); }
    X_FIN();
  }
  {
    const int vb = (int)(unsigned)(uintptr_t)(lds + ((NT - 1) & 3) * 32768 + 16384) + v_rd_base(lane);
    s16x4 va[4], vc[4];
    X_RD4(va, 0, 0); X_RD4(vc, 0, 1); X_W(4); X_MM2(0, va); SBAR();
    X_RD4(va, 0, 2); X_W(4); X_MM2(1, vc); SBAR();
    X_RD4(vc, 0, 3); X_W(4); X_MM2(2, va); SBAR();
    X_RD4(va, 1, 0); X_W(4); X_MM2(3, vc); SBAR();
    X_RD4(vc, 1, 1); X_W(4); X_MM2(4, va); SBAR();
    X_RD4(va, 1, 2); X_W(4); X_MM2(5, vc); SBAR();
    X_RD4(vc, 1, 3); X_W(4); X_MM2(6, va); SBAR();
    X_W(0); X_MM2(7, vc); SBAR(); }
#undef X_BAR
#undef X_QK
#undef X_EXP2
#undef X_FIN
#undef X_RD4
#undef X_MM2
#undef X_W
  __syncthreads();
  if (hi == 0) li_l[r32] = l_reg; asm volatile("s_waitcnt lgkmcnt(0)" ::: "memory");
  float rli[16];
#pragma unroll
  for (int r = 0; r < 16; ++r) rli[r] = __builtin_amdgcn_rcpf(li_l[crow(r, hi)]);
  ALAS float* XL = (ALAS float*)(lds) + wq * 8192;
  if (c == 1) {
#pragma unroll
    for (int r = 0; r < 16; ++r) { const float f = rli[r] * lam;
#pragma unroll
      for (int d = 0; d < 8; ++d) XL[crow(r, hi) * 256 + d * 32 + r32] = o[d][r] * f; }
  }
  __syncthreads();
  if (c == 0) {
    float gs[8];
#pragma unroll
    for (int d = 0; d < 8; ++d) gs[d] = g_subln[d * 32 + r32] * post;
#pragma unroll
    for (int r = 0; r < 16; ++r) { const int q = crow(r, hi); float ss = 0.f;
#pragma unroll
      for (int d = 0; d < 8; ++d) { const float v = o[d][r] * rli[r] - XL[q * 256 + d * 32 + r32]; o[d][r] = v; ss += v * v; }
#pragma unroll
      for (int m = 1; m < 32; m <<= 1) ss += __shfl_xor(ss, m);
      const float rs = __builtin_amdgcn_rsqf(ss * (1.0f / 256.0f) + EPS);
#pragma unroll
      for (int d = 0; d < 8; ++d) o[d][r] *= rs * gs[d]; }
    asm volatile("s_waitcnt lgkmcnt(0)" ::: "memory");
    ALAS bf16* stg = (ALAS bf16*)XL;
#pragma unroll
    for (int r = 0; r < 16; ++r) { const int q = crow(r, hi);
#pragma unroll
      for (int d = 0; d < 8; ++d) stg[q * 256 + d * 32 + r32] = (bf16)(cvtpk(o[d][r], 0.f) & 0xffffu); }
    asm volatile("s_waitcnt lgkmcnt(0)" ::: "memory");
    bf16* Ow = O + (size_t)(qb * 128 + wq * 32) * DMODEL + h * 256;
#pragma unroll
    for (int i = 0; i < 16; ++i) { const int id = i * 64 + lane, row = id >> 5, ch = id & 31; const u32x4 v = *(const ALAS u32x4*)(stg + row * 256 + ch * 8); *(u32x4*)(Ow + (size_t)row * DMODEL + ch * 8) = v; }
    asm volatile("s_waitcnt lgkmcnt(0)" ::: "memory");
  }
  __syncthreads();
#undef X_DMA
}

constexpr int SA_KB = 0, SA_VB = 65536, SA_WS = 131072, SA_LDS = SA_WS + NW * 64 * 4;
__device__ __forceinline__ void attnA_sample_unit(int b, int h, const float* __restrict__ cak, const float* __restrict__ cav, const float* __restrict__ nak, const float* __restrict__ nav,
                                                  const bf16* __restrict__ AQ, float lam, const float* __restrict__ g_subln, float post, bf16* __restrict__ O, ALAS char* lds) {
  int tid = threadIdx.x; asm volatile("" : "+v"(tid));
  const int wid = __builtin_amdgcn_readfirstlane(tid >> 6), lane = tid & 63, r32 = lane & 31, hi = lane >> 5;
  const int c = wid & 1, vq = wid >> 1;
  ALAS float* ws = (ALAS float*)(lds + SA_WS) + wid * 64; ALAS float* li_l = ws; ALAS float* al_l = ws + 32;
  bf16x8 qr[8];
  { const bf16* Qw = AQ + (size_t)(TP + b * 16 + (r32 & 15)) * HW + h * 256 + c * 128 + hi * 8;
#pragma unroll
    for (int d0 = 0; d0 < 8; ++d0) qr[d0] = ld8bf(Qw + d0 * 16); }
  const int sr = tid >> 3, sk = (tid & 7) * 16, sv = (tid & 7) * 32;
  f32x8 kreg[4], vreg[4];
#define SA_LOAD(j) do { if ((j) < 32) { const size_t ro = ((size_t)(b * 2048 + (j) * 64 + sr) * 8 + h) * 256; \
      kreg[0] = ld8f(cak + ro + sk); kreg[1] = ld8f(cak + ro + sk + 8); kreg[2] = ld8f(cak + ro + 128 + sk); kreg[3] = ld8f(cak + ro + 128 + sk + 8); \
      vreg[0] = ld8f(cav + ro + sv); vreg[1] = ld8f(cav + ro + sv + 8); vreg[2] = ld8f(cav + ro + sv + 16); vreg[3] = ld8f(cav + ro + sv + 24); } \
    else if (sr < 16) { const size_t ro = ((size_t)(b * 16 + sr) * 8 + h) * 256; \
      kreg[0] = ld8f(nak + ro + sk); kreg[1] = ld8f(nak + ro + sk + 8); kreg[2] = ld8f(nak + ro + 128 + sk); kreg[3] = ld8f(nak + ro + 128 + sk + 8); \
      vreg[0] = ld8f(nav + ro + sv); vreg[1] = ld8f(nav + ro + sv + 8); vreg[2] = ld8f(nav + ro + sv + 16); vreg[3] = ld8f(nav + ro + sv + 24); } \
    else { _Pragma("unroll") for (int i_ = 0; i_ < 4; ++i_) { kreg[i_] = f32x8{}; vreg[i_] = f32x8{}; } } } while (0)
#define SA_WRITE(buf) do { ALAS char* kb_ = lds + SA_KB + (buf) * 32768; ALAS char* vb_ = lds + SA_VB + (buf) * 32768 + (sv >> 7) * 16384; const int cv_ = sv & 127; \
    *(ALAS bf16x8*)(kb_ + KSWZ(sr, sk * 2)) = tobf(kreg[0]); *(ALAS bf16x8*)(kb_ + KSWZ(sr, (sk + 8) * 2)) = tobf(kreg[1]); \
    *(ALAS bf16x8*)(kb_ + 16384 + KSWZ(sr, sk * 2)) = tobf(kreg[2]); *(ALAS bf16x8*)(kb_ + 16384 + KSWZ(sr, (sk + 8) * 2)) = tobf(kreg[3]); \
    *(ALAS bf16x8*)(vb_ + v_st(sr, cv_)) = tobf(vreg[0]); *(ALAS bf16x8*)(vb_ + v_st(sr, cv_ + 8)) = tobf(vreg[1]); \
    *(ALAS bf16x8*)(vb_ + v_st(sr, cv_ + 16)) = tobf(vreg[2]); *(ALAS bf16x8*)(vb_ + v_st(sr, cv_ + 24)) = tobf(vreg[3]); } while (0)
  float m_reg = -1e30f, l_reg = 0.f; f32x16 o[2] = {};
  SA_LOAD(0); asm volatile("s_waitcnt vmcnt(0)" ::: "memory"); SA_WRITE(0); __syncthreads();
  for (int j = 0; j <= 32; ++j) {
    const int buf = j & 1;
    if (j < 32) SA_LOAD(j + 1);
    f32x16 p0, p1; float mn, alpha; bf16x8 pa0, pa1, pa2, pa3;
    qkt(p0, p1, lds + SA_KB + buf * 32768 + c * 16384, qr, r32, hi);
    if (j == 32) {
#pragma unroll
      for (int r = 0; r < 16; ++r) { if (crow(r, hi) >= 16) p0[r] = -1e30f; p1[r] = -1e30f; }
    }
    partialSM(p0, p1, m_reg, mn, alpha);
    if (__any(alpha < 1.f)) { if (hi == 0) al_l[r32] = alpha; asm volatile("s_waitcnt lgkmcnt(0)" ::: "memory");
#pragma unroll
      for (int d = 0; d < 2; ++d)
#pragma unroll
        for (int r = 0; r < 16; ++r) o[d][r] *= al_l[crow(r, hi)]; }
    finishSM(p0, p1, alpha, l_reg, pa0, pa1, pa2, pa3); SBAR();
    const int vb = (int)(unsigned)(uintptr_t)(lds + SA_VB + buf * 32768 + (vq >> 1) * 16384) + v_rd_base(lane);
    if (vq & 1) { pv_one<2>(o[0], vb, pa0, pa1, pa2, pa3); pv_one<3>(o[1], vb, pa0, pa1, pa2, pa3); }
    else        { pv_one<0>(o[0], vb, pa0, pa1, pa2, pa3); pv_one<1>(o[1], vb, pa0, pa1, pa2, pa3); }
    if (j < 32) { asm volatile("s_waitcnt vmcnt(0)" ::: "memory"); SA_WRITE(buf ^ 1); }
    __syncthreads();
  }
  if (hi == 0) li_l[r32] = l_reg; asm volatile("s_waitcnt lgkmcnt(0)" ::: "memory");
  ALAS float* OL = (ALAS float*)(lds + SA_KB);
#pragma unroll
  for (int r = 0; r < 8; ++r) { const int q = crow(r, hi); const float rl = __builtin_amdgcn_rcpf(li_l[q]);
#pragma unroll
    for (int dd = 0; dd < 2; ++dd) OL[(c * 16 + q) * 256 + vq * 64 + dd * 32 + r32] = o[dd][r] * rl; }
  __syncthreads();
  { const int q = tid >> 5, e0 = (tid & 31) * 8; float dv[8]; float ss = 0.f;
#pragma unroll
    for (int i = 0; i < 8; ++i) { dv[i] = OL[q * 256 + e0 + i] - lam * OL[(16 + q) * 256 + e0 + i]; ss += dv[i] * dv[i]; }
#pragma unroll
    for (int m = 1; m < 32; m <<= 1) ss += __shfl_xor(ss, m);
    const float rs = __builtin_amdgcn_rsqf(ss * (1.0f / 256.0f) + EPS) * post;
    u32x4 w; w.x = cvtpk(dv[0] * rs * g_subln[e0 + 0], dv[1] * rs * g_subln[e0 + 1]); w.y = cvtpk(dv[2] * rs * g_subln[e0 + 2], dv[3] * rs * g_subln[e0 + 3]);
    w.z = cvtpk(dv[4] * rs * g_subln[e0 + 4], dv[5] * rs * g_subln[e0 + 5]); w.w = cvtpk(dv[6] * rs * g_subln[e0 + 6], dv[7] * rs * g_subln[e0 + 7]);
    *(u32x4*)(O + (size_t)(TP + b * 16 + q) * DMODEL + h * 256 + e0) = w; }
  __syncthreads();
#undef SA_LOAD
#undef SA_WRITE
}

constexpr float SB_STOP = -104.0f;
__device__ __forceinline__ float softplus_f(float z) {
  const float e = __builtin_amdgcn_exp2f(-fabsf(z) * LOG2E);
  return fmaxf(z, 0.f) + LN2 * __builtin_amdgcn_logf(1.0f + e);
}
__device__ __forceinline__ void stick_half(f32x16& p, float& carry, int kbase, int kpos0, int qpos, int nvalid, bool need_mask, int hi) {
  float x[16];
#pragma unroll
  for (int r = 0; r < 16; ++r) {
    const float z = p[r] * SCALE; const float sp = softplus_f(z);
    bool ok = true;
    if (need_mask) { const int kl = kbase + crow(r, hi); ok = (kpos0 + kl < qpos) && (kl < nvalid); }
    x[r] = ok ? -sp : 0.f;
    p[r] = ok ? z - sp : -1e30f;
    if ((r & 3) == 3) SBAR();
  }
  float own[4], par[4], T[4], R[4];
#pragma unroll
  for (int g = 0; g < 4; ++g) { own[g] = (x[4 * g] + x[4 * g + 1]) + (x[4 * g + 2] + x[4 * g + 3]); par[g] = swap32(own[g], hi); T[g] = own[g] + par[g]; }
  R[3] = 0.f; R[2] = T[3]; R[1] = R[2] + T[2]; R[0] = R[1] + T[1];
#pragma unroll
  for (int g = 0; g < 4; ++g) {
    const float E = carry + R[g] + (hi == 0 ? par[g] : 0.f);
    const float w2 = x[4 * g + 3], w1 = w2 + x[4 * g + 2], w0 = w1 + x[4 * g + 1];
    p[4 * g + 3] = __builtin_amdgcn_exp2f((p[4 * g + 3] + E) * LOG2E); p[4 * g + 2] = __builtin_amdgcn_exp2f((p[4 * g + 2] + E + w2) * LOG2E);
    p[4 * g + 1] = __builtin_amdgcn_exp2f((p[4 * g + 1] + E + w1) * LOG2E); p[4 * g + 0] = __builtin_amdgcn_exp2f((p[4 * g + 0] + E + w0) * LOG2E);
    SBAR();
  }
  carry += R[0] + T[0];
}
template <typename TS>
__device__ __forceinline__ void stick_tile(f32x16 (&o)[4], float& carry, const bf16* __restrict__ Qw, const TS* __restrict__ Kt, const TS* __restrict__ Vt, int stride, int nvalid, int kpos0, int qpos,
                                           bool need_mask, ALAS char* vbuf, int lane, int r32, int hi) {
  constexpr bool SRC16 = sizeof(TS) == 2;
  f32x16 p0 = {}, p1 = {};
  { const int k0 = r32 < nvalid ? r32 : nvalid - 1, k1 = (32 + r32) < nvalid ? (32 + r32) : nvalid - 1;
    const TS* K0 = Kt + (size_t)k0 * stride + hi * 8; const TS* K1 = Kt + (size_t)k1 * stride + hi * 8;
    bf16x8 kf0[8], kf1[8], qr[8];
#pragma unroll
    for (int d0 = 0; d0 < 8; ++d0) qr[d0] = ld8bf(Qw + d0 * 16);
#pragma unroll
    for (int d0 = 0; d0 < 8; ++d0) kf0[d0] = ld8any(K0 + d0 * 16);
    if constexpr (SRC16) {
#pragma unroll
      for (int d0 = 0; d0 < 8; ++d0) kf1[d0] = ld8any(K1 + d0 * 16);
    }
#pragma unroll
    for (int d0 = 0; d0 < 8; ++d0) p0 = __builtin_amdgcn_mfma_f32_32x32x16_bf16(kf0[d0], qr[d0], p0, 0, 0, 0);
    if constexpr (!SRC16) {
      asm volatile("" ::: "memory");
#pragma unroll
      for (int d0 = 0; d0 < 8; ++d0) kf1[d0] = ld8any(K1 + d0 * 16);
    }
#pragma unroll
    for (int d0 = 0; d0 < 8; ++d0) p1 = __builtin_amdgcn_mfma_f32_32x32x16_bf16(kf1[d0], qr[d0], p1, 0, 0, 0);
  }
  asm volatile("" ::: "memory"); SBAR();
  const unsigned vsrc_off = (unsigned)(((lane >> 4) * stride + (lane & 15) * 8) * (int)sizeof(TS));
  const int vdst_off = (((lane & 15) * 8) >> 5) * 512 + ((lane >> 4) * 32 + (((lane & 15) * 8) & 31)) * 2;
  const int nvc = nvalid >> 2;
#define VSRC(i) ((const char*)Vt + (size_t)(((i) < nvc ? (i) : nvc - 1) * 4) * stride * sizeof(TS) + vsrc_off)
#define VDST(i) (vbuf + vdst_off + ((((i) & 1) + 2 * ((i) >> 2)) * 2048 + (((i) >> 1) & 1) * 256))
  bf16x8 vtb[16]; f32x8 vtf[4];
  if constexpr (SRC16) {
#pragma unroll
    for (int i = 0; i < 16; ++i) vtb[i] = *(const bf16x8*)VSRC(i);
  } else {
#pragma unroll
    for (int i = 0; i < 4; ++i) vtf[i] = *(const f32x8*)VSRC(i);
  }
  SBAR();
  bf16x8 pa0, pa1, pa2, pa3;
  stick_half(p1, carry, 32, kpos0, qpos, nvalid, need_mask, hi);
  PK4(p1, 0, pa2); PK4(p1, 8, pa3);
  stick_half(p0, carry, 0, kpos0, qpos, nvalid, need_mask, hi);
  PK4(p0, 0, pa0); PK4(p0, 8, pa1);
  if constexpr (SRC16) {
#pragma unroll
    for (int i = 0; i < 16; ++i) *(ALAS bf16x8*)VDST(i) = vtb[i];
  } else {
#pragma unroll
    for (int i = 0; i < 4; ++i) *(ALAS bf16x8*)VDST(i) = tobf(vtf[i]);
#pragma unroll
    for (int bt = 1; bt < 4; ++bt) {
#pragma unroll
      for (int i = 0; i < 4; ++i) vtf[i] = *(const f32x8*)VSRC(4 * bt + i);
#pragma unroll
      for (int i = 0; i < 4; ++i) *(ALAS bf16x8*)VDST(4 * bt + i) = tobf(vtf[i]);
    }
  }
#undef VSRC
#undef VDST
  asm volatile("s_waitcnt lgkmcnt(0)" ::: "memory"); SBAR();
  const int vb = (int)(unsigned)(uintptr_t)vbuf + v_rd_base(lane);
  pv_d0(o, vb, pa0, pa1, pa2, pa3);
}
__device__ __forceinline__ void stick_store(const f32x16 (&o)[4], const float* __restrict__ g_sb, bf16* __restrict__ Orow0, int nrows, ALAS char* vbuf, int lane, int r32, int hi) {
  float gs[4];
#pragma unroll
  for (int d0 = 0; d0 < 4; ++d0) gs[d0] = g_sb[d0 * 32 + r32];
  ALAS bf16* stg = (ALAS bf16*)vbuf;
#pragma unroll
  for (int r = 0; r < 16; ++r) {
    float ss = (o[0][r] * o[0][r] + o[1][r] * o[1][r]) + (o[2][r] * o[2][r] + o[3][r] * o[3][r]);
#pragma unroll
    for (int m = 1; m < 32; m <<= 1) ss += __shfl_xor(ss, m);
    const float rs = __builtin_amdgcn_rsqf(ss * (1.0f / 128.0f) + EPS);
    const int q = crow(r, hi);
#pragma unroll
    for (int d0 = 0; d0 < 4; ++d0) stg[q * 128 + d0 * 32 + r32] = (bf16)(cvtpk(o[d0][r] * rs * gs[d0], 0.f) & 0xffffu);
  }
  asm volatile("s_waitcnt lgkmcnt(0)" ::: "memory");
#pragma unroll
  for (int i = 0; i < 8; ++i) { const int id = i * 64 + lane, row = id >> 4, ch = id & 15;
    if (row < nrows) { const u32x4 v = *(const ALAS u32x4*)(stg + row * 128 + ch * 8); *(u32x4*)(Orow0 + (size_t)row * DMODEL + ch * 8) = v; } }
  asm volatile("s_waitcnt lgkmcnt(0)" ::: "memory");
}
__device__ __forceinline__ void stick_prompt_unit(int h, int qt, const bf16* __restrict__ BQ, const bf16* __restrict__ BK, const bf16* __restrict__ BV, const float* __restrict__ g_sb, bf16* __restrict__ O, ALAS char* vbuf) {
  int lane = threadIdx.x & 63; asm volatile("" : "+v"(lane)); const int r32 = lane & 31, hi = lane >> 5; const int t0 = 32 * qt;
  const bf16* Qw = BQ + (size_t)(t0 + r32) * HW + h * 128 + hi * 8;
  f32x16 o[4] = {}; float carry = 0.f; const int qpos = t0 + r32; const int jd = t0 >> 6;
  for (int j = jd; j >= 0; --j) {
    stick_tile<bf16>(o, carry, Qw, BK + (size_t)(64 * j) * HW + h * 128, BV + (size_t)(64 * j) * HW + h * 128, HW, 64, 64 * j, qpos, j == jd, vbuf, lane, r32, hi);
    if (__all(carry < SB_STOP)) break;
  }
  stick_store(o, g_sb, O + (size_t)t0 * DMODEL + 2048 + h * 128, 32, vbuf, lane, r32, hi);
}
__device__ __forceinline__ void stick_sample_unit(int b, int h, const bf16* __restrict__ BQ, const bf16* __restrict__ BK, const bf16* __restrict__ BV, const float* __restrict__ cbk, const float* __restrict__ cbv,
                                                  const float* __restrict__ g_sb, bf16* __restrict__ O, ALAS char* vbuf) {
  int lane = threadIdx.x & 63; asm volatile("" : "+v"(lane)); const int r32 = lane & 31, hi = lane >> 5; const size_t row0 = (size_t)TP + b * 16;
  const bf16* Qw = BQ + (row0 + (r32 & 15)) * HW + h * 128 + hi * 8;
  f32x16 o[4] = {}; float carry = 0.f; const int qpos = 2048 + (r32 & 15);
  stick_tile<bf16>(o, carry, Qw, BK + row0 * HW + h * 128, BV + row0 * HW + h * 128, HW, 16, 2048, qpos, true, vbuf, lane, r32, hi);
  for (int j = 31; j >= 0; --j) {
    if (__all(carry < SB_STOP)) break;
    const size_t ro = ((size_t)(b * 2048 + 64 * j) * 16 + h) * 128;
    stick_tile<float>(o, carry, Qw, cbk + ro, cbv + ro, 2048, 64, 64 * j, qpos, false, vbuf, lane, r32, hi);
  }
  stick_store(o, g_sb, O + row0 * DMODEL + 2048 + h * 128, 16, vbuf, lane, r32, hi);
}
#undef PK4
#undef SBAR
#undef RESC
}
namespace sk {
#define SLAS __attribute__((address_space(3)))
typedef unsigned short bf16;
using bf16x8 = __attribute__((ext_vector_type(8))) short;
using f32x16 = __attribute__((ext_vector_type(16))) float;
constexpr int SLOT = 40960, A_BYTES = 32768;
__device__ __forceinline__ int crow(int r, int hi) { return (r & 3) + 8 * (r >> 2) + 4 * hi; }
__device__ __forceinline__ void glds16(const void* gsrc, unsigned lds_dst) { unsigned keep;
  asm volatile("s_mov_b32 %0, m0\n\ts_mov_b32 m0, %2\n\ts_nop 0\n\tglobal_load_lds_dwordx4 %1, off\n\ts_mov_b32 m0, %0" : "=&s"(keep) : "v"(gsrc), "s"(lds_dst) : "memory"); }
struct Item { int t; int kt0; int nkt; int ks; };
template <class Epi>
__device__ __forceinline__ void skinny_item(const Item it, const bf16* __restrict__ A, int lda, const bf16* __restrict__ Wt, int KT  , const Epi& E, SLAS char* lds) {
  int tid = threadIdx.x; asm volatile("" : "+v"(tid));
  const int wid = __builtin_amdgcn_readfirstlane(tid >> 6), lane = tid & 63, r32 = lane & 31, hi = lane >> 5;
  const int arow0 = 32 * wid + (lane >> 3), cs = lane & 7;
  unsigned aoff[4];
#pragma unroll
  for (int q = 0; q < 4; ++q) { const int row = arow0 + 8 * q; aoff[q] = (unsigned)row * (unsigned)(lda * 2) + (unsigned)((cs ^ ((row >> 1) & 7)) * 16); }
  const int brow = 8 * wid + (lane >> 3); const unsigned boff = (unsigned)(brow * 128 + ((cs ^ ((brow >> 1) & 7)) * 16));
  const char* Ag = (const char*)A + (size_t)it.kt0 * 128;
  const char* Wg = (const char*)Wt + ((size_t)(it.t >> 2) * KT + it.kt0) * 32768 + (size_t)(it.t & 3) * 8192;
  const unsigned lds0 = (unsigned)(uintptr_t)lds;
#define SK_DMA(kt, slot) do { const unsigned sl_ = (unsigned)__builtin_amdgcn_readfirstlane((int)(lds0 + (slot) * SLOT)); const char* ag_ = Ag + (size_t)(kt) * 128; \
    glds16(ag_ + aoff[0], sl_ + (unsigned)(wid * 4096)); glds16(ag_ + aoff[1], sl_ + (unsigned)(wid * 4096 + 1024)); glds16(ag_ + aoff[2], sl_ + (unsigned)(wid * 4096 + 2048)); glds16(ag_ + aoff[3], sl_ + (unsigned)(wid * 4096 + 3072)); \
    glds16(Wg + (size_t)(kt) * 32768 + boff, sl_ + (unsigned)(A_BYTES + wid * 1024)); } while (0)
  const int ar = 32 * wid + r32, asw = (ar >> 1) & 7, b0sw = (r32 >> 1) & 7, b1sw = ((32 + r32) >> 1) & 7;
  f32x16 acc[2] = {};
  const int nkt = it.nkt;
  SK_DMA(0, 0); if (nkt > 1) SK_DMA(1, 1);
  int slot = 0, slot2 = 2;
  for (int kt = 0; kt < nkt; ++kt) {
    if (kt + 1 < nkt) asm volatile("s_waitcnt vmcnt(5)" ::: "memory"); else asm volatile("s_waitcnt vmcnt(0)" ::: "memory");
    asm volatile("s_waitcnt lgkmcnt(0)\n\ts_barrier" ::: "memory");
    if (kt + 2 < nkt) SK_DMA(kt + 2, slot2);
    const SLAS char* sa = lds + slot * SLOT + ar * 128; const SLAS char* sb = lds + slot * SLOT + A_BYTES;
#pragma unroll
    for (int s = 0; s < 4; ++s) { const int c = 2 * s + hi;
      const bf16x8 a = *reinterpret_cast<const SLAS bf16x8*>(sa + ((c ^ asw) * 16));
      const bf16x8 w0 = *reinterpret_cast<const SLAS bf16x8*>(sb + r32 * 128 + ((c ^ b0sw) * 16));
      const bf16x8 w1 = *reinterpret_cast<const SLAS bf16x8*>(sb + (32 + r32) * 128 + ((c ^ b1sw) * 16));
      acc[0] = __builtin_amdgcn_mfma_f32_32x32x16_bf16(a, w0, acc[0], 0, 0, 0);
      acc[1] = __builtin_amdgcn_mfma_f32_32x32x16_bf16(a, w1, acc[1], 0, 0, 0); }
    slot = (slot == 2) ? 0 : slot + 1; slot2 = (slot2 == 2) ? 0 : slot2 + 1;
  }
#undef SK_DMA
  E(acc, it, wid, r32, hi);
  asm volatile("s_waitcnt lgkmcnt(0)" ::: "memory"); __syncthreads();
}
#undef SLAS
}
constexpr int NWAVES = 8;
#ifndef MK_N_LAUNCHES
#define MK_N_LAUNCHES 1
#endif
constexpr int N_PHASES = 8;
constexpr int N_LAUNCHES = MK_N_LAUNCHES;
static_assert(N_LAUNCHES == 1 || N_LAUNCHES == N_PHASES, "MK_N_LAUNCHES is 1 or 8");

constexpr int DM = 4096, TP = 8192, TS = 256, MROWS = TP + TS, HW = 2048, NIN = 6 * HW, DFF = 16384;
constexpr int DEC_B = 16, DEC_T = 16, PAST = 2048, A_HEADS = 8, B_HEADS = 16;
constexpr float EPS = 1e-6f, LAM_INIT = 0.2f;
constexpr size_t OUT_Y = 0;
constexpr size_t OUT_KVP = (size_t)MROWS * DM;
constexpr size_t OUT_KVS = OUT_KVP + 4 * (size_t)TP * HW;
constexpr size_t OUT_TOTAL = OUT_KVS + 4 * (size_t)TS * HW;
static_assert(OUT_TOTAL == 103809024ull, "output size");
constexpr size_t MiB = 1u << 20;
constexpr size_t WS_CTL = 0, CTL_ZERO_BYTES = 1 * MiB;
constexpr size_t WS_ROPE = 2 * MiB;
constexpr size_t WS_WIN = 4 * MiB;
constexpr size_t WS_WOUT = WS_WIN + 96 * MiB;
constexpr size_t WS_WUP = WS_WOUT + 32 * MiB;
constexpr size_t WS_WDOWN = WS_WUP + 128 * MiB;
constexpr size_t WS_H0 = WS_WDOWN + 128 * MiB;
constexpr size_t WS_QKV = WS_H0 + 66 * MiB;
constexpr size_t WS_OA = WS_QKV + 198 * MiB;
constexpr size_t WS_O = WS_OA + 128 * MiB;
constexpr size_t WS_X1 = WS_O + 66 * MiB;
constexpr size_t WS_X1S = WS_X1 + 66 * MiB, WS_X2B = WS_OA;
constexpr size_t WS_H1 = WS_X1 + 132 * MiB;
constexpr size_t WS_U = WS_H1 + 66 * MiB;
constexpr size_t WS_PART1 = WS_U + 264 * MiB;
constexpr size_t WS_PART2 = WS_PART1 + 48 * MiB;
constexpr size_t WS_PART3 = WS_PART2 + 32 * MiB;
constexpr size_t WS_PART4 = WS_PART3 + 64 * MiB;
constexpr size_t WS_END = WS_PART4 + 64 * MiB;
#ifndef WGMS
#define WGMS 4, 4, 4, 4
#endif
constexpr int WGM_TAB[4] = {WGMS}; constexpr int WGM_P1 = WGM_TAB[0], WGM_P4 = WGM_TAB[1], WGM_P5 = WGM_TAB[2], WGM_P6 = WGM_TAB[3];
constexpr int SPL2 = 4, SPL4 = 4;
static_assert((size_t)MROWS * DM * 2 <= 66 * MiB && (size_t)MROWS * HW * 2 * 6 <= 198 * MiB && (size_t)MROWS * DM * 4 <= 132 * MiB && (size_t)MROWS * DFF * 2 <= 264 * MiB, "ws map");
constexpr int CW_TMO = 0, CW_CODE = 1;
constexpr int CW_BAR = 4096;
constexpr int CW_BQ = 8192, CW_AQ = 8704;
constexpr int CW_SSQ1 = 16384, CW_SSQ2 = 32768;
static_assert((CW_SSQ2 + MROWS) * 4 <= (int)CTL_ZERO_BYTES, "CTL words inside the memset region");
constexpr int RING_OFF = 0, RING_BYTES = 135168;
constexpr int LDSCTL_OFF = RING_BYTES, MISC_OFF = LDSCTL_OFF + 320;
constexpr int LDS_BYTES = 147456;
static_assert(MISC_OFF + 128 <= LDS_BYTES && 8 * 64 * 65 * 4 <= RING_BYTES && att::SA_LDS <= RING_BYTES && att::X_LDS <= RING_BYTES, "LDS map");

#define GAS __attribute__((address_space(1)))
#define LAS __attribute__((address_space(3)))
typedef unsigned short bf16;
typedef unsigned v4u __attribute__((ext_vector_type(4)));
typedef float f32x4 __attribute__((ext_vector_type(4)));
typedef short bf16x8 __attribute__((ext_vector_type(8)));
typedef GAS unsigned gu32;
typedef GAS unsigned long long gu64;
#define RLX_AGENT __ATOMIC_RELAXED, __HIP_MEMORY_SCOPE_AGENT
#define LDS_WAIT() asm volatile("s_waitcnt lgkmcnt(0)" ::: "memory")
#define VM_WAIT() asm volatile("s_waitcnt vmcnt(0)" ::: "memory")
__device__ __forceinline__ unsigned long long rt() { return __builtin_amdgcn_s_memrealtime(); }
__device__ __forceinline__ unsigned f2bf(float f) { unsigned u = __builtin_bit_cast(unsigned, f); return (u + 0x7fffu + ((u >> 16) & 1u)) >> 16; }
__device__ __forceinline__ unsigned pk2(float lo, float hi) { return f2bf(lo) | (f2bf(hi) << 16); }

#define XB_TMO      128
#define XB_XCNT(j)  (256  + 64 * (j))
#define XB_XSUB(j)  (1280 + 64 * (j))
#define XB_XGEN(j)  (2304 + 64 * (j))
#define XB_TOP      3328
#define XB_TOPGEN   3392
#define XCD_BAR_WORDS 3456
#define XB_SPIN_CAP (1u << 18)

__device__ __forceinline__ unsigned xb_ld(unsigned* p)              { return __hip_atomic_load(p, __ATOMIC_RELAXED, __HIP_MEMORY_SCOPE_AGENT); }
__device__ __forceinline__ unsigned xb_add(unsigned* p, unsigned v) { return __hip_atomic_fetch_add(p, v, __ATOMIC_RELAXED, __HIP_MEMORY_SCOPE_AGENT); }
__device__ __forceinline__ unsigned xb_xcc_id() { return (unsigned)__builtin_amdgcn_s_getreg((3 << 11) | 20) & 0xFu; }
#define XB_SPIN(cond, bar) do { unsigned _sp = 0; while (cond) { __builtin_amdgcn_s_sleep(1); \
    if ((++_sp & 255u) == 0u) { if (xb_ld(&(bar)[XB_TMO])) break; if (_sp > XB_SPIN_CAP) { atomicAdd(&(bar)[XB_TMO], 1u); break; } } } } while (0)

struct XcdBarrier {
    unsigned* bar; unsigned x;
    volatile LAS unsigned* st;
};

__device__ __forceinline__ XcdBarrier xcd_barrier_post(unsigned* bar, volatile LAS unsigned* st) {
    XcdBarrier b; b.bar = bar; b.x = xb_xcc_id(); b.st = st;
    if (threadIdx.x == 0) (void)xb_add(&bar[XB_XCNT(b.x)], 1u);
    return b;
}
__device__ __forceinline__ void xcd_barrier_complete(unsigned* bar, unsigned x, unsigned& nloc, unsigned& nx) {
    const unsigned G = gridDim.x * gridDim.y * gridDim.z;
    unsigned sum, cnt, mine, sp = 0u;
    for (;;) {
        sum = 0u; cnt = 0u; mine = 0u;
#pragma unroll
        for (unsigned j = 0; j < 16; ++j) { const unsigned c = xb_ld(&bar[XB_XCNT(j)]); sum += c; cnt += (c > 0u) ? 1u : 0u; mine = (j == x) ? c : mine; }
        if (sum == G) break;
        __builtin_amdgcn_s_sleep(1);
        if ((++sp & 255u) == 0u) { if (xb_ld(&bar[XB_TMO])) break; if (sp > XB_SPIN_CAP) { atomicAdd(&bar[XB_TMO], 1u); break; } }
    }
    nloc = mine > 0u ? mine : 1u; nx = cnt > 0u ? cnt : 1u;
}

__device__ __forceinline__ void xcd_barrier(const XcdBarrier& b) {
    asm volatile("s_waitcnt vmcnt(0)" ::: "memory");
    __syncthreads();
    if (threadIdx.x == 0) {
        unsigned* bar = b.bar;
        __builtin_amdgcn_s_waitcnt(0);
        unsigned nloc = b.st[0], nx = b.st[1];
        if (nloc == 0u) { xcd_barrier_complete(bar, b.x, nloc, nx); b.st[0] = nloc; b.st[1] = nx; }
        const unsigned old = xb_add(&bar[XB_XSUB(b.x)], 1u);
        const unsigned gen = old / nloc;
        if (old + 1u == (gen + 1u) * nloc) {
            __builtin_amdgcn_fence(__ATOMIC_RELEASE, "agent");
            asm volatile("s_waitcnt vmcnt(0)" ::: "memory");
            const unsigned og = xb_add(&bar[XB_TOP], 1u);
            const unsigned tg = og / nx;
            if (og + 1u == (tg + 1u) * nx) xb_add(&bar[XB_TOPGEN], 1u);
            else XB_SPIN(xb_ld(&bar[XB_TOPGEN]) == tg, bar);
            __builtin_amdgcn_fence(__ATOMIC_ACQUIRE, "agent");
            xb_add(&bar[XB_XGEN(b.x)], 1u);
            asm volatile("s_waitcnt vmcnt(0)" ::: "memory");
        } else {
            XB_SPIN(xb_ld(&bar[XB_XGEN(b.x)]) == gen, bar);
            __builtin_amdgcn_fence(__ATOMIC_ACQUIRE, "agent");
            asm volatile("s_waitcnt vmcnt(0)" ::: "memory");
        }
    }
    __syncthreads();
}


__device__ __forceinline__ int lane_now() { int t = threadIdx.x; asm volatile("" : "+v"(t)); return t & 63; }
struct Frame {
    LAS unsigned char* lds;
    volatile LAS unsigned* MISC;
    gu32* ctl;
    int tid, lane, wave;
    int vcu, G;
};
__device__ __forceinline__ float wave_sum(float v) {
#pragma unroll
    for (int o = 1; o < 64; o <<= 1) v += __shfl_xor(v, o);
    return v;
}
__constant__ double ROPE_INV[16] = {
    1.0, 0.44036660267178046, 0.19392274474868576, 0.08539710028576561, 0.03760603093086393, 0.016560440080994446, 0.007292664737217109, 0.003211445994752591,
    0.001414213562373095, 0.000622772421914596, 0.0002742481756762073, 0.00012076973741146504, 5.318295896944988e-05, 2.341999896140934e-05, 1.031338537721246e-05, 4.5416704806078695e-06 };

__device__ __forceinline__ void p0_transpose_item(const float* W, int K, int N, bf16* WT, LAS float* scr, int item, int lane) {
    const int nblk = N / 32, kb = item / nblk, nb = item % nblk, k0 = 64 * kb, n0 = 32 * nb;
#pragma unroll 8
    for (int i = 0; i < 32; ++i) { const int kk = 2 * i + (lane >> 5); scr[kk * 33 + (lane & 31)] = W[(size_t)(k0 + kk) * N + n0 + (lane & 31)]; }
    LDS_WAIT(); asm volatile("" ::: "memory");
    const int c = lane & 7;
#pragma unroll
    for (int j = 0; j < 4; ++j) { const int n = (lane >> 3) + 8 * j; const LAS float* s = scr + (8 * c) * 33 + n;
        v4u o; o.x = pk2(s[0 * 33], s[1 * 33]); o.y = pk2(s[2 * 33], s[3 * 33]); o.z = pk2(s[4 * 33], s[5 * 33]); o.w = pk2(s[6 * 33], s[7 * 33]);
        *(GAS v4u*)(WT + (size_t)(n0 + n) * K + k0 + 8 * c) = o; }
    LDS_WAIT(); asm volatile("" ::: "memory");
}
constexpr int CONV_SCR = 64 * 65 * 4;
__device__ __forceinline__ void conv_item64(const float* W, int K, int N, bf16* WT, LAS float* scr, int item, int lane) {
    const int nblk = N >> 6, kb = item / nblk, nb = item - kb * nblk, k0 = kb << 6, n0 = nb << 6;
    const float* src = W + (size_t)(k0 + (lane >> 4)) * N + n0 + 4 * (lane & 15);
    f32x4 v[16];
#pragma unroll
    for (int i = 0; i < 16; ++i) v[i] = *(const f32x4*)(src + (size_t)(4 * i) * N);
    LAS float* d = scr + (lane >> 4) * 65 + 4 * (lane & 15);
#pragma unroll
    for (int i = 0; i < 16; ++i) { LAS float* p = d + i * (4 * 65); p[0] = v[i].x; p[1] = v[i].y; p[2] = v[i].z; p[3] = v[i].w; }
    LDS_WAIT(); asm volatile("" ::: "memory");
    const int c = lane & 7;
#pragma unroll
    for (int j = 0; j < 8; ++j) { const int n = (lane >> 3) + 8 * j; const LAS float* s = scr + (8 * c) * 65 + n;
        v4u o; o.x = pk2(s[0 * 65], s[1 * 65]); o.y = pk2(s[2 * 65], s[3 * 65]); o.z = pk2(s[4 * 65], s[5 * 65]); o.w = pk2(s[6 * 65], s[7 * 65]);
        const int ng = n0 + n;
        *(GAS v4u*)(WT + ((size_t)(ng >> 8) * (K >> 6) + kb) * 16384 + (size_t)(ng & 255) * 64 + 8 * c) = o; }
    LDS_WAIT(); asm volatile("" ::: "memory");
}
__device__ __forceinline__ void rms_row_to_bf16(const float* xrow, const f32x4 (&gv)[16], bf16* orow, int lane) {
    const GAS f32x4* xr = (const GAS f32x4*)xrow + lane;
    f32x4 v[16]; float s = 0.f;
#pragma unroll
    for (int j = 0; j < 16; ++j) { v[j] = xr[64 * j]; s += (v[j].x * v[j].x + v[j].y * v[j].y) + (v[j].z * v[j].z + v[j].w * v[j].w); }
    const float rstd = 1.0f / sqrtf(wave_sum(s) * (1.f / DM) + EPS);
#pragma unroll
    for (int j = 0; j < 16; ++j) { const f32x4 gg = gv[j]; v[j].x = v[j].x * rstd * gg.x; v[j].y = v[j].y * rstd * gg.y; v[j].z = v[j].z * rstd * gg.z; v[j].w = v[j].w * rstd * gg.w; }
#pragma unroll
    for (int j = 0; j < 16; ++j) asm volatile("" : "+v"(v[j]));
    asm volatile("" ::: "memory");
    GAS unsigned long long* o8 = (GAS unsigned long long*)orow + lane;
#pragma unroll
    for (int j = 0; j < 16; ++j) o8[64 * j] = (unsigned long long)pk2(v[j].x, v[j].y) | ((unsigned long long)pk2(v[j].z, v[j].w) << 32);
}
__device__ __forceinline__ float lambda_of(const float* q1, const float* k1, const float* q2, const float* k2, int lane) {
    const float a = wave_sum(q1[lane] * k1[lane] + q1[64 + lane] * k1[64 + lane]);
    const float b = wave_sum(q2[lane] * k2[lane] + q2[64 + lane] * k2[64 + lane]);
    return expf(a) - expf(b) + LAM_INIT;
}

typedef const __attribute__((address_space(4))) char* kaptr;
__device__ __forceinline__ kaptr karg_base() { kaptr ka = (kaptr)__builtin_amdgcn_kernarg_segment_ptr(); asm volatile("" : "+s"(ka)); return ka; }
__device__ __forceinline__ const float* karg_in(int i) { return *(const float* const __attribute__((address_space(4)))*)(karg_base() + 8 * i); }
__device__ __forceinline__ float* karg_out() { return *(float* const __attribute__((address_space(4)))*)(karg_base() + 152); }
__device__ __forceinline__ unsigned char* karg_ws() { return *(unsigned char* const __attribute__((address_space(4)))*)(karg_base() + 160); }
struct SkInProj {
    bf16* qkv; float* out_kvs; const float* rope;
    __device__ __forceinline__ void operator()(const sk::f32x16 (&acc)[2], const sk::Item& it, int wid, int r32, int hi) const {
        const int col0 = it.t * 64, tt = col0 >> 11, ct0 = col0 & 2047;
        const bool rot = (tt < 2) && ((col0 & 127) == 0);
        const int d = r32 & 15; const float sgn = (r32 < 16) ? -1.f : 1.f;
        const int idx = (tt == 1) ? 0 : (tt == 2) ? 1 : (tt == 4) ? 2 : 3; const bool f32out = (tt == 1 || tt == 2 || tt == 4 || tt == 5);
        bf16* qb = qkv + (size_t)tt * ((size_t)MROWS * HW) + (size_t)TP * HW; float* fo = out_kvs + (size_t)idx * (TS * HW);
        float cc[16], ss[16];
#pragma unroll
        for (int r = 0; r < 16; ++r) { const int row = 32 * wid + sk::crow(r, hi); cc[r] = rot ? rope[(size_t)(TP + row) * 32 + d] : 1.f; ss[r] = rot ? rope[(size_t)(TP + row) * 32 + 16 + d] : 0.f; }
        asm volatile("" ::: "memory");
#pragma unroll
        for (int r = 0; r < 16; ++r) { const int row = 32 * wid + sk::crow(r, hi);
            float v0 = acc[0][r]; const float v1 = acc[1][r];
            const float other = __shfl_xor(v0, 16);
            if (rot) v0 = v0 * cc[r] + sgn * other * ss[r];
            qb[(size_t)row * HW + ct0 + r32] = (bf16)f2bf(v0); qb[(size_t)row * HW + ct0 + 32 + r32] = (bf16)f2bf(v1);
            if (f32out) { fo[(size_t)row * HW + ct0 + r32] = v0; fo[(size_t)row * HW + ct0 + 32 + r32] = v1; } }
    }
};
struct SkPartial {
    float* part; int N;
    __device__ __forceinline__ void operator()(const sk::f32x16 (&acc)[2], const sk::Item& it, int wid, int r32, int hi) const {
#pragma unroll
        for (int r = 0; r < 16; ++r) { float* p = part + ((size_t)it.ks * TS + 32 * wid + sk::crow(r, hi)) * N + it.t * 64 + r32; p[0] = acc[0][r]; p[32] = acc[1][r]; }
    }
};
struct SkUp {
    const float* ssq; bf16* U;
    __device__ __forceinline__ void operator()(const sk::f32x16 (&acc)[2], const sk::Item& it, int wid, int r32, int hi) const {
        float sq[16];
#pragma unroll
        for (int r = 0; r < 16; ++r) sq[r] = ssq[TP + 32 * wid + sk::crow(r, hi)];
        asm volatile("" ::: "memory");
#pragma unroll
        for (int r = 0; r < 16; ++r) { const int row = 32 * wid + sk::crow(r, hi); const float rs = 1.0f / sqrtf(sq[r] * (1.f / DM) + EPS);
            const float a = fmaxf(acc[0][r] * rs, 0.f), b = fmaxf(acc[1][r] * rs, 0.f);
            bf16* p = U + (size_t)(TP + row) * DFF + it.t * 64 + r32; p[0] = (bf16)f2bf(a * a); p[32] = (bf16)f2bf(b * b); }
    }
};
struct Args { const float* in[19]; float* out; unsigned char* ws; int ph_lo, ph_hi, li, pad; };
static_assert(offsetof(Args, out) == 152 && offsetof(Args, ws) == 160 && sizeof(Args) == 184, "kernarg layout used by karg_*");
__global__ void __launch_bounds__(NWAVES * 64, 2) hybrid_fwd(Args args) {
    extern __shared__ __attribute__((aligned(16))) unsigned char lds[];
    Frame F;
    F.lds = (LAS unsigned char*)lds;
    F.MISC = (volatile LAS unsigned*)(F.lds + MISC_OFF);
    F.tid = threadIdx.x; F.lane = 0; F.wave = __builtin_amdgcn_readfirstlane(F.tid >> 6);
    F.G = gridDim.x; { const int bx = blockIdx.x; F.vcu = (F.G % 8 == 0) ? (bx % 8) * (F.G / 8) + bx / 8 : bx; }
    F.ctl = (gu32*)(karg_ws() + WS_CTL);
    constexpr size_t QS = (size_t)MROWS * HW;
#define KIN(i) karg_in(i)
#define KWS(T, off) ((T*)(karg_ws() + (off)))
#define KSSQ(w) ((float*)(karg_ws() + WS_CTL) + (w))
    for (int u = F.tid; u < (LDS_BYTES - LDSCTL_OFF) / 4; u += NWAVES * 64) ((LAS unsigned*)(F.lds + LDSCTL_OFF))[u] = 0u;
    __syncthreads();
    XcdBarrier bar; bar.bar = (unsigned*)(F.ctl + CW_BAR); bar.x = 0; bar.st = nullptr;
    if (N_LAUNCHES == 1) bar = xcd_barrier_post((unsigned*)(F.ctl + CW_BAR), F.MISC + 8);
#define GRID_BAR() do { if (N_LAUNCHES == 1) xcd_barrier(bar); } while (0)
    const int lo = args.ph_lo, hi = args.ph_hi;
#ifndef PH_MASK
#define PH_MASK 0xff
#endif
#define IN(k) (((PH_MASK >> (k)) & 1) && lo <= (k) && (k) < hi)
#define BOTH(k) (IN(k) && IN((k) + 1))
    const int gw = F.vcu * NWAVES + F.wave, NGW = F.G * NWAVES;

    if (IN(0)) {
        LAS float* scr = (LAS float*)(F.lds + RING_OFF + F.wave * CONV_SCR);
        const float* x_prompt = KIN(0); const float* x_sample = KIN(1); const float* g_attn = KIN(6); const float* w_in = KIN(7);
        bf16* Win_t = KWS(bf16, WS_WIN); bf16* H0 = KWS(bf16, WS_H0); float* ROPE = KWS(float, WS_ROPE);
        for (int it = gw; it < (DM / 64) * (NIN / 64); it += NGW) conv_item64(w_in, DM, NIN, Win_t, scr, it, lane_now());
        { f32x4 gv[16]; { const GAS f32x4* gr = (const GAS f32x4*)g_attn + lane_now();
#pragma unroll
            for (int j = 0; j < 16; ++j) gv[j] = gr[64 * j]; }
#pragma unroll 1
          for (int m = gw; m < MROWS; m += NGW) rms_row_to_bf16(m < TP ? x_prompt + (size_t)m * DM : x_sample + (size_t)(m - TP) * DM, gv, H0 + (size_t)m * DM, lane_now()); }
        for (int e = blockIdx.x * (NWAVES * 64) + F.tid; e < MROWS * 16; e += F.G * NWAVES * 64) {
            const int row = e >> 4, d = e & 15; const int pos = row < TP ? row : PAST + ((row - TP) & 15);
            const double rev = (double)pos * ROPE_INV[d] * 0.15915494309189535; const float fr = (float)(rev - floor(rev));
            ROPE[(size_t)row * 32 + d] = __builtin_amdgcn_cosf(fr); ROPE[(size_t)row * 32 + 16 + d] = __builtin_amdgcn_sinf(fr);
        }
        if (BOTH(0)) GRID_BAR();
    }
    if (IN(1)) {
        float* out = karg_out();
        { pg8::Gemm g{KWS(bf16, WS_H0), KWS(bf16, WS_WIN), TP, NIN, DM, DM}; pg8::StaticOrder S; S.init(TP, NIN, F.G, (int)blockIdx.x, WGM_P1);
          pg8::EpiInProj E{KWS(bf16, WS_QKV), out + OUT_KVP, out + OUT_KVS, KWS(float, WS_ROPE)};
          if (!(args.pad & 32)) pg8::gemm_phase<pg8::EpiInProj, pg8::StaticOrder, true, true>(F.lds + RING_OFF, g, S, E); }
        if (!(args.pad & 16)) {
            const SkInProj E{KWS(bf16, WS_QKV), out + OUT_KVS, KWS(float, WS_ROPE)};
            for (int i = (int)blockIdx.x; i < NIN / 64; i += F.G) sk::skinny_item(sk::Item{i, 0, DM / 64, 0}, KWS(bf16, WS_H0) + (size_t)TP * DM, DM, KWS(bf16, WS_WIN), DM / 64, E, (LAS char*)(F.lds + RING_OFF));
        }
        if (BOTH(1)) GRID_BAR();
    }
    if (IN(2)) {
        LAS char* al = (LAS char*)(F.lds + RING_OFF);
        const bf16* QKV = KWS(bf16, WS_QKV); bf16* OB = KWS(bf16, WS_O);
        const bf16* AQ = QKV; const bf16* AK = QKV + QS; const bf16* AV = QKV + 2 * QS; const bf16* BQ = QKV + 3 * QS; const bf16* BK = QKV + 4 * QS; const bf16* BV = QKV + 5 * QS;
#ifndef P2_MASK
#define P2_MASK 7
#endif
        const int sub = args.pad ? args.pad : 15;
        if ((P2_MASK & 3) && (sub & 11)) {
            constexpr int NQE = 64 + DEC_B + 32;
            constexpr int CI_OUT = (DM / 64) * (DM / 64), CI_UP = (DM / 64) * (DFF / 64), CI_DOWN = (DFF / 64) * (DM / 64), CI_PER_UNIT = (CI_OUT + CI_UP + CI_DOWN) / 256;
            static_assert((CI_OUT + CI_UP + CI_DOWN) % 256 == 0 && CI_PER_UNIT % NWAVES == 0, "conversion items divide over 256 units x 8 waves");
            const int qx0 = (int)(xb_xcc_id() & 7u);
            for (int pass = 0; pass < 8; ++pass) {
                const int x = (qx0 + pass) & 7;
                for (;;) {
                    __syncthreads();
                    if (F.tid == 0) F.MISC[0] = __hip_atomic_fetch_add(F.ctl + CW_AQ + 64 * x, 1u, RLX_AGENT);
                    __syncthreads();
                    const int e = (int)F.MISC[0];
                    if (e >= NQE) break;
                    const int blk = e / 7, r = e - blk * 7;
                    if (r == 3 || r == 6) {
                        if (sub & 8) {
                            const int u = 32 * x + 2 * blk + (r == 6 ? 1 : 0); LAS float* scr = (LAS float*)(F.lds + RING_OFF + F.wave * CONV_SCR); const int lane = lane_now();
                            for (int t = 0; t < CI_PER_UNIT / NWAVES; ++t) {
                                int g = u * CI_PER_UNIT + t * NWAVES + F.wave;
                                if (g < CI_OUT) conv_item64(KIN(14), DM, DM, KWS(bf16, WS_WOUT), scr, g, lane);
                                else if (g < CI_OUT + CI_UP) conv_item64(KIN(16), DM, DFF, KWS(bf16, WS_WUP), scr, g - CI_OUT, lane);
                                else conv_item64(KIN(17), DFF, DM, KWS(bf16, WS_WDOWN), scr, g - CI_OUT - CI_UP, lane);
                            }
                        }
                        continue;
                    }
                    const int a = blk * 5 + (r < 3 ? r : r - 1);
                    const float lam = lambda_of(KIN(8), KIN(9), KIN(10), KIN(11), lane_now());
                    if (a >= 42 && a < 58) { if (sub & 2) att::attnA_sample_unit(a - 42, x, KIN(2), KIN(3), karg_out() + OUT_KVS, karg_out() + OUT_KVS + (size_t)TS * HW, AQ, lam, KIN(12), 1.0f - LAM_INIT, OB, al); }
                    else if (sub & 1) att::attnA_prompt_unit2(x, a < 42 ? 63 - a : 79 - a, AQ, AK, AV, lam, KIN(12), 1.0f - LAM_INIT, OB, al);
                }
            }
        }
        if ((P2_MASK & 4) && (sub & 4)) {
            LAS char* vbuf = al + F.wave * 16384; const float* g_sb = KIN(13); const float* cache_b_k = KIN(4); const float* cache_b_v = KIN(5);
            constexpr unsigned NBU = DEC_B * B_HEADS + B_HEADS * (TP / 32);
            for (;;) {
                unsigned u = 0;
                if (lane_now() == 0) u = __hip_atomic_fetch_add(F.ctl + CW_BQ, 1u, RLX_AGENT);
                u = (unsigned)__builtin_amdgcn_readfirstlane((int)u);
                if (u >= NBU) break;
                if (u < DEC_B * B_HEADS) att::stick_sample_unit((int)(u >> 4), (int)(u & 15), BQ, BK, BV, cache_b_k, cache_b_v, g_sb, OB, vbuf);
                else { const int idx = (int)u - DEC_B * B_HEADS; const int h = (idx >> 3) & 15, qt = (TP / 32 - 1) - ((idx & 7) | ((idx >> 7) << 3)); att::stick_prompt_unit(h, qt, BQ, BK, BV, g_sb, OB, vbuf); }
            }
        }
        if (BOTH(2)) GRID_BAR();
    }
    if (IN(3)) {
        { pg8::Gemm g{KWS(bf16, WS_O), KWS(bf16, WS_WOUT), TP, DM, DM, DM}; pg8::StaticOrder S; S.init(TP, DM, F.G, (int)blockIdx.x, WGM_P4);
          pg8::EpiOutProj E{KIN(0), KIN(1), KIN(15), KWS(bf16, WS_X1), KWS(bf16, WS_H1), KSSQ(CW_SSQ1)};
          if (!(args.pad & 32)) pg8::gemm_phase<pg8::EpiOutProj, pg8::StaticOrder, true, true>(F.lds + RING_OFF, g, S, E); }
        if (!(args.pad & 16)) {
            const SkPartial E{KWS(float, WS_PART2), DM};
            for (int i = (int)blockIdx.x; i < (DM / 64) * SPL2; i += F.G) sk::skinny_item(sk::Item{i >> 2, (i & 3) * (DM / 64 / SPL2), DM / 64 / SPL2, i & 3}, KWS(bf16, WS_O) + (size_t)TP * DM, DM, KWS(bf16, WS_WOUT), DM / 64, E, (LAS char*)(F.lds + RING_OFF));
        }
        if (BOTH(3)) GRID_BAR();
    }
    if (IN(4)) {
        const int lane = lane_now(); const float* PART = KWS(float, WS_PART2); const float* xs = KIN(1); const float* g = KIN(15); float* X1S = KWS(float, WS_X1S); bf16* H1 = KWS(bf16, WS_H1); float* SSQ1 = KSSQ(CW_SSQ1);
        for (int it = gw; it < TS * (DM / 512); it += NGW) {
            const int row = it / (DM / 512), col = (it % (DM / 512)) * 512 + lane * 8;
            f32x4 a0 = *(const f32x4*)(xs + (size_t)row * DM + col), a1 = *(const f32x4*)(xs + (size_t)row * DM + col + 4);
#pragma unroll
            for (int ks = 0; ks < SPL2; ++ks) { const float* p = PART + ((size_t)ks * TS + row) * DM + col; a0 += *(const f32x4*)p; a1 += *(const f32x4*)(p + 4); }
            const f32x4 g0 = *(const f32x4*)(g + col), g1 = *(const f32x4*)(g + col + 4);
            asm volatile("" ::: "memory");
            float* xo = X1S + (size_t)row * DM + col; *(f32x4*)xo = a0; *(f32x4*)(xo + 4) = a1;
            const float ss = wave_sum((a0.x * a0.x + a0.y * a0.y) + (a0.z * a0.z + a0.w * a0.w) + (a1.x * a1.x + a1.y * a1.y) + (a1.z * a1.z + a1.w * a1.w));
            if (lane == 0) pg8::ssq_add(SSQ1 + TP + row, ss);
            v4u w; w.x = pk2(a0.x * g0.x, a0.y * g0.y); w.y = pk2(a0.z * g0.z, a0.w * g0.w); w.z = pk2(a1.x * g1.x, a1.y * g1.y); w.w = pk2(a1.z * g1.z, a1.w * g1.w);
            *(v4u*)(H1 + (size_t)(TP + row) * DM + col) = w;
        }
        if (BOTH(4)) GRID_BAR();
    }
    if (IN(5)) {
        { pg8::Gemm g{KWS(bf16, WS_H1), KWS(bf16, WS_WUP), TP, DFF, DM, DM}; pg8::StaticOrder S; S.init(TP, DFF, F.G, (int)blockIdx.x, WGM_P5);
          pg8::EpiUp E{KSSQ(CW_SSQ1), KWS(bf16, WS_U)};
          if (!(args.pad & 32)) pg8::gemm_phase<pg8::EpiUp, pg8::StaticOrder, true, true>(F.lds + RING_OFF, g, S, E); }
        if (!(args.pad & 16)) {
            const SkUp E{KSSQ(CW_SSQ1), KWS(bf16, WS_U)};
            for (int i = (int)blockIdx.x; i < DFF / 64; i += F.G) sk::skinny_item(sk::Item{i, 0, DM / 64, 0}, KWS(bf16, WS_H1) + (size_t)TP * DM, DM, KWS(bf16, WS_WUP), DM / 64, E, (LAS char*)(F.lds + RING_OFF));
        }
        if (BOTH(5)) GRID_BAR();
    }
    if (IN(6)) {
        { pg8::Gemm g{KWS(bf16, WS_U), KWS(bf16, WS_WDOWN), TP, DM, DFF, DFF}; pg8::StaticOrder S; S.init(TP, DM, F.G, (int)blockIdx.x, WGM_P6);
          pg8::EpiDown E{KWS(bf16, WS_X1), KWS(bf16, WS_X2B), KSSQ(CW_SSQ2)};
          if (!(args.pad & 32)) pg8::gemm_phase<pg8::EpiDown, pg8::StaticOrder, true, true>(F.lds + RING_OFF, g, S, E); }
        if (!(args.pad & 16)) {
            const SkPartial E{KWS(float, WS_PART4), DM};
            for (int i = (int)blockIdx.x; i < (DM / 64) * SPL4; i += F.G) sk::skinny_item(sk::Item{i >> 2, (i & 3) * (DFF / 64 / SPL4), DFF / 64 / SPL4, i & 3}, KWS(bf16, WS_U) + (size_t)TP * DFF, DFF, KWS(bf16, WS_WDOWN), DFF / 64, E, (LAS char*)(F.lds + RING_OFF));
        }
        if (BOTH(6)) GRID_BAR();
    }
    if (IN(7)) {
        unsigned bad = __hip_atomic_load(F.ctl + CW_BAR + XB_TMO, RLX_AGENT);
        const float poison = bad ? __builtin_nanf("") : 0.f; float* out = karg_out(); const float* g_final = KIN(18); const float* SSQ2 = KSSQ(CW_SSQ2);
        const int lane = lane_now();
        for (int m = gw; m < TS; m += NGW) {
            const float* PART = KWS(float, WS_PART4); const GAS f32x4* xr = (const GAS f32x4*)(KWS(float, WS_X1S) + (size_t)m * DM) + lane;
            f32x4 v[16]; float s = 0.f;
#pragma unroll
            for (int j = 0; j < 16; ++j) v[j] = xr[64 * j];
#pragma unroll 1
            for (int ks = 0; ks < SPL4; ++ks) { const GAS f32x4* pr = (const GAS f32x4*)(PART + ((size_t)ks * TS + m) * DM) + lane;
#pragma unroll
                for (int j = 0; j < 16; ++j) v[j] += pr[64 * j]; }
#pragma unroll
            for (int j = 0; j < 16; ++j) s += (v[j].x * v[j].x + v[j].y * v[j].y) + (v[j].z * v[j].z + v[j].w * v[j].w);
            const float rs = 1.0f / sqrtf(wave_sum(s) * (1.f / DM) + EPS) + poison;
            GAS f32x4* yr = (GAS f32x4*)(out + OUT_Y + (size_t)(TP + m) * DM) + lane; const GAS f32x4* gr = (const GAS f32x4*)g_final + lane;
#pragma unroll
            for (int j = 0; j < 16; ++j) v[j] = v[j] * rs * gr[64 * j];
#pragma unroll
            for (int j = 0; j < 16; ++j) asm volatile("" : "+v"(v[j]));
            asm volatile("" ::: "memory");
#pragma unroll
            for (int j = 0; j < 16; ++j) yr[64 * j] = v[j];
        }
        const bf16* X2B = KWS(bf16, WS_X2B);
        { const GAS f32x4* gr = (const GAS f32x4*)g_final + 2 * lane;
          f32x4 gg[8][2];
#pragma unroll
          for (int j = 0; j < 8; ++j) { gg[j][0] = gr[128 * j]; gg[j][1] = gr[128 * j + 1]; }
          v4u w[8]; float q = 0.f;
          if (gw < TP) { const GAS v4u* xr = (const GAS v4u*)(X2B + (size_t)gw * DM) + lane; q = SSQ2[gw];
#pragma unroll
              for (int j = 0; j < 8; ++j) w[j] = xr[64 * j]; }
#pragma unroll 1
          for (int m = gw; m < TP; m += NGW) {
            f32x4 y[8][2];
            const float rs = 1.0f / sqrtf(q * (1.f / DM) + EPS) + poison;
#pragma unroll
            for (int j = 0; j < 8; ++j) { const f32x4 g0 = gg[j][0], g1 = gg[j][1];
                y[j][0] = (f32x4){pg8::bf_lo(w[j].x), pg8::bf_hi(w[j].x), pg8::bf_lo(w[j].y), pg8::bf_hi(w[j].y)} * rs * g0; y[j][1] = (f32x4){pg8::bf_lo(w[j].z), pg8::bf_hi(w[j].z), pg8::bf_lo(w[j].w), pg8::bf_hi(w[j].w)} * rs * g1; }
#pragma unroll
            for (int j = 0; j < 8; ++j) asm volatile("" : "+v"(y[j][0]), "+v"(y[j][1]));
            const int mn = m + NGW;
            if (mn < TP) { const GAS v4u* xr = (const GAS v4u*)(X2B + (size_t)mn * DM) + lane; q = SSQ2[mn];
#pragma unroll
                for (int j = 0; j < 8; ++j) w[j] = xr[64 * j]; }
            asm volatile("" ::: "memory");
            GAS f32x4* yr = (GAS f32x4*)(out + OUT_Y + (size_t)m * DM) + 2 * lane;
#pragma unroll
            for (int j = 0; j < 8; ++j) { yr[128 * j] = y[j][0]; yr[128 * j + 1] = y[j][1]; }
          }
        }
    }
#undef IN
#undef BOTH
#undef GRID_BAR
}

extern "C" void kernel_launch(void* const* d_in, const int* in_sizes, int n_in, void* d_out, int out_size, void* d_ws, size_t ws_size, hipStream_t stream) {
    static int grid = 0;
    if (grid == 0) {
        if (n_in != 19 || in_sizes[0] != TP * DM || (size_t)out_size != OUT_TOTAL || ws_size < WS_END) {
            fprintf(stderr, "kernel_launch: shape mismatch (n_in %d, in0 %d, out %d, ws %zu; need ws >= %zu); nothing launched\n", n_in, n_in > 0 ? in_sizes[0] : -1, out_size, ws_size, (size_t)WS_END); grid = -1; return; }
        int dev = 0, cus = 0, per_cu = 0;
        if (hipGetDevice(&dev) != hipSuccess || hipDeviceGetAttribute(&cus, hipDeviceAttributeMultiprocessorCount, dev) != hipSuccess) { grid = -1; return; }
        if (hipFuncSetAttribute((const void*)hybrid_fwd, hipFuncAttributeMaxDynamicSharedMemorySize, LDS_BYTES) != hipSuccess) { fprintf(stderr, "kernel_launch: hipFuncSetAttribute failed\n"); grid = -1; return; }
        if (hipOccupancyMaxActiveBlocksPerMultiprocessor(&per_cu, (const void*)hybrid_fwd, NWAVES * 64, LDS_BYTES) != hipSuccess || per_cu < 1) { fprintf(stderr, "kernel_launch: occupancy query reports %d blocks per CU\n", per_cu); grid = -1; (void)hipGetLastError(); return; }
        (void)hipGetLastError();
        grid = cus;
    }
    if (grid < 0) return;
    if (hipMemsetAsync((char*)d_ws + WS_CTL, 0, CTL_ZERO_BYTES, stream) != hipSuccess) return;
    Args a{};
    for (int i = 0; i < 19; ++i) a.in[i] = (const float*)d_in[i];
    a.out = (float*)d_out; a.ws = (unsigned char*)d_ws;
#ifndef DUP_MASK
#define DUP_MASK 0
#endif
    for (int li = 0; li < N_LAUNCHES; ++li) {
        a.ph_lo = (N_LAUNCHES == 1) ? 0 : li; a.ph_hi = (N_LAUNCHES == 1) ? N_PHASES : li + 1; a.li = li; a.pad = 0;
        if (N_LAUNCHES != 1 && ((DUP_MASK >> li) & 1)) hipLaunchKernelGGL(hybrid_fwd, dim3(grid), dim3(NWAVES * 64), LDS_BYTES, stream, a);
#ifdef DUP_SUB
#ifndef DUP_PH
#define DUP_PH 2
#endif
        if (N_LAUNCHES != 1 && li == DUP_PH) { a.pad = DUP_SUB; hipLaunchKernelGGL(hybrid_fwd, dim3(grid), dim3(NWAVES * 64), LDS_BYTES, stream, a); a.pad = 0;
            (void)hipMemsetAsync((char*)d_ws + WS_CTL + CW_BQ * 4, 0, (CW_AQ + 64 * 8 - CW_BQ) * 4, stream); }
#endif
        hipLaunchKernelGGL(hybrid_fwd, dim3(grid), dim3(NWAVES * 64), LDS_BYTES, stream, a);
        const hipError_t le = hipPeekAtLastError();
        if (le != hipSuccess) { fprintf(stderr, "kernel_launch: launch %d failed: %s\n", li, hipGetErrorName(le)); break; }
    }
}
```

```cpp
#ifndef MK_N_LAUNCHES
#define MK_N_LAUNCHES 1
#endif
#include <hip/hip_runtime.h>
#include <cstdio>
#include <cstdint>
#include <cmath>
namespace pg8 {
#define PG8_LAS __attribute__((address_space(3)))
typedef unsigned short bf16_t;
typedef short bf16x8 __attribute__((ext_vector_type(8)));
typedef float f32x4 __attribute__((ext_vector_type(4)));
typedef unsigned u32x4 __attribute__((ext_vector_type(4)));
constexpr int BM = 256, BK = 64, HALF = 128, HTB = HALF * BK * 2  , STAGE_BYTES = 8 * HTB, NXCD = 8, WGM = 8;

__host__ __device__ __forceinline__ int lds_byte(int r, int c) { const int st = (r >> 4) * 2 + (c >> 5), rr = r & 15, cc = c & 31, ob = rr * 64 + cc * 2; return st * 1024 + (ob ^ (((ob >> 9) & 1) << 5)); }
__host__ __device__ __forceinline__ void stage_rc(int b, int& R, int& C) { const int st = b / 1024, sb = b % 1024, swz = sb ^ (((sb >> 9) & 1) << 5); R = (st >> 1) * 16 + swz / 64; C = (st & 1) * 32 + (swz % 64) / 2; }
__host__ __device__ __forceinline__ int perm32(int rho) { const int n = rho >> 4, i = rho & 15; return 8 * (i >> 2) + 4 * n + (i & 3); }

struct Unit { int pm, pn, kofs, ks; };
struct Gemm { const bf16_t* A; const bf16_t* Bt; int M, N, K, ld; };

struct StaticOrder {
    int nM, nN, nwg, G, c, wgm;
    int i0, i1;
    __host__ __device__ void init(int M, int N, int G_, int c_, int wgm_ = WGM) { nM = M / BM; nN = N / BM; nwg = nM * nN; G = G_; c = c_; wgm = wgm_; i0 = 0; i1 = 1 << 20; }
    __host__ __device__ bool next(int i, Unit& u) const {
        i += i0; if (i >= i1) return false;
        const long L = (long)i * G + c; if (L >= nwg) return false;
        int wgid = (int)L; { const int q = nwg / NXCD, r = nwg % NXCD, xcd = wgid % NXCD, off = wgid / NXCD; wgid = (xcd < r ? xcd * (q + 1) : r * (q + 1) + (xcd - r) * q) + off; }
        const int nig = wgm * nN, gid = wgid / nig, fm = gid * wgm, gsz = (nM - fm) < wgm ? (nM - fm) : wgm;
        u.pm = fm + ((wgid % nig) % gsz); u.pn = (wgid % nig) / gsz; u.kofs = 0; u.ks = 0; return true;
    }
    __device__ __forceinline__ void a_ready(const Unit&) const {}
    __device__ __forceinline__ void done(const Unit&) const {}
};
struct MiniOrder {
    int nN, nsplit, ksl, G, c, pm;
    __host__ __device__ void init(int N, int nsplit_, int ksl_, int G_, int c_, int pm_) { nN = N / BM; nsplit = nsplit_; ksl = ksl_; G = G_; c = c_; pm = pm_; }
    __host__ __device__ bool next(int i, Unit& u) const {
        const long L = (long)i * G + c; if (L >= (long)nN * nsplit) return false;
        const int m = (int)L; u.pm = pm; u.pn = m / nsplit; u.ks = m % nsplit; u.kofs = u.ks * ksl; return true;
    }
    __device__ __forceinline__ void a_ready(const Unit&) const {}
    __device__ __forceinline__ void done(const Unit&) const {}
};


typedef float f32x2_cv __attribute__((ext_vector_type(2))); typedef __bf16 bf16x2_cv __attribute__((ext_vector_type(2)));
__device__ __forceinline__ unsigned cvt_pk_bf16(float lo, float hi) { f32x2_cv v = {lo, hi}; bf16x2_cv b = __builtin_convertvector(v, bf16x2_cv); return __builtin_bit_cast(unsigned, b); }
typedef float f32x2 __attribute__((ext_vector_type(2)));
constexpr int E_DM = 4096, E_TP = 8192, E_MROWS = 8448, E_HW = 2048, E_DFF = 16384;
constexpr float E_EPS = 1e-6f;
__device__ __forceinline__ float dot4(const f32x4 a) { return (a[0] * a[0] + a[1] * a[1]) + (a[2] * a[2] + a[3] * a[3]); }
__device__ __forceinline__ void ssq_add(float* p, float v) { __hip_atomic_fetch_add(p, v, __ATOMIC_RELAXED, __HIP_MEMORY_SCOPE_AGENT); }

struct EpiInProj {
    static constexpr bool PERM = true, AFTER_DRAIN = false;
    bf16_t* qkv;
    float* out_kvp;
    float* out_kvs;
    const float* rope;
    __device__ __forceinline__ void operator()(const f32x4 (&acc)[2][2][4][2], const Unit& u, int wr, int wc, int fr, int fq) const {
        const int t = u.pn >> 3;
        const int col0 = (u.pn & 7) * BM + wc * 32 + 8 * fq;
        const int row0 = u.pm * BM + wr * 64 + fr;
        bf16_t* base = qkv + (size_t)t * ((size_t)E_MROWS * E_HW);
        float* fo = nullptr;
        if (t == 1 || t == 2 || t == 4 || t == 5) {
            const int idx = (t == 1) ? 0 : (t == 2) ? 1 : (t == 4) ? 2 : 3;
            fo = (u.pm < 32) ? out_kvp + (size_t)idx * ((size_t)E_TP * E_HW) : out_kvs + (size_t)idx * (256 * E_HW) - (size_t)E_TP * E_HW;
        }
        const bool rope_on = (t < 2) && (wc == 0);
        const float sgn = (fq < 2) ? -1.f : 1.f;
#pragma unroll
        for (int ai = 0; ai < 2; ++ai)
#pragma unroll
            for (int m = 0; m < 4; ++m) {
                const int row = row0 + ai * HALF + m * 16;
                f32x4 v[2][2];
#pragma unroll
                for (int bj = 0; bj < 2; ++bj)
#pragma unroll
                    for (int n = 0; n < 2; ++n) v[bj][n] = acc[ai][bj][m][n];
                if (rope_on) {
                    const float* rp = rope + (size_t)row * 32 + 8 * (fq & 1);
                    const f32x4 c0 = *(const f32x4*)(rp), c1 = *(const f32x4*)(rp + 4), s0 = *(const f32x4*)(rp + 16), s1 = *(const f32x4*)(rp + 20);
#pragma unroll
                    for (int bj = 0; bj < 2; ++bj)
#pragma unroll
                        for (int n = 0; n < 2; ++n)
#pragma unroll
                            for (int j = 0; j < 4; ++j) {
                                const float mine = v[bj][n][j], other = __shfl_xor(mine, 32);
                                const float cc = n ? c1[j] : c0[j], ss = n ? s1[j] : s0[j];
                                v[bj][n][j] = mine * cc + sgn * other * ss;
                            }
                }
#pragma unroll
                for (int bj = 0; bj < 2; ++bj) {
                    u32x4 w; w.x = cvt_pk_bf16(v[bj][0][0], v[bj][0][1]); w.y = cvt_pk_bf16(v[bj][0][2], v[bj][0][3]); w.z = cvt_pk_bf16(v[bj][1][0], v[bj][1][1]); w.w = cvt_pk_bf16(v[bj][1][2], v[bj][1][3]);
                    *(u32x4*)(base + (size_t)row * E_HW + col0 + bj * HALF) = w;
                }
                if (fo) {
#pragma unroll
                    for (int bj = 0; bj < 2; ++bj) { float* p = fo + (size_t)row * E_HW + col0 + bj * HALF; *(f32x4*)p = v[bj][0]; *(f32x4*)(p + 4) = v[bj][1]; }
                }
            }
    }
};

struct EpiOutProj {
    static constexpr bool PERM = true, AFTER_DRAIN = false;
    const float* xp; const float* xs; const float* g; bf16_t* x1b; bf16_t* h1; float* ssq;
    __device__ __forceinline__ void operator()(const f32x4 (&acc)[2][2][4][2], const Unit& u, int wr, int wc, int fr, int fq) const {
        const int col0 = u.pn * BM + wc * 32 + 8 * fq;
        const int row0 = u.pm * BM + wr * 64 + fr;
        f32x4 gv[2][2];
#pragma unroll
        for (int bj = 0; bj < 2; ++bj) { gv[bj][0] = *(const f32x4*)(g + col0 + bj * HALF); gv[bj][1] = *(const f32x4*)(g + col0 + bj * HALF + 4); }
#pragma unroll
        for (int ai = 0; ai < 2; ++ai)
#pragma unroll
            for (int m = 0; m < 4; ++m) {
                const int row = row0 + ai * HALF + m * 16;
                const float* xrow = (row < E_TP) ? xp + (size_t)row * E_DM : xs + (size_t)(row - E_TP) * E_DM;
                float s = 0.f;
#pragma unroll
                for (int bj = 0; bj < 2; ++bj) {
                    const f32x4 r0 = *(const f32x4*)(xrow + col0 + bj * HALF), r1 = *(const f32x4*)(xrow + col0 + bj * HALF + 4);
                    const f32x4 v0 = acc[ai][bj][m][0] + r0, v1 = acc[ai][bj][m][1] + r1;
                    { u32x4 w; w.x = cvt_pk_bf16(v0[0], v0[1]); w.y = cvt_pk_bf16(v0[2], v0[3]); w.z = cvt_pk_bf16(v1[0], v1[1]); w.w = cvt_pk_bf16(v1[2], v1[3]); *(u32x4*)(x1b + (size_t)row * E_DM + col0 + bj * HALF) = w; }
                    s += dot4(v0) + dot4(v1);
                    const f32x4 a = v0 * gv[bj][0], b = v1 * gv[bj][1];
                    u32x4 w; w.x = cvt_pk_bf16(a[0], a[1]); w.y = cvt_pk_bf16(a[2], a[3]); w.z = cvt_pk_bf16(b[0], b[1]); w.w = cvt_pk_bf16(b[2], b[3]);
                    *(u32x4*)(h1 + (size_t)row * E_DM + col0 + bj * HALF) = w;
                }
                s += __shfl_xor(s, 16); s += __shfl_xor(s, 32);
                if (fq == 0) ssq_add(ssq + row, s);
                if (m & 1) asm volatile("" ::: "memory");
            }
    }
};

struct EpiUp {
    static constexpr bool PERM = true, AFTER_DRAIN = false;
    const float* ssq; bf16_t* U;
    __device__ __forceinline__ void operator()(const f32x4 (&acc)[2][2][4][2], const Unit& u, int wr, int wc, int fr, int fq) const {
        const int col0 = u.pn * BM + wc * 32 + 8 * fq;
        const int row0 = u.pm * BM + wr * 64 + fr;
#pragma unroll
        for (int ai = 0; ai < 2; ++ai)
#pragma unroll
            for (int m = 0; m < 4; ++m) {
                const int row = row0 + ai * HALF + m * 16;
                const float rs = __builtin_amdgcn_rsqf(ssq[row] * (1.0f / E_DM) + E_EPS);
#pragma unroll
                for (int bj = 0; bj < 2; ++bj) {
                    f32x4 a = acc[ai][bj][m][0] * rs, b = acc[ai][bj][m][1] * rs;
#pragma unroll
                    for (int j = 0; j < 4; ++j) { const float x = fmaxf(a[j], 0.f), y = fmaxf(b[j], 0.f); a[j] = x * x; b[j] = y * y; }
                    u32x4 w; w.x = cvt_pk_bf16(a[0], a[1]); w.y = cvt_pk_bf16(a[2], a[3]); w.z = cvt_pk_bf16(b[0], b[1]); w.w = cvt_pk_bf16(b[2], b[3]);
                    *(u32x4*)(U + (size_t)row * E_DFF + col0 + bj * HALF) = w;
                }
            }
    }
};

__device__ __forceinline__ float bf_lo(unsigned w) { return __uint_as_float(w << 16); }
__device__ __forceinline__ float bf_hi(unsigned w) { return __uint_as_float(w & 0xffff0000u); }
struct EpiDown {
    static constexpr bool PERM = true, AFTER_DRAIN = false;
    const bf16_t* x1b; bf16_t* x2b; float* ssq;
    __device__ __forceinline__ void operator()(const f32x4 (&acc)[2][2][4][2], const Unit& u, int wr, int wc, int fr, int fq) const {
        const int col0 = u.pn * BM + wc * 32 + 8 * fq;
        const int row0 = u.pm * BM + wr * 64 + fr;
#pragma unroll
        for (int ai = 0; ai < 2; ++ai)
#pragma unroll
            for (int m = 0; m < 4; ++m) {
                const int row = row0 + ai * HALF + m * 16;
                float s = 0.f;
#pragma unroll
                for (int bj = 0; bj < 2; ++bj) {
                    const u32x4 r = *(const u32x4*)(x1b + (size_t)row * E_DM + col0 + bj * HALF);
                    const f32x4 v0 = acc[ai][bj][m][0] + (f32x4){bf_lo(r.x), bf_hi(r.x), bf_lo(r.y), bf_hi(r.y)}, v1 = acc[ai][bj][m][1] + (f32x4){bf_lo(r.z), bf_hi(r.z), bf_lo(r.w), bf_hi(r.w)};
                    u32x4 w; w.x = cvt_pk_bf16(v0[0], v0[1]); w.y = cvt_pk_bf16(v0[2], v0[3]); w.z = cvt_pk_bf16(v1[0], v1[1]); w.w = cvt_pk_bf16(v1[2], v1[3]);
                    *(u32x4*)(x2b + (size_t)row * E_DM + col0 + bj * HALF) = w;
                    s += dot4(v0) + dot4(v1);
                }
                s += __shfl_xor(s, 16); s += __shfl_xor(s, 32);
                if (fq == 0) ssq_add(ssq + row, s);
                if (m & 1) asm volatile("" ::: "memory");
            }
    }
};

struct EpiPartial {
    static constexpr bool PERM = true, AFTER_DRAIN = false;
    float* part; int N;
    __device__ __forceinline__ void operator()(const f32x4 (&acc)[2][2][4][2], const Unit& u, int wr, int wc, int fr, int fq) const {
        const int col0 = u.pn * BM + wc * 32 + 8 * fq;
        float* base = part + ((size_t)u.ks * BM + wr * 64 + fr) * N + col0;
#pragma unroll
        for (int ai = 0; ai < 2; ++ai)
#pragma unroll
            for (int m = 0; m < 4; ++m)
#pragma unroll
                for (int bj = 0; bj < 2; ++bj) { float* p = base + (size_t)(ai * HALF + m * 16) * N + bj * HALF; *(f32x4*)p = acc[ai][bj][m][0]; *(f32x4*)(p + 4) = acc[ai][bj][m][1]; }
    }
};

template <class Epi, class Sched, bool ALIGN_EPI = false, bool SP2 = false>
__device__ __forceinline__ void gemm_phase(PG8_LAS unsigned char* lds, const Gemm g, const Sched& S, const Epi& E) {
    int tid = threadIdx.x; asm volatile("" : "+v"(tid));
    const int wid = __builtin_amdgcn_readfirstlane(tid >> 6), lane = tid & 63, wr = wid >> 2, wc = wid & 3, fr = lane & 15, fq = lane >> 4;
    const int K = g.ld, nt = g.K / BK;
    unsigned voffA[2], voffB[2];
#pragma unroll
    for (int i = 0; i < 2; ++i) { int R, C; stage_rc(tid * 16 + i * 8192, R, C); const int Rb = Epi::PERM ? ((R & ~31) + perm32(R & 31)) : R;
        voffA[i] = (unsigned)(R * K + C) * 2u; voffB[i] = (unsigned)(Rb * BK + C) * 2u; }
    const size_t kstep = (size_t)(BK * 2);
    const size_t hstep = (size_t)HALF * K * 2;
    const size_t tstep = 2 * hstep;
    const size_t kstepB = (size_t)BM * BK * 2, hstepB = (size_t)HALF * BK * 2, tstepB = (size_t)(K / BK) * kstepB;
    const unsigned ldsw = (unsigned)wid * 1024u;
    const int aoff = lds_byte(wr * 64 + fr, fq * 8), boff = lds_byte(wc * 32 + fr, fq * 8);
#define PG8_SA(b, h) (((b) * 2 + (h)) * HTB)
#define PG8_SB(b, h) ((4 + (b) * 2 + (h)) * HTB)
#define PG8_STAGE(bufoff, gbase, voff) do { _Pragma("unroll") for (int _i = 0; _i < 2; ++_i) \
        __builtin_amdgcn_global_load_lds((const unsigned*)((const char*)(gbase) + (voff)[_i]), (PG8_LAS unsigned*)(lds + (bufoff) + ldsw + _i * 8192), 16, 0, 0); } while (0)
#define PG8_LDA(dst, b, h) do { _Pragma("unroll") for (int m = 0; m < 4; ++m) _Pragma("unroll") for (int k = 0; k < 2; ++k) dst[m][k] = *(const PG8_LAS bf16x8*)(lds + PG8_SA(b, h) + aoff + m * 2048 + k * 1024); } while (0)
#define PG8_LDB(dst, b, h) do { _Pragma("unroll") for (int n = 0; n < 2; ++n) _Pragma("unroll") for (int k = 0; k < 2; ++k) dst[n][k] = *(const PG8_LAS bf16x8*)(lds + PG8_SB(b, h) + boff + n * 2048 + k * 1024); } while (0)
#define PG8_MMA(ai, bj, At, Bt) do { __builtin_amdgcn_s_setprio(1); _Pragma("unroll") for (int m = 0; m < 4; ++m) _Pragma("unroll") for (int n = 0; n < 2; ++n) _Pragma("unroll") for (int k = 0; k < 2; ++k) \
        acc[ai][bj][m][n] = __builtin_amdgcn_mfma_f32_16x16x32_bf16(Bt[n][k], At[m][k], acc[ai][bj][m][n], 0, 0, 0); __builtin_amdgcn_s_setprio(0); } while (0)
#define PG8_WAIT_V(n) asm volatile("s_waitcnt vmcnt(" #n ")" ::: "memory")
#define PG8_WAIT_L(n) asm volatile("s_waitcnt lgkmcnt(" #n ")" ::: "memory")
#define PG8_BAR __builtin_amdgcn_s_barrier()
#define PG8_SCHED __builtin_amdgcn_sched_barrier(0)
    Unit cur, nxt; int ui = 0;
    if (!S.next(0, cur)) return;
    f32x4 acc[2][2][4][2];
#pragma unroll
    for (int a = 0; a < 2; ++a)
#pragma unroll
        for (int b = 0; b < 2; ++b)
#pragma unroll
            for (int m = 0; m < 4; ++m)
#pragma unroll
                for (int n = 0; n < 2; ++n) acc[a][b][m][n] = (f32x4){0.f, 0.f, 0.f, 0.f};
    bf16x8 At[4][2], B0[2][2], B1[2][2];
    const char* cA = (const char*)g.A + (size_t)cur.pm * tstep + (size_t)cur.kofs * 2; const char* cB = (const char*)g.Bt + (size_t)cur.pn * tstepB + (size_t)(cur.kofs / BK) * kstepB;
    S.a_ready(cur);
    if constexpr (SP2) {
        PG8_STAGE(PG8_SB(0, 0), cB, voffB); PG8_STAGE(PG8_SB(0, 1), cB + hstepB, voffB); PG8_STAGE(PG8_SA(0, 0), cA, voffA); PG8_STAGE(PG8_SA(0, 1), cA + hstep, voffA);
        if (wr == 1) PG8_BAR;
        PG8_WAIT_V(2); PG8_BAR;
        PG8_STAGE(PG8_SB(1, 0), cB + kstepB, voffB); PG8_STAGE(PG8_SA(1, 0), cA + kstep, voffA); PG8_STAGE(PG8_SB(1, 1), cB + hstepB + kstepB, voffB);
        PG8_WAIT_V(6); PG8_BAR;
    } else {
        PG8_STAGE(PG8_SB(0, 0), cB, voffB); PG8_STAGE(PG8_SA(0, 0), cA, voffA); PG8_STAGE(PG8_SB(0, 1), cB + hstepB, voffB); PG8_STAGE(PG8_SA(0, 1), cA + hstep, voffA);
        if (wr == 1) PG8_BAR;
        PG8_WAIT_V(4); PG8_BAR;
        PG8_STAGE(PG8_SB(1, 0), cB + kstepB, voffB); PG8_STAGE(PG8_SA(1, 0), cA + kstep, voffA); PG8_STAGE(PG8_SB(1, 1), cB + hstepB + kstepB, voffB);
        PG8_WAIT_V(6); PG8_BAR;
    }
    for (;;) {
        const bool has_next = S.next(ui + 1, nxt);
        const char* nA = has_next ? (const char*)g.A + (size_t)nxt.pm * tstep + (size_t)nxt.kofs * 2 : cA; const char* nB = has_next ? (const char*)g.Bt + (size_t)nxt.pn * tstepB + (size_t)(nxt.kofs / BK) * kstepB : cB;
        for (int t = 0; t < nt; t += 2) {
            const bool last = (t == nt - 2);
            const char* a1 = cA + (size_t)(t + 1) * kstep;
            const char* a2 = last ? nA : cA + (size_t)(t + 2) * kstep; const char* b2 = last ? nB : cB + (size_t)(t + 2) * kstepB;
            const char* a3 = a2 + kstep; const char* b3 = b2 + kstepB;
            if (last && has_next) S.a_ready(nxt);
            if constexpr (SP2) {
            PG8_LDB(B0, 0, 0); PG8_LDB(B1, 0, 1); PG8_SCHED; PG8_LDA(At, 0, 0); PG8_STAGE(PG8_SA(1, 1), a1 + hstep, voffA);
            PG8_WAIT_V(8); PG8_WAIT_L(0); PG8_BAR; PG8_MMA(0, 0, At, B0); PG8_MMA(0, 1, At, B1); PG8_BAR; PG8_SCHED;
            PG8_LDA(At, 0, 1); PG8_STAGE(PG8_SB(0, 0), b2, voffB); PG8_STAGE(PG8_SB(0, 1), b2 + hstepB, voffB); PG8_STAGE(PG8_SA(0, 0), a2, voffA);
            PG8_WAIT_V(8); PG8_WAIT_L(0); PG8_BAR; PG8_MMA(1, 0, At, B0); PG8_MMA(1, 1, At, B1); PG8_BAR; PG8_SCHED;
            PG8_LDB(B0, 1, 0); PG8_LDB(B1, 1, 1); PG8_SCHED; PG8_LDA(At, 1, 0); PG8_STAGE(PG8_SA(0, 1), a2 + hstep, voffA);
            PG8_WAIT_V(8); PG8_WAIT_L(0); PG8_BAR; PG8_MMA(0, 0, At, B0); PG8_MMA(0, 1, At, B1); PG8_BAR; PG8_SCHED;
            PG8_LDA(At, 1, 1); PG8_STAGE(PG8_SB(1, 0), b3, voffB); PG8_STAGE(PG8_SB(1, 1), b3 + hstepB, voffB); PG8_STAGE(PG8_SA(1, 0), a3, voffA);
            PG8_WAIT_V(8); PG8_WAIT_L(0); PG8_BAR; PG8_MMA(1, 0, At, B0); PG8_MMA(1, 1, At, B1); PG8_BAR; PG8_SCHED;
            } else {
            PG8_LDB(B0, 0, 0); PG8_SCHED; PG8_LDA(At, 0, 0); PG8_STAGE(PG8_SA(1, 1), a1 + hstep, voffA);
            PG8_WAIT_L(8); PG8_BAR; PG8_WAIT_L(0); PG8_MMA(0, 0, At, B0); PG8_BAR; PG8_SCHED;
            PG8_LDB(B1, 0, 1); PG8_STAGE(PG8_SB(0, 0), b2, voffB);
            PG8_BAR; PG8_WAIT_L(0); PG8_MMA(0, 1, At, B1); PG8_BAR;
            PG8_LDA(At, 0, 1); PG8_STAGE(PG8_SA(0, 0), a2, voffA);
            PG8_BAR; PG8_WAIT_L(0); PG8_MMA(1, 0, At, B0); PG8_BAR; PG8_SCHED;
            PG8_STAGE(PG8_SB(0, 1), b2 + hstepB, voffB);
            PG8_WAIT_V(6); PG8_BAR; PG8_MMA(1, 1, At, B1); PG8_BAR;
            PG8_LDB(B0, 1, 0); PG8_SCHED; PG8_LDA(At, 1, 0); PG8_STAGE(PG8_SA(0, 1), a2 + hstep, voffA);
            PG8_WAIT_L(8); PG8_BAR; PG8_WAIT_L(0); PG8_MMA(0, 0, At, B0); PG8_BAR; PG8_SCHED;
            PG8_LDB(B1, 1, 1); PG8_STAGE(PG8_SB(1, 0), b3, voffB);
            PG8_BAR; PG8_WAIT_L(0); PG8_MMA(0, 1, At, B1); PG8_BAR;
            PG8_LDA(At, 1, 1); PG8_STAGE(PG8_SA(1, 0), a3, voffA);
            PG8_BAR; PG8_WAIT_L(0); PG8_MMA(1, 0, At, B0); PG8_BAR; PG8_SCHED;
            PG8_STAGE(PG8_SB(1, 1), b3 + hstepB, voffB);
            PG8_WAIT_V(6); PG8_BAR; PG8_MMA(1, 1, At, B1); PG8_BAR;
            }
        }
        if constexpr (ALIGN_EPI) { if (wr == 0) PG8_BAR; }
        if constexpr (!Epi::AFTER_DRAIN) { E(acc, cur, wr, wc, fr, fq); S.done(cur); }
        if (!has_next) break;
#pragma unroll
        for (int a = 0; a < 2; ++a)
#pragma unroll
            for (int b = 0; b < 2; ++b)
#pragma unroll
                for (int m = 0; m < 4; ++m)
#pragma unroll
                    for (int n = 0; n < 2; ++n) acc[a][b][m][n] = (f32x4){0.f, 0.f, 0.f, 0.f};
        cur = nxt; cA = nA; cB = nB; ++ui;
        if constexpr (ALIGN_EPI) { if (wr == 1) PG8_BAR; }
    }
    PG8_WAIT_V(0);
    if constexpr (!ALIGN_EPI) { if (wr == 0) PG8_BAR; }
    PG8_BAR;
    if constexpr (Epi::AFTER_DRAIN) { E.fused(acc, cur, wr, wc, fr, fq, lds, wid, lane); S.done(cur); }
#undef PG8_SA
#undef PG8_SB
#undef PG8_STAGE
#undef PG8_LDA
#undef PG8_LDB
#undef PG8_MMA
#undef PG8_WAIT_V
#undef PG8_WAIT_L
#undef PG8_BAR
#undef PG8_SCHED
}
}
namespace att {
#define ALAS __attribute__((address_space(3)))
typedef unsigned short bf16;
using bf16x8 = __attribute__((ext_vector_type(8))) short;
using s16x4  = __attribute__((ext_vector_type(4))) short;
using f32x16 = __attribute__((ext_vector_type(16))) float;
using f32x8  = __attribute__((ext_vector_type(8))) float;
using f32x4  = __attribute__((ext_vector_type(4))) float;
using u32x4  = __attribute__((ext_vector_type(4))) unsigned;
constexpr int D = 128, NW = 8, QBLK = 32, KVBLK = 64;
constexpr float SCALE = 0.088388347648318440f;
constexpr float LOG2E = 1.4426950408889634f, LN2 = 0.6931471805599453f;
constexpr float THR = 8.f;
constexpr int HW = 2048;
constexpr int DMODEL = 4096, TP = 8192;
constexpr float EPS = 1e-6f;
constexpr int SHM_V = KVBLK * D * 2, SHM_K = KVBLK * D * 2;
#define KSWZ(row, colB) ((row) * 256 + ((colB) ^ (((row) & 7) << 4)))
#define SBAR() __builtin_amdgcn_sched_barrier(0)
__device__ __forceinline__ int crow(int r, int hi) { return (r & 3) + 8 * (r >> 2) + 4 * hi; }
typedef float f32x2_cv __attribute__((ext_vector_type(2))); typedef __bf16 bf16x2_cv __attribute__((ext_vector_type(2)));
__device__ __forceinline__ unsigned cvtpk(float lo, float hi) { f32x2_cv v = {lo, hi}; bf16x2_cv b = __builtin_convertvector(v, bf16x2_cv); return __builtin_bit_cast(unsigned, b); }
__device__ __forceinline__ bf16x8 ld8bf(const bf16* p) { return *reinterpret_cast<const bf16x8*>(p); }
__device__ __forceinline__ f32x8 ld8f(const float* p) { return *reinterpret_cast<const f32x8*>(p); }
__device__ __forceinline__ bf16x8 tobf(f32x8 x) { u32x4 w = {cvtpk(x[0], x[1]), cvtpk(x[2], x[3]), cvtpk(x[4], x[5]), cvtpk(x[6], x[7])}; return *reinterpret_cast<bf16x8*>(&w); }
__device__ __forceinline__ bf16x8 ld8any(const bf16* p) { return ld8bf(p); }
__device__ __forceinline__ bf16x8 ld8any(const float* p) { return tobf(ld8f(p)); }
__device__ __forceinline__ float swap32(float x, int hi) {
    auto rr = __builtin_amdgcn_permlane32_swap(__float_as_uint(x), __float_as_uint(x), false, false);
    return __uint_as_float(hi ? rr[0] : rr[1]);
}

__device__ __forceinline__ void glds16(const void* gsrc, unsigned lds_dst) { unsigned keep;
  asm volatile("s_mov_b32 %0, m0\n\ts_mov_b32 m0, %2\n\ts_nop 0\n\tglobal_load_lds_dwordx4 %1, off\n\ts_mov_b32 m0, %0" : "=&s"(keep) : "v"(gsrc), "s"(lds_dst) : "memory"); }
__device__ __forceinline__ void partialSM(f32x16& p0, f32x16& p1, float& m_reg, float& mn, float& alpha, float msk = 0.f) {
  constexpr float C = SCALE * LOG2E;
  float pmax = p0[0];
#pragma unroll
  for (int r = 1; r < 16; ++r) pmax = fmaxf(pmax, p0[r]);
#pragma unroll
  for (int r = 0; r < 16; ++r) pmax = fmaxf(pmax, p1[r]);
  { auto rr = __builtin_amdgcn_permlane32_swap(__float_as_uint(pmax), __float_as_uint(pmax), false, false);
    pmax = fmaxf(__uint_as_float(rr[0]), __uint_as_float(rr[1])) + msk; }
  if (__builtin_expect(__all(pmax - m_reg <= THR / SCALE), 1)) { mn = m_reg; alpha = 1.f; }
  else { mn = fmaxf(m_reg, pmax); alpha = __builtin_amdgcn_exp2f((m_reg - mn) * C); m_reg = mn; }
  float mnC = -mn * C + msk;
#pragma unroll
  for (int r = 0; r < 16; ++r) p0[r] = fmaf(p0[r], C, mnC);
#pragma unroll
  for (int r = 0; r < 16; ++r) p1[r] = fmaf(p1[r], C, mnC);
#pragma unroll
  for (int r = 0; r < 16; ++r) p0[r] = __builtin_amdgcn_exp2f(p0[r]);
}
#define PK4(P, BASE, OUT) do { unsigned a0 = cvtpk(P[BASE + 0], P[BASE + 1]), a1 = cvtpk(P[BASE + 2], P[BASE + 3]);   \
    unsigned b0 = cvtpk(P[BASE + 4], P[BASE + 5]), b1 = cvtpk(P[BASE + 6], P[BASE + 7]);                              \
    auto r0 = __builtin_amdgcn_permlane32_swap(a0, b0, false, false); auto r1 = __builtin_amdgcn_permlane32_swap(a1, b1, false, false); \
    u32x4 w = {r0[0], r1[0], r0[1], r1[1]}; OUT = *reinterpret_cast<bf16x8*>(&w); } while (0)
__device__ __forceinline__ void finishSM(f32x16& p0, f32x16& p1, float alpha, float& l_reg, bf16x8& pa0, bf16x8& pa1, bf16x8& pa2, bf16x8& pa3) {
#pragma unroll
  for (int r = 0; r < 16; ++r) p1[r] = __builtin_amdgcn_exp2f(p1[r]);
  float ps = 0;
#pragma unroll
  for (int r = 0; r < 16; ++r) ps += p0[r];
#pragma unroll
  for (int r = 0; r < 16; ++r) ps += p1[r];
  { auto rr = __builtin_amdgcn_permlane32_swap(__float_as_uint(ps), __float_as_uint(ps), false, false);
    ps = __uint_as_float(rr[0]) + __uint_as_float(rr[1]); }
  l_reg = l_reg * alpha + ps;
  PK4(p0, 0, pa0); PK4(p0, 8, pa1); PK4(p1, 0, pa2); PK4(p1, 8, pa3);
}
__device__ __forceinline__ void qkt(f32x16& p0, f32x16& p1, const ALAS char* Ks, const bf16x8* qr, int r32, int hi) {
  p0 = f32x16{}; p1 = f32x16{};
#pragma unroll
  for (int d0 = 0; d0 < 8; ++d0) { int cb = (d0 * 16 + hi * 8) * 2;
    bf16x8 b0 = *reinterpret_cast<const ALAS bf16x8*>(Ks + KSWZ(r32, cb));
    bf16x8 b1 = *reinterpret_cast<const ALAS bf16x8*>(Ks + KSWZ(32 + r32, cb));
    p0 = __builtin_amdgcn_mfma_f32_32x32x16_bf16(b0, qr[d0], p0, 0, 0, 0);
    p1 = __builtin_amdgcn_mfma_f32_32x32x16_bf16(b1, qr[d0], p1, 0, 0, 0); }
}
template <int NQR>
__device__ __forceinline__ void qkt_h(f32x16& p0, f32x16& p1, const ALAS char* Ks, const bf16x8* qr, const ALAS char* Qs, int qrow, int r32, int hi) {
  p0 = f32x16{}; p1 = f32x16{};
#pragma unroll
  for (int d0 = 0; d0 < 8; ++d0) { int cb = (d0 * 16 + hi * 8) * 2;
    bf16x8 b0 = *reinterpret_cast<const ALAS bf16x8*>(Ks + KSWZ(r32, cb));
    bf16x8 b1 = *reinterpret_cast<const ALAS bf16x8*>(Ks + KSWZ(32 + r32, cb));
    bf16x8 q = d0 < NQR ? qr[d0] : *reinterpret_cast<const ALAS bf16x8*>(Qs + KSWZ(qrow, cb));
    p0 = __builtin_amdgcn_mfma_f32_32x32x16_bf16(b0, q, p0, 0, 0, 0);
    p1 = __builtin_amdgcn_mfma_f32_32x32x16_bf16(b1, q, p1, 0, 0, 0); }
}
__device__ __forceinline__ int v_st(int k, int c) { const int kk = (k & ~0xC) | ((k & 4) << 1) | ((k & 8) >> 1); return ((kk >> 3) * 4 + (c >> 5)) * 512 + ((kk & 7) * 32 + (c & 31)) * 2; }
__device__ __forceinline__ int v_rd_base(int lane) { return ((lane & 3) << 3) | (((lane >> 2) & 3) << 6) | (((lane >> 4) & 1) << 5) | (((lane >> 5) & 1) << 8); }
constexpr int v_rd_off(int d0, int ks, int half) { return d0 * 512 + ks * 4096 + half * 2048; }
template <int OFF> __device__ __forceinline__ s16x4 tr_read(int vb) {
  s16x4 r; asm volatile("ds_read_b64_tr_b16 %0, %1 offset:%2" : "=&v"(r) : "v"(vb), "i"(OFF) : "memory"); return r;
}
template <int D0> __device__ __forceinline__ void pv_one(f32x16& od, int vb, bf16x8 pa0, bf16x8 pa1, bf16x8 pa2, bf16x8 pa3) {
  const s16x4 l0 = tr_read<v_rd_off(D0, 0, 0)>(vb), h0 = tr_read<v_rd_off(D0, 0, 1)>(vb), l1 = tr_read<v_rd_off(D0, 1, 0)>(vb), h1 = tr_read<v_rd_off(D0, 1, 1)>(vb);
  const s16x4 l2 = tr_read<v_rd_off(D0, 2, 0)>(vb), h2 = tr_read<v_rd_off(D0, 2, 1)>(vb), l3 = tr_read<v_rd_off(D0, 3, 0)>(vb), h3 = tr_read<v_rd_off(D0, 3, 1)>(vb);
  asm volatile("s_waitcnt lgkmcnt(0)" ::: "memory"); SBAR();
#define PK(L, H) (bf16x8){L[0], L[1], L[2], L[3], H[0], H[1], H[2], H[3]}
  od = __builtin_amdgcn_mfma_f32_32x32x16_bf16(pa0, PK(l0, h0), od, 0, 0, 0);
  od = __builtin_amdgcn_mfma_f32_32x32x16_bf16(pa1, PK(l1, h1), od, 0, 0, 0);
  od = __builtin_amdgcn_mfma_f32_32x32x16_bf16(pa2, PK(l2, h2), od, 0, 0, 0);
  od = __builtin_amdgcn_mfma_f32_32x32x16_bf16(pa3, PK(l3, h3), od, 0, 0, 0);
#undef PK
}
__device__ __forceinline__ void pv_d0(f32x16* o, int vb, bf16x8 pa0, bf16x8 pa1, bf16x8 pa2, bf16x8 pa3) {
  pv_one<0>(o[0], vb, pa0, pa1, pa2, pa3); pv_one<1>(o[1], vb, pa0, pa1, pa2, pa3); pv_one<2>(o[2], vb, pa0, pa1, pa2, pa3); pv_one<3>(o[3], vb, pa0, pa1, pa2, pa3);
}
__device__ __forceinline__ void fill_neg(f32x16& p0, f32x16& p1) {
#pragma unroll
  for (int r = 0; r < 16; ++r) { p0[r] = -1e30f; p1[r] = -1e30f; }
}

constexpr int SHM_QOFF = 2 * SHM_V + 2 * SHM_K + NW * 64 * 4, SHM_ATTN = SHM_QOFF + 256 * 256;
constexpr int NQR = 8;
__device__ __forceinline__ void attnA_prompt_unit(int vh, int qb, const bf16* __restrict__ AQ, const bf16* __restrict__ AK, const bf16* __restrict__ AV, float* __restrict__ OA, ALAS char* lds) {
  int tid = threadIdx.x; asm volatile("" : "+v"(tid));
  const int wid = __builtin_amdgcn_readfirstlane(tid >> 6), lane = tid & 63, r32 = lane & 31, hi = lane >> 5;
  const int h = vh >> 2, c = (vh >> 1) & 1, vhalf = vh & 1;
  const bf16* Qb = AQ + (size_t)(qb * 256) * HW + h * 256 + c * 128;
  const bf16* Kh = AK + h * 256 + c * 128;
  const bf16* Vh = AV + h * 256 + vhalf * 128;
  float* Ob = OA + (size_t)(qb * 256) * DMODEL + h * 512 + c * 256 + vhalf * 128;
  const int NT = 4 * qb + 4, jmax = 4 * qb + (wid >> 1);
  ALAS char* V_lds = lds; ALAS char* K_lds = lds + 2 * SHM_V;
  ALAS float* ws = (ALAS float*)(lds + 2 * SHM_V + 2 * SHM_K) + wid * 64; ALAS float* li_l = ws; ALAS float* al_l = ws + 32;
  float m_reg = -1e30f, l_reg = 0; f32x16 o[4] = {}; bf16x8 qr[NQR];
  const bf16* Qw = Qb + (size_t)(wid * QBLK + r32) * HW + hi * 8;
  ALAS char* Q_lds = lds + SHM_QOFF; const int qrow = wid * QBLK + r32;
#pragma unroll
  for (int d0 = 0; d0 < 8; ++d0) { const bf16x8 q = ld8bf(Qw + d0 * 16); if (d0 < NQR) qr[d0] = q; else *(ALAS bf16x8*)(Q_lds + KSWZ(qrow, (d0 * 16 + hi * 8) * 2)) = q; }
  const int sr = tid >> 4, sc = (tid & 15) * 8, vst0 = v_st(sr, sc), vst1 = v_st(32 + sr, sc);
  const int vb0 = (int)(unsigned)(uintptr_t)V_lds + v_rd_base(lane);
  constexpr int SDEPTH = 1;
  struct { bf16x8 vs0, vs1, ks0, ks1; } sr_[SDEPTH];
  const unsigned lo0 = (unsigned)(sr * HW + sc) * 2u, lo1 = lo0 + 32u * HW * 2u;
#define SLOAD(i, k0) do { const char* kb_ = (const char*)Kh + (size_t)(k0) * (HW * 2); const char* vb_ = (const char*)Vh + (size_t)(k0) * (HW * 2); \
    sr_[i].vs0 = *(const bf16x8*)(vb_ + lo0); sr_[i].vs1 = *(const bf16x8*)(vb_ + lo1); sr_[i].ks0 = *(const bf16x8*)(kb_ + lo0); sr_[i].ks1 = *(const bf16x8*)(kb_ + lo1); } while (0)
#define SWRITE(b, i) do { *(ALAS bf16x8*)(V_lds + (b) * SHM_V + vst0) = sr_[i].vs0;          \
    *(ALAS bf16x8*)(V_lds + (b) * SHM_V + vst1) = sr_[i].vs1; int kc = sc * 2;               \
    *(ALAS bf16x8*)(K_lds + (b) * SHM_K + KSWZ(sr, kc)) = sr_[i].ks0;                       \
    *(ALAS bf16x8*)(K_lds + (b) * SHM_K + KSWZ(32 + sr, kc)) = sr_[i].ks1; } while (0)
#define SWAIT() do { if constexpr (SDEPTH == 2) asm volatile("s_waitcnt vmcnt(4)" ::: "memory"); else asm volatile("s_waitcnt vmcnt(0)" ::: "memory"); } while (0)
#define RESC(a) do { if (__any((a) < 1.f)) { if (hi == 0) al_l[r32] = (a); asm volatile("s_waitcnt lgkmcnt(0)" ::: "memory"); \
    _Pragma("unroll") for (int d = 0; d < 4; ++d) _Pragma("unroll") for (int r = 0; r < 16; ++r) o[d][r] *= al_l[crow(r, hi)]; } } while (0)
#define QKT_M(P0, P1, KS, j) qkt_h<NQR>(P0, P1, KS, qr, Q_lds, qrow, r32, hi)
#define MSK(j) (((j) <= jmax) ? 0.f : -1e30f)
  f32x16 pA0, pA1, pB0, pB1; float mnA, mnB, alA, alB; bf16x8 pa0, pa1, pa2, pa3;
  constexpr int SE = 0, SO = SDEPTH - 1;
  SLOAD(SE, 0); asm volatile("s_waitcnt vmcnt(0)" ::: "memory"); SWRITE(0, SE); __syncthreads();
  QKT_M(pA0, pA1, K_lds, 0); partialSM(pA0, pA1, m_reg, mnA, alA);
  SLOAD(SO, KVBLK); if constexpr (SDEPTH == 2) { if (2 < NT) SLOAD(SE, 2 * KVBLK); }
  SWAIT(); SWRITE(1, SO); __syncthreads();
  for (int j = 1; j + 1 < NT; j += 2) {
    SBAR(); QKT_M(pB0, pB1, K_lds + SHM_K, j);
    finishSM(pA0, pA1, alA, l_reg, pa0, pa1, pa2, pa3); SBAR();
    SLOAD(SO, (j + SDEPTH) * KVBLK); SBAR();
    pv_d0(o, vb0, pa0, pa1, pa2, pa3); partialSM(pB0, pB1, m_reg, mnB, alB, MSK(j));
    __syncthreads(); SWAIT(); SWRITE(0, SE);
    RESC(alB); __syncthreads();
    SBAR(); QKT_M(pA0, pA1, K_lds, j + 1);
    finishSM(pB0, pB1, alB, l_reg, pa0, pa1, pa2, pa3); SBAR();
    if (SDEPTH == 1 || j + 3 < NT) SLOAD(SE, (j + 1 + SDEPTH) * KVBLK); SBAR();
    pv_d0(o, vb0 + SHM_V, pa0, pa1, pa2, pa3); partialSM(pA0, pA1, m_reg, mnA, alA, MSK(j + 1));
    __syncthreads(); SWAIT(); SWRITE(1, SO);
    RESC(alA); __syncthreads();
  }
  SBAR(); QKT_M(pB0, pB1, K_lds + SHM_K, NT - 1);
  finishSM(pA0, pA1, alA, l_reg, pa0, pa1, pa2, pa3); SBAR();
  pv_d0(o, vb0, pa0, pa1, pa2, pa3); partialSM(pB0, pB1, m_reg, mnB, alB, MSK(NT - 1));
  __syncthreads(); RESC(alB);
  finishSM(pB0, pB1, alB, l_reg, pa0, pa1, pa2, pa3); SBAR();
  pv_d0(o, vb0 + SHM_V, pa0, pa1, pa2, pa3);
  if (hi == 0) li_l[r32] = l_reg; asm volatile("s_waitcnt lgkmcnt(0)" ::: "memory");
  float rli[16];
#pragma unroll
  for (int r = 0; r < 16; ++r) rli[r] = __builtin_amdgcn_rcpf(li_l[crow(r, hi)]);
  float* Ow = Ob + (size_t)(wid * QBLK) * DMODEL;
#pragma unroll
  for (int r = 0; r < 16; ++r) { int orow = crow(r, hi);
#pragma unroll
    for (int d0 = 0; d0 < 4; ++d0) Ow[(size_t)orow * DMODEL + d0 * 32 + r32] = o[d0][r] * rli[r]; }
  __syncthreads();
#undef SLOAD
#undef SWRITE
#undef SWAIT
#undef QKT_M
#undef MSK
}

constexpr int X_KB = 0, X_VB = 32768, X_WS = 131072, X_LDS = X_WS + NW * 64 * 4;
__device__ __forceinline__ void attnA_prompt_unit2(int h, int qb, const bf16* __restrict__ AQ, const bf16* __restrict__ AK, const bf16* __restrict__ AV, float lam, const float* __restrict__ g_subln, float post,
                                                   bf16* __restrict__ O, ALAS char* lds) {
  int tid = threadIdx.x; asm volatile("" : "+v"(tid));
  const int wid = __builtin_amdgcn_readfirstlane(tid >> 6), lane = tid & 63, r32 = lane & 31, hi = lane >> 5;
  const int c = wid >> 2, wq = wid & 3;
  const int NT = 4 * qb + 4, jmax = 4 * qb + 2 * (wq >> 1) + 1;
  ALAS float* ws = (ALAS float*)(lds + X_WS) + wid * 64; ALAS float* li_l = ws; ALAS float* al_l = ws + 32;
  bf16x8 qr[8];
  { const bf16* Qw = AQ + (size_t)(qb * 128 + wq * 32) * HW + h * 256 + c * 128; const unsigned qo = (unsigned)(r32 * HW + hi * 8) * 2u;
#pragma unroll
    for (int d0 = 0; d0 < 8; ++d0) qr[d0] = *(const bf16x8*)((const char*)Qw + qo + d0 * 32);
#pragma unroll
    for (int d0 = 0; d0 < 8; ++d0) asm volatile("" : "+v"(qr[d0])); }
  const char* Kg = (const char*)(AK + h * 256); const char* Vg = (const char*)(AV + h * 256);
  unsigned koff, voff;
  { const int row = 4 * wid + (lane >> 4), cs = lane & 15; koff = (unsigned)(row * (HW * 2) + ((cs ^ (row & 7)) * 16));
    const int sub = 2 * wid + (lane >> 5), kk = (sub >> 2) * 8 + ((lane & 31) >> 2), k = (kk & ~0xC) | ((kk & 4) << 1) | ((kk & 8) >> 1), c8 = (sub & 3) * 4 + (lane & 3);
    voff = (unsigned)(k * (HW * 2) + c8 * 16); }
  const unsigned lds0 = (unsigned)(uintptr_t)lds;
#define X_DMA(j) do { const size_t to_ = (size_t)(j) * (32 * HW * 2); const unsigned sl_ = (unsigned)__builtin_amdgcn_readfirstlane((int)(lds0 + ((j) & 3) * 32768 + wid * 1024)); \
    glds16(Kg + to_ + koff, sl_); glds16(Kg + to_ + 256 + koff, sl_ + 8192); glds16(Vg + to_ + voff, sl_ + 16384); glds16(Vg + to_ + 256 + voff, sl_ + 24576); } while (0)
  float m_reg = -1e30f, l_reg = 0.f; f32x16 o[8] = {};
  constexpr float C = SCALE * LOG2E;
  bf16x8 pa0, pa1;
#define X_BAR() asm volatile("s_waitcnt lgkmcnt(0)\n\ts_barrier" ::: "memory")
#define X_QK(j) \
    f32x16 p = {}; \
    { const ALAS char* Ks = lds + ((j) & 3) * 32768 + c * 8192; f32x16 p2 = {}; \
      _Pragma("unroll") for (int d0 = 0; d0 < 8; d0 += 2) { const bf16x8 kf = *reinterpret_cast<const ALAS bf16x8*>(Ks + KSWZ(r32, (d0 * 16 + hi * 8) * 2)); const bf16x8 kg = *reinterpret_cast<const ALAS bf16x8*>(Ks + KSWZ(r32, ((d0 + 1) * 16 + hi * 8) * 2)); \
        p = __builtin_amdgcn_mfma_f32_32x32x16_bf16(kf, qr[d0], p, 0, 0, 0); p2 = __builtin_amdgcn_mfma_f32_32x32x16_bf16(kg, qr[d0 + 1], p2, 0, 0, 0); } \
      _Pragma("unroll") for (int r = 0; r < 16; ++r) p[r] += p2[r]; } \
    const float msk = ((j) <= jmax) ? 0.f : -1e30f; \
    float pmax = p[0]; \
    _Pragma("unroll") for (int r = 1; r < 16; ++r) pmax = fmaxf(pmax, p[r]); \
    { auto rr = __builtin_amdgcn_permlane32_swap(__float_as_uint(pmax), __float_as_uint(pmax), false, false); pmax = fmaxf(__uint_as_float(rr[0]), __uint_as_float(rr[1])) + msk; } \
    float mn, alpha; bool resc = false; \
    if (__builtin_expect(__all(pmax - m_reg <= THR / SCALE), 1)) { mn = m_reg; alpha = 1.f; } \
    else { mn = fmaxf(m_reg, pmax); alpha = __builtin_amdgcn_exp2f((m_reg - mn) * C); m_reg = mn; resc = true; } \
    const float mnC = -mn * C + msk; float ps = 0.f;
#define X_EXP2(r0) do { p[r0] = __builtin_amdgcn_exp2f(fmaf(p[r0], C, mnC)); p[(r0) + 1] = __builtin_amdgcn_exp2f(fmaf(p[(r0) + 1], C, mnC)); ps += p[r0]; ps += p[(r0) + 1]; } while (0)
#define X_FIN() do { \
    { auto rr = __builtin_amdgcn_permlane32_swap(__float_as_uint(ps), __float_as_uint(ps), false, false); ps = __uint_as_float(rr[0]) + __uint_as_float(rr[1]); } \
    l_reg = l_reg * alpha + ps; \
    if (resc) { if (hi == 0) al_l[r32] = alpha; asm volatile("s_waitcnt lgkmcnt(0)" ::: "memory"); \
      _Pragma("unroll") for (int d = 0; d < 8; ++d) _Pragma("unroll") for (int r = 0; r < 16; ++r) o[d][r] *= al_l[crow(r, hi)]; } \
    PK4(p, 0, pa0); PK4(p, 8, pa1); } while (0)
#define X_RD4(A, IMG, D0) do { A[0] = tr_read<(IMG) * 8192 + v_rd_off(D0, 0, 0)>(vb); A[1] = tr_read<(IMG) * 8192 + v_rd_off(D0, 0, 1)>(vb); A[2] = tr_read<(IMG) * 8192 + v_rd_off(D0, 1, 0)>(vb); A[3] = tr_read<(IMG) * 8192 + v_rd_off(D0, 1, 1)>(vb); } while (0)
#define X_MM2(D8, A) do { o[D8] = __builtin_amdgcn_mfma_f32_32x32x16_bf16(pa0, (bf16x8){A[0][0], A[0][1], A[0][2], A[0][3], A[1][0], A[1][1], A[1][2], A[1][3]}, o[D8], 0, 0, 0); \
        o[D8] = __builtin_amdgcn_mfma_f32_32x32x16_bf16(pa1, (bf16x8){A[2][0], A[2][1], A[2][2], A[2][3], A[3][0], A[3][1], A[3][2], A[3][3]}, o[D8], 0, 0, 0); } while (0)
#define X_W(n) do { asm volatile("s_waitcnt lgkmcnt(" #n ")" ::: "memory"); SBAR(); } while (0)
  X_DMA(0); X_DMA(1);
  {
    asm volatile("s_waitcnt vmcnt(4)" ::: "memory"); X_BAR(); X_DMA(2);
    X_QK(0)
    X_EXP2(0); X_EXP2(2); X_EXP2(4); X_EXP2(6); X_EXP2(8); X_EXP2(10); X_EXP2(12); X_EXP2(14);
    X_FIN(); }
  for (int j = 1; j < NT; ++j) {
    if (j + 1 < NT) asm volatile("s_waitcnt vmcnt(4)" ::: "memory"); else asm volatile("s_waitcnt vmcnt(0)" ::: "memory");
    X_BAR();
    if (j + 2 < NT) X_DMA(j + 2);
    X_QK(j)
    SBAR();
    { const int vb = (int)(unsigned)(uintptr_t)(lds + ((j - 1) & 3) * 32768 + 16384) + v_rd_base(lane);
      s16x4 va[4], vc[4];
      X_RD4(va, 0, 0); X_RD4(vc, 0, 1); X_W(4); X_MM2(0, va); X_EXP2(0); SBAR();
      X_RD4(va, 0, 2); X_W(4); X_MM2(1, vc); X_EXP2(2); SBAR();
      X_RD4(vc, 0, 3); X_W(4); X_MM2(2, va); X_EXP2(4); SBAR();
      X_RD4(va, 1, 0); X_W(4); X_MM2(3, vc); X_EXP2(6); SBAR();
      X_RD4(vc, 1, 1); X_W(4); X_MM2(4, va); X_EXP2(8); SBAR();
      X_RD4(va, 1, 2); X_W(4); X_MM2(5, vc); X_EXP2(10); SBAR();
      X_RD4(vc, 1, 3); X_W(4); X_MM2(6, va); X_EXP2(12); SBAR();
      X_W(0); X_MM2(7, vc); X_EXP2(14); SBAR(); }
    X_FIN();
  }
  {
    const int vb = (int)(unsigned)(uintptr_t)(lds + ((NT - 1) & 3) * 32768 + 16384) + v_rd_base(lane);
    s16x4 va[4], vc[4];
    X_RD4(va, 0, 0); X_RD4(vc, 0, 1); X_W(4); X_MM2(0, va); SBAR();
    X_RD4(va, 0, 2); X_W(4); X_MM2(1, vc); SBAR();
    X_RD4(vc, 0, 3); X_W(4); X_MM2(2, va); SBAR();
    X_RD4(va, 1, 0); X_W(4); X_MM2(3, vc); SBAR();
    X_RD4(vc, 1, 1); X_W(4); X_MM2(4, va); SBAR();
    X_RD4(va, 1, 2); X_W(4); X_MM2(5, vc); SBAR();
    X_RD4(vc, 1, 3); X_W(4); X_MM2(6, va); SBAR();
    X_W(0); X_MM2(7, vc); SBAR(); }
#undef X_BAR
#undef X_QK
#undef X_EXP2
#undef X_FIN
#undef X_RD4
#undef X_MM2
#undef X_W
  __syncthreads();
  if (hi == 0) li_l[r32] = l_reg; asm volatile("s_waitcnt lgkmcnt(0)" ::: "memory");
  float rli[16];
#pragma unroll
  for (int r = 0; r < 16; ++r) rli[r] = __builtin_amdgcn_rcpf(li_l[crow(r, hi)]);
  ALAS float* XL = (ALAS float*)(lds) + wq * 8192;
  if (c == 1) {
#pragma unroll
    for (int r = 0; r < 16; ++r) { const float f = rli[r] * lam;
#pragma unroll
      for (int d = 0; d < 8; ++d) XL[crow(r, hi) * 256 + d * 32 + r32] = o[d][r] * f; }
  }
  __syncthreads();
  if (c == 0) {
    float gs[8];
#pragma unroll
    for (int d = 0; d < 8; ++d) gs[d] = g_subln[d * 32 + r32] * post;
#pragma unroll
    for (int r = 0; r < 16; ++r) { const int q = crow(r, hi); float ss = 0.f;
#pragma unroll
      for (int d = 0; d < 8; ++d) { const float v = o[d][r] * rli[r] - XL[q * 256 + d * 32 + r32]; o[d][r] = v; ss += v * v; }
#pragma unroll
      for (int m = 1; m < 32; m <<= 1) ss += __shfl_xor(ss, m);
      const float rs = __builtin_amdgcn_rsqf(ss * (1.0f / 256.0f) + EPS);
#pragma unroll
      for (int d = 0; d < 8; ++d) o[d][r] *= rs * gs[d]; }
    asm volatile("s_waitcnt lgkmcnt(0)" ::: "memory");
    ALAS bf16* stg = (ALAS bf16*)XL;
#pragma unroll
    for (int r = 0; r < 16; ++r) { const int q = crow(r, hi);
#pragma unroll
      for (int d = 0; d < 8; ++d) stg[q * 256 + d * 32 + r32] = (bf16)(cvtpk(o[d][r], 0.f) & 0xffffu); }
    asm volatile("s_waitcnt lgkmcnt(0)" ::: "memory");
    bf16* Ow = O + (size_t)(qb * 128 + wq * 32) * DMODEL + h * 256;
#pragma unroll
    for (int i = 0; i < 16; ++i) { const int id = i * 64 + lane, row = id >> 5, ch = id & 31; const u32x4 v = *(const ALAS u32x4*)(stg + row * 256 + ch * 8); *(u32x4*)(Ow + (size_t)row * DMODEL + ch * 8) = v; }
    asm volatile("s_waitcnt lgkmcnt(0)" ::: "memory");
  }
  __syncthreads();
#undef X_DMA
}

constexpr int SA_KB = 0, SA_VB = 65536, SA_WS = 131072, SA_LDS = SA_WS + NW * 64 * 4;
__device__ __forceinline__ void attnA_sample_unit(int b, int h, const float* __restrict__ cak, const float* __restrict__ cav, const float* __restrict__ nak, const float* __restrict__ nav,
                                                  const bf16* __restrict__ AQ, float lam, const float* __restrict__ g_subln, float post, bf16* __restrict__ O, ALAS char* lds) {
  int tid = threadIdx.x; asm volatile("" : "+v"(tid));
  const int wid = __builtin_amdgcn_readfirstlane(tid >> 6), lane = tid & 63, r32 = lane & 31, hi = lane >> 5;
  const int c = wid & 1, vq = wid >> 1;
  ALAS float* ws = (ALAS float*)(lds + SA_WS) + wid * 64; ALAS float* li_l = ws; ALAS float* al_l = ws + 32;
  bf16x8 qr[8];
  { const bf16* Qw = AQ + (size_t)(TP + b * 16 + (r32 & 15)) * HW + h * 256 + c * 128 + hi * 8;
#pragma unroll
    for (int d0 = 0; d0 < 8; ++d0) qr[d0] = ld8bf(Qw + d0 * 16); }
  const int sr = tid >> 3, sk = (tid & 7) * 16, sv = (tid & 7) * 32;
  f32x8 kreg[4], vreg[4];
#define SA_LOAD(j) do { if ((j) < 32) { const size_t ro = ((size_t)(b * 2048 + (j) * 64 + sr) * 8 + h) * 256; \
      kreg[0] = ld8f(cak + ro + sk); kreg[1] = ld8f(cak + ro + sk + 8); kreg[2] = ld8f(cak + ro + 128 + sk); kreg[3] = ld8f(cak + ro + 128 + sk + 8); \
      vreg[0] = ld8f(cav + ro + sv); vreg[1] = ld8f(cav + ro + sv + 8); vreg[2] = ld8f(cav + ro + sv + 16); vreg[3] = ld8f(cav + ro + sv + 24); } \
    else if (sr < 16) { const size_t ro = ((size_t)(b * 16 + sr) * 8 + h) * 256; \
      kreg[0] = ld8f(nak + ro + sk); kreg[1] = ld8f(nak + ro + sk + 8); kreg[2] = ld8f(nak + ro + 128 + sk); kreg[3] = ld8f(nak + ro + 128 + sk + 8); \
      vreg[0] = ld8f(nav + ro + sv); vreg[1] = ld8f(nav + ro + sv + 8); vreg[2] = ld8f(nav + ro + sv + 16); vreg[3] = ld8f(nav + ro + sv + 24); } \
    else { _Pragma("unroll") for (int i_ = 0; i_ < 4; ++i_) { kreg[i_] = f32x8{}; vreg[i_] = f32x8{}; } } } while (0)
#define SA_WRITE(buf) do { ALAS char* kb_ = lds + SA_KB + (buf) * 32768; ALAS char* vb_ = lds + SA_VB + (buf) * 32768 + (sv >> 7) * 16384; const int cv_ = sv & 127; \
    *(ALAS bf16x8*)(kb_ + KSWZ(sr, sk * 2)) = tobf(kreg[0]); *(ALAS bf16x8*)(kb_ + KSWZ(sr, (sk + 8) * 2)) = tobf(kreg[1]); \
    *(ALAS bf16x8*)(kb_ + 16384 + KSWZ(sr, sk * 2)) = tobf(kreg[2]); *(ALAS bf16x8*)(kb_ + 16384 + KSWZ(sr, (sk + 8) * 2)) = tobf(kreg[3]); \
    *(ALAS bf16x8*)(vb_ + v_st(sr, cv_)) = tobf(vreg[0]); *(ALAS bf16x8*)(vb_ + v_st(sr, cv_ + 8)) = tobf(vreg[1]); \
    *(ALAS bf16x8*)(vb_ + v_st(sr, cv_ + 16)) = tobf(vreg[2]); *(ALAS bf16x8*)(vb_ + v_st(sr, cv_ + 24)) = tobf(vreg[3]); } while (0)
  float m_reg = -1e30f, l_reg = 0.f; f32x16 o[2] = {};
  SA_LOAD(0); asm volatile("s_waitcnt vmcnt(0)" ::: "memory"); SA_WRITE(0); __syncthreads();
  for (int j = 0; j <= 32; ++j) {
    const int buf = j & 1;
    if (j < 32) SA_LOAD(j + 1);
    f32x16 p0, p1; float mn, alpha; bf16x8 pa0, pa1, pa2, pa3;
    qkt(p0, p1, lds + SA_KB + buf * 32768 + c * 16384, qr, r32, hi);
    if (j == 32) {
#pragma unroll
      for (int r = 0; r < 16; ++r) { if (crow(r, hi) >= 16) p0[r] = -1e30f; p1[r] = -1e30f; }
    }
    partialSM(p0, p1, m_reg, mn, alpha);
    if (__any(alpha < 1.f)) { if (hi == 0) al_l[r32] = alpha; asm volatile("s_waitcnt lgkmcnt(0)" ::: "memory");
#pragma unroll
      for (int d = 0; d < 2; ++d)
#pragma unroll
        for (int r = 0; r < 16; ++r) o[d][r] *= al_l[crow(r, hi)]; }
    finishSM(p0, p1, alpha, l_reg, pa0, pa1, pa2, pa3); SBAR();
    const int vb = (int)(unsigned)(uintptr_t)(lds + SA_VB + buf * 32768 + (vq >> 1) * 16384) + v_rd_base(lane);
    if (vq & 1) { pv_one<2>(o[0], vb, pa0, pa1, pa2, pa3); pv_one<3>(o[1], vb, pa0, pa1, pa2, pa3); }
    else        { pv_one<0>(o[0], vb, pa0, pa1, pa2, pa3); pv_one<1>(o[1], vb, pa0, pa1, pa2, pa3); }
    if (j < 32) { asm volatile("s_waitcnt vmcnt(0)" ::: "memory"); SA_WRITE(buf ^ 1); }
    __syncthreads();
  }
  if (hi == 0) li_l[r32] = l_reg; asm volatile("s_waitcnt lgkmcnt(0)" ::: "memory");
  ALAS float* OL = (ALAS float*)(lds + SA_KB);
#pragma unroll
  for (int r = 0; r < 8; ++r) { const int q = crow(r, hi); const float rl = __builtin_amdgcn_rcpf(li_l[q]);
#pragma unroll
    for (int dd = 0; dd < 2; ++dd) OL[(c * 16 + q) * 256 + vq * 64 + dd * 32 + r32] = o[dd][r] * rl; }
  __syncthreads();
  { const int q = tid >> 5, e0 = (tid & 31) * 8; float dv[8]; float ss = 0.f;
#pragma unroll
    for (int i = 0; i < 8; ++i) { dv[i] = OL[q * 256 + e0 + i] - lam * OL[(16 + q) * 256 + e0 + i]; ss += dv[i] * dv[i]; }
#pragma unroll
    for (int m = 1; m < 32; m <<= 1) ss += __shfl_xor(ss, m);
    const float rs = __builtin_amdgcn_rsqf(ss * (1.0f / 256.0f) + EPS) * post;
    u32x4 w; w.x = cvtpk(dv[0] * rs * g_subln[e0 + 0], dv[1] * rs * g_subln[e0 + 1]); w.y = cvtpk(dv[2] * rs * g_subln[e0 + 2], dv[3] * rs * g_subln[e0 + 3]);
    w.z = cvtpk(dv[4] * rs * g_subln[e0 + 4], dv[5] * rs * g_subln[e0 + 5]); w.w = cvtpk(dv[6] * rs * g_subln[e0 + 6], dv[7] * rs * g_subln[e0 + 7]);
    *(u32x4*)(O + (size_t)(TP + b * 16 + q) * DMODEL + h * 256 + e0) = w; }
  __syncthreads();
#undef SA_LOAD
#undef SA_WRITE
}

constexpr float SB_STOP = -104.0f;
__device__ __forceinline__ float softplus_f(float z) {
  const float e = __builtin_amdgcn_exp2f(-fabsf(z) * LOG2E);
  return fmaxf(z, 0.f) + LN2 * __builtin_amdgcn_logf(1.0f + e);
}
__device__ __forceinline__ void stick_half(f32x16& p, float& carry, int kbase, int kpos0, int qpos, int nvalid, bool need_mask, int hi) {
  float x[16];
#pragma unroll
  for (int r = 0; r < 16; ++r) {
    const float z = p[r] * SCALE; const float sp = softplus_f(z);
    bool ok = true;
    if (need_mask) { const int kl = kbase + crow(r, hi); ok = (kpos0 + kl < qpos) && (kl < nvalid); }
    x[r] = ok ? -sp : 0.f;
    p[r] = ok ? z - sp : -1e30f;
    if ((r & 3) == 3) SBAR();
  }
  float own[4], par[4], T[4], R[4];
#pragma unroll
  for (int g = 0; g < 4; ++g) { own[g] = (x[4 * g] + x[4 * g + 1]) + (x[4 * g + 2] + x[4 * g + 3]); par[g] = swap32(own[g], hi); T[g] = own[g] + par[g]; }
  R[3] = 0.f; R[2] = T[3]; R[1] = R[2] + T[2]; R[0] = R[1] + T[1];
#pragma unroll
  for (int g = 0; g < 4; ++g) {
    const float E = carry + R[g] + (hi == 0 ? par[g] : 0.f);
    const float w2 = x[4 * g + 3], w1 = w2 + x[4 * g + 2], w0 = w1 + x[4 * g + 1];
    p[4 * g + 3] = __builtin_amdgcn_exp2f((p[4 * g + 3] + E) * LOG2E); p[4 * g + 2] = __builtin_amdgcn_exp2f((p[4 * g + 2] + E + w2) * LOG2E);
    p[4 * g + 1] = __builtin_amdgcn_exp2f((p[4 * g + 1] + E + w1) * LOG2E); p[4 * g + 0] = __builtin_amdgcn_exp2f((p[4 * g + 0] + E + w0) * LOG2E);
    SBAR();
  }
  carry += R[0] + T[0];
}
template <typename TS>
__device__ __forceinline__ void stick_tile(f32x16 (&o)[4], float& carry, const bf16* __restrict__ Qw, const TS* __restrict__ Kt, const TS* __restrict__ Vt, int stride, int nvalid, int kpos0, int qpos,
                                           bool need_mask, ALAS char* vbuf, int lane, int r32, int hi) {
  constexpr bool SRC16 = sizeof(TS) == 2;
  f32x16 p0 = {}, p1 = {};
  { const int k0 = r32 < nvalid ? r32 : nvalid - 1, k1 = (32 + r32) < nvalid ? (32 + r32) : nvalid - 1;
    const TS* K0 = Kt + (size_t)k0 * stride + hi * 8; const TS* K1 = Kt + (size_t)k1 * stride + hi * 8;
    bf16x8 kf0[8], kf1[8], qr[8];
#pragma unroll
    for (int d0 = 0; d0 < 8; ++d0) qr[d0] = ld8bf(Qw + d0 * 16);
#pragma unroll
    for (int d0 = 0; d0 < 8; ++d0) kf0[d0] = ld8any(K0 + d0 * 16);
    if constexpr (SRC16) {
#pragma unroll
      for (int d0 = 0; d0 < 8; ++d0) kf1[d0] = ld8any(K1 + d0 * 16);
    }
#pragma unroll
    for (int d0 = 0; d0 < 8; ++d0) p0 = __builtin_amdgcn_mfma_f32_32x32x16_bf16(kf0[d0], qr[d0], p0, 0, 0, 0);
    if constexpr (!SRC16) {
      asm volatile("" ::: "memory");
#pragma unroll
      for (int d0 = 0; d0 < 8; ++d0) kf1[d0] = ld8any(K1 + d0 * 16);
    }
#pragma unroll
    for (int d0 = 0; d0 < 8; ++d0) p1 = __builtin_amdgcn_mfma_f32_32x32x16_bf16(kf1[d0], qr[d0], p1, 0, 0, 0);
  }
  asm volatile("" ::: "memory"); SBAR();
  const unsigned vsrc_off = (unsigned)(((lane >> 4) * stride + (lane & 15) * 8) * (int)sizeof(TS));
  const int vdst_off = (((lane & 15) * 8) >> 5) * 512 + ((lane >> 4) * 32 + (((lane & 15) * 8) & 31)) * 2;
  const int nvc = nvalid >> 2;
#define VSRC(i) ((const char*)Vt + (size_t)(((i) < nvc ? (i) : nvc - 1) * 4) * stride * sizeof(TS) + vsrc_off)
#define VDST(i) (vbuf + vdst_off + ((((i) & 1) + 2 * ((i) >> 2)) * 2048 + (((i) >> 1) & 1) * 256))
  bf16x8 vtb[16]; f32x8 vtf[4];
  if constexpr (SRC16) {
#pragma unroll
    for (int i = 0; i < 16; ++i) vtb[i] = *(const bf16x8*)VSRC(i);
  } else {
#pragma unroll
    for (int i = 0; i < 4; ++i) vtf[i] = *(const f32x8*)VSRC(i);
  }
  SBAR();
  bf16x8 pa0, pa1, pa2, pa3;
  stick_half(p1, carry, 32, kpos0, qpos, nvalid, need_mask, hi);
  PK4(p1, 0, pa2); PK4(p1, 8, pa3);
  stick_half(p0, carry, 0, kpos0, qpos, nvalid, need_mask, hi);
  PK4(p0, 0, pa0); PK4(p0, 8, pa1);
  if constexpr (SRC16) {
#pragma unroll
    for (int i = 0; i < 16; ++i) *(ALAS bf16x8*)VDST(i) = vtb[i];
  } else {
#pragma unroll
    for (int i = 0; i < 4; ++i) *(ALAS bf16x8*)VDST(i) = tobf(vtf[i]);
#pragma unroll
    for (int bt = 1; bt < 4; ++bt) {
#pragma unroll
      for (int i = 0; i < 4; ++i) vtf[i] = *(const f32x8*)VSRC(4 * bt + i);
#pragma unroll
      for (int i = 0; i < 4; ++i) *(ALAS bf16x8*)VDST(4 * bt + i) = tobf(vtf[i]);
    }
  }
#undef VSRC
#undef VDST
  asm volatile("s_waitcnt lgkmcnt(0)" ::: "memory"); SBAR();
  const int vb = (int)(unsigned)(uintptr_t)vbuf + v_rd_base(lane);
  pv_d0(o, vb, pa0, pa1, pa2, pa3);
}
__device__ __forceinline__ void stick_store(const f32x16 (&o)[4], const float* __restrict__ g_sb, bf16* __restrict__ Orow0, int nrows, ALAS char* vbuf, int lane, int r32, int hi) {
  float gs[4];
#pragma unroll
  for (int d0 = 0; d0 < 4; ++d0) gs[d0] = g_sb[d0 * 32 + r32];
  ALAS bf16* stg = (ALAS bf16*)vbuf;
#pragma unroll
  for (int r = 0; r < 16; ++r) {
    float ss = (o[0][r] * o[0][r] + o[1][r] * o[1][r]) + (o[2][r] * o[2][r] + o[3][r] * o[3][r]);
#pragma unroll
    for (int m = 1; m < 32; m <<= 1) ss += __shfl_xor(ss, m);
    const float rs = __builtin_amdgcn_rsqf(ss * (1.0f / 128.0f) + EPS);
    const int q = crow(r, hi);
#pragma unroll
    for (int d0 = 0; d0 < 4; ++d0) stg[q * 128 + d0 * 32 + r32] = (bf16)(cvtpk(o[d0][r] * rs * gs[d0], 0.f) & 0xffffu);
  }
  asm volatile("s_waitcnt lgkmcnt(0)" ::: "memory");
#pragma unroll
  for (int i = 0; i < 8; ++i) { const int id = i * 64 + lane, row = id >> 4, ch = id & 15;
    if (row < nrows) { const u32x4 v = *(const ALAS u32x4*)(stg + row * 128 + ch * 8); *(u32x4*)(Orow0 + (size_t)row * DMODEL + ch * 8) = v; } }
  asm volatile("s_waitcnt lgkmcnt(0)" ::: "memory");
}
__device__ __forceinline__ void stick_prompt_unit(int h, int qt, const bf16* __restrict__ BQ, const bf16* __restrict__ BK, const bf16* __restrict__ BV, const float* __restrict__ g_sb, bf16* __restrict__ O, ALAS char* vbuf) {
  int lane = threadIdx.x & 63; asm volatile("" : "+v"(lane)); const int r32 = lane & 31, hi = lane >> 5; const int t0 = 32 * qt;
  const bf16* Qw = BQ + (size_t)(t0 + r32) * HW + h * 128 + hi * 8;
  f32x16 o[4] = {}; float carry = 0.f; const int qpos = t0 + r32; const int jd = t0 >> 6;
  for (int j = jd; j >= 0; --j) {
    stick_tile<bf16>(o, carry, Qw, BK + (size_t)(64 * j) * HW + h * 128, BV + (size_t)(64 * j) * HW + h * 128, HW, 64, 64 * j, qpos, j == jd, vbuf, lane, r32, hi);
    if (__all(carry < SB_STOP)) break;
  }
  stick_store(o, g_sb, O + (size_t)t0 * DMODEL + 2048 + h * 128, 32, vbuf, lane, r32, hi);
}
__device__ __forceinline__ void stick_sample_unit(int b, int h, const bf16* __restrict__ BQ, const bf16* __restrict__ BK, const bf16* __restrict__ BV, const float* __restrict__ cbk, const float* __restrict__ cbv,
                                                  const float* __restrict__ g_sb, bf16* __restrict__ O, ALAS char* vbuf) {
  int lane = threadIdx.x & 63; asm volatile("" : "+v"(lane)); const int r32 = lane & 31, hi = lane >> 5; const size_t row0 = (size_t)TP + b * 16;
  const bf16* Qw = BQ + (row0 + (r32 & 15)) * HW + h * 128 + hi * 8;
  f32x16 o[4] = {}; float carry = 0.f; const int qpos = 2048 + (r32 & 15);
  stick_tile<bf16>(o, carry, Qw, BK + row0 * HW + h * 128, BV + row0 * HW + h * 128, HW, 16, 2048, qpos, true, vbuf, lane, r32, hi);
  for (int j = 31; j >= 0; --j) {
    if (__all(carry < SB_STOP)) break;
    const size_t ro = ((size_t)(b * 2048 + 64 * j) * 16 + h) * 128;
    stick_tile<float>(o, carry, Qw, cbk + ro, cbv + ro, 2048, 64, 64 * j, qpos, false, vbuf, lane, r32, hi);
  }
  stick_store(o, g_sb, O + row0 * DMODEL + 2048 + h * 128, 16, vbuf, lane, r32, hi);
}
#undef PK4
#undef SBAR
#undef RESC
}
namespace sk {
#define SLAS __attribute__((address_space(3)))
typedef unsigned short bf16;
using bf16x8 = __attribute__((ext_vector_type(8))) short;
using f32x16 = __attribute__((ext_vector_type(16))) float;
constexpr int SLOT = 40960, A_BYTES = 32768;
__device__ __forceinline__ int crow(int r, int hi) { return (r & 3) + 8 * (r >> 2) + 4 * hi; }
__device__ __forceinline__ void glds16(const void* gsrc, unsigned lds_dst) { unsigned keep;
  asm volatile("s_mov_b32 %0, m0\n\ts_mov_b32 m0, %2\n\ts_nop 0\n\tglobal_load_lds_dwordx4 %1, off\n\ts_mov_b32 m0, %0" : "=&s"(keep) : "v"(gsrc), "s"(lds_dst) : "memory"); }
struct Item { int t; int kt0; int nkt; int ks; };
template <class Epi>
__device__ __forceinline__ void skinny_item(const Item it, const bf16* __restrict__ A, int lda, const bf16* __restrict__ Wt, int KT  , const Epi& E, SLAS char* lds) {
  int tid = threadIdx.x; asm volatile("" : "+v"(tid));
  const int wid = __builtin_amdgcn_readfirstlane(tid >> 6), lane = tid & 63, r32 = lane & 31, hi = lane >> 5;
  const int arow0 = 32 * wid + (lane >> 3), cs = lane & 7;
  unsigned aoff[4];
#pragma unroll
  for (int q = 0; q < 4; ++q) { const int row = arow0 + 8 * q; aoff[q] = (unsigned)row * (unsigned)(lda * 2) + (unsigned)((cs ^ ((row >> 1) & 7)) * 16); }
  const int brow = 8 * wid + (lane >> 3); const unsigned boff = (unsigned)(brow * 128 + ((cs ^ ((brow >> 1) & 7)) * 16));
  const char* Ag = (const char*)A + (size_t)it.kt0 * 128;
  const char* Wg = (const char*)Wt + ((size_t)(it.t >> 2) * KT + it.kt0) * 32768 + (size_t)(it.t & 3) * 8192;
  const unsigned lds0 = (unsigned)(uintptr_t)lds;
#define SK_DMA(kt, slot) do { const unsigned sl_ = (unsigned)__builtin_amdgcn_readfirstlane((int)(lds0 + (slot) * SLOT)); const char* ag_ = Ag + (size_t)(kt) * 128; \
    glds16(ag_ + aoff[0], sl_ + (unsigned)(wid * 4096)); glds16(ag_ + aoff[1], sl_ + (unsigned)(wid * 4096 + 1024)); glds16(ag_ + aoff[2], sl_ + (unsigned)(wid * 4096 + 2048)); glds16(ag_ + aoff[3], sl_ + (unsigned)(wid * 4096 + 3072)); \
    glds16(Wg + (size_t)(kt) * 32768 + boff, sl_ + (unsigned)(A_BYTES + wid * 1024)); } while (0)
  const int ar = 32 * wid + r32, asw = (ar >> 1) & 7, b0sw = (r32 >> 1) & 7, b1sw = ((32 + r32) >> 1) & 7;
  f32x16 acc[2] = {};
  const int nkt = it.nkt;
  SK_DMA(0, 0); if (nkt > 1) SK_DMA(1, 1);
  int slot = 0, slot2 = 2;
  for (int kt = 0; kt < nkt; ++kt) {
    if (kt + 1 < nkt) asm volatile("s_waitcnt vmcnt(5)" ::: "memory"); else asm volatile("s_waitcnt vmcnt(0)" ::: "memory");
    asm volatile("s_waitcnt lgkmcnt(0)\n\ts_barrier" ::: "memory");
    if (kt + 2 < nkt) SK_DMA(kt + 2, slot2);
    const SLAS char* sa = lds + slot * SLOT + ar * 128; const SLAS char* sb = lds + slot * SLOT + A_BYTES;
#pragma unroll
    for (int s = 0; s < 4; ++s) { const int c = 2 * s + hi;
      const bf16x8 a = *reinterpret_cast<const SLAS bf16x8*>(sa + ((c ^ asw) * 16));
      const bf16x8 w0 = *reinterpret_cast<const SLAS bf16x8*>(sb + r32 * 128 + ((c ^ b0sw) * 16));
      const bf16x8 w1 = *reinterpret_cast<const SLAS bf16x8*>(sb + (32 + r32) * 128 + ((c ^ b1sw) * 16));
      acc[0] = __builtin_amdgcn_mfma_f32_32x32x16_bf16(a, w0, acc[0], 0, 0, 0);
      acc[1] = __builtin_amdgcn_mfma_f32_32x32x16_bf16(a, w1, acc[1], 0, 0, 0); }
    slot = (slot == 2) ? 0 : slot + 1; slot2 = (slot2 == 2) ? 0 : slot2 + 1;
  }
#undef SK_DMA
  E(acc, it, wid, r32, hi);
  asm volatile("s_waitcnt lgkmcnt(0)" ::: "memory"); __syncthreads();
}
#undef SLAS
}
constexpr int NWAVES = 8;
#ifndef MK_N_LAUNCHES
#define MK_N_LAUNCHES 1
#endif
constexpr int N_PHASES = 8;
constexpr int N_LAUNCHES = MK_N_LAUNCHES;
static_assert(N_LAUNCHES == 1 || N_LAUNCHES == N_PHASES, "MK_N_LAUNCHES is 1 or 8");

constexpr int DM = 4096, TP = 8192, TS = 256, MROWS = TP + TS, HW = 2048, NIN = 6 * HW, DFF = 16384;
constexpr int DEC_B = 16, DEC_T = 16, PAST = 2048, A_HEADS = 8, B_HEADS = 16;
constexpr float EPS = 1e-6f, LAM_INIT = 0.2f;
constexpr size_t OUT_Y = 0;
constexpr size_t OUT_KVP = (size_t)MROWS * DM;
constexpr size_t OUT_KVS = OUT_KVP + 4 * (size_t)TP * HW;
constexpr size_t OUT_TOTAL = OUT_KVS + 4 * (size_t)TS * HW;
static_assert(OUT_TOTAL == 103809024ull, "output size");
constexpr size_t MiB = 1u << 20;
constexpr size_t WS_CTL = 0, CTL_ZERO_BYTES = 1 * MiB;
constexpr size_t WS_ROPE = 2 * MiB;
constexpr size_t WS_WIN = 4 * MiB;
constexpr size_t WS_WOUT = WS_WIN + 96 * MiB;
constexpr size_t WS_WUP = WS_WOUT + 32 * MiB;
constexpr size_t WS_WDOWN = WS_WUP + 128 * MiB;
constexpr size_t WS_H0 = WS_WDOWN + 128 * MiB;
constexpr size_t WS_QKV = WS_H0 + 66 * MiB;
constexpr size_t WS_OA = WS_QKV + 198 * MiB;
constexpr size_t WS_O = WS_OA + 128 * MiB;
constexpr size_t WS_X1 = WS_O + 66 * MiB;
constexpr size_t WS_X1S = WS_X1 + 66 * MiB, WS_X2B = WS_OA;
constexpr size_t WS_H1 = WS_X1 + 132 * MiB;
constexpr size_t WS_U = WS_H1 + 66 * MiB;
constexpr size_t WS_PART1 = WS_U + 264 * MiB;
constexpr size_t WS_PART2 = WS_PART1 + 48 * MiB;
constexpr size_t WS_PART3 = WS_PART2 + 32 * MiB;
constexpr size_t WS_PART4 = WS_PART3 + 64 * MiB;
constexpr size_t WS_END = WS_PART4 + 64 * MiB;
#ifndef WGMS
#define WGMS 4, 4, 4, 4
#endif
constexpr int WGM_TAB[4] = {WGMS}; constexpr int WGM_P1 = WGM_TAB[0], WGM_P4 = WGM_TAB[1], WGM_P5 = WGM_TAB[2], WGM_P6 = WGM_TAB[3];
constexpr int SPL2 = 4, SPL4 = 4;
static_assert((size_t)MROWS * DM * 2 <= 66 * MiB && (size_t)MROWS * HW * 2 * 6 <= 198 * MiB && (size_t)MROWS * DM * 4 <= 132 * MiB && (size_t)MROWS * DFF * 2 <= 264 * MiB, "ws map");
constexpr int CW_TMO = 0, CW_CODE = 1;
constexpr int CW_BAR = 4096;
constexpr int CW_BQ = 8192, CW_AQ = 8704;
constexpr int CW_SSQ1 = 16384, CW_SSQ2 = 32768;
static_assert((CW_SSQ2 + MROWS) * 4 <= (int)CTL_ZERO_BYTES, "CTL words inside the memset region");
constexpr int RING_OFF = 0, RING_BYTES = 135168;
constexpr int LDSCTL_OFF = RING_BYTES, MISC_OFF = LDSCTL_OFF + 320;
constexpr int LDS_BYTES = 147456;
static_assert(MISC_OFF + 128 <= LDS_BYTES && 8 * 64 * 65 * 4 <= RING_BYTES && att::SA_LDS <= RING_BYTES && att::X_LDS <= RING_BYTES, "LDS map");

#define GAS __attribute__((address_space(1)))
#define LAS __attribute__((address_space(3)))
typedef unsigned short bf16;
typedef unsigned v4u __attribute__((ext_vector_type(4)));
typedef float f32x4 __attribute__((ext_vector_type(4)));
typedef short bf16x8 __attribute__((ext_vector_type(8)));
typedef GAS unsigned gu32;
typedef GAS unsigned long long gu64;
#define RLX_AGENT __ATOMIC_RELAXED, __HIP_MEMORY_SCOPE_AGENT
#define LDS_WAIT() asm volatile("s_waitcnt lgkmcnt(0)" ::: "memory")
#define VM_WAIT() asm volatile("s_waitcnt vmcnt(0)" ::: "memory")
__device__ __forceinline__ unsigned long long rt() { return __builtin_amdgcn_s_memrealtime(); }
__device__ __forceinline__ unsigned f2bf(float f) { unsigned u = __builtin_bit_cast(unsigned, f); return (u + 0x7fffu + ((u >> 16) & 1u)) >> 16; }
__device__ __forceinline__ unsigned pk2(float lo, float hi) { return f2bf(lo) | (f2bf(hi) << 16); }

#define XB_TMO      128
#define XB_XCNT(j)  (256  + 64 * (j))
#define XB_XSUB(j)  (1280 + 64 * (j))
#define XB_XGEN(j)  (2304 + 64 * (j))
#define XB_TOP      3328
#define XB_TOPGEN   3392
#define XCD_BAR_WORDS 3456
#define XB_SPIN_CAP (1u << 18)

__device__ __forceinline__ unsigned xb_ld(unsigned* p)              { return __hip_atomic_load(p, __ATOMIC_RELAXED, __HIP_MEMORY_SCOPE_AGENT); }
__device__ __forceinline__ unsigned xb_add(unsigned* p, unsigned v) { return __hip_atomic_fetch_add(p, v, __ATOMIC_RELAXED, __HIP_MEMORY_SCOPE_AGENT); }
__device__ __forceinline__ unsigned xb_xcc_id() { return (unsigned)__builtin_amdgcn_s_getreg((3 << 11) | 20) & 0xFu; }
#define XB_SPIN(cond, bar) do { unsigned _sp = 0; while (cond) { __builtin_amdgcn_s_sleep(1); \
    if ((++_sp & 255u) == 0u) { if (xb_ld(&(bar)[XB_TMO])) break; if (_sp > XB_SPIN_CAP) { atomicAdd(&(bar)[XB_TMO], 1u); break; } } } } while (0)

struct XcdBarrier {
    unsigned* bar; unsigned x;
    volatile LAS unsigned* st;
};

__device__ __forceinline__ XcdBarrier xcd_barrier_post(unsigned* bar, volatile LAS unsigned* st) {
    XcdBarrier b; b.bar = bar; b.x = xb_xcc_id(); b.st = st;
    if (threadIdx.x == 0) (void)xb_add(&bar[XB_XCNT(b.x)], 1u);
    return b;
}
__device__ __forceinline__ void xcd_barrier_complete(unsigned* bar, unsigned x, unsigned& nloc, unsigned& nx) {
    const unsigned G = gridDim.x * gridDim.y * gridDim.z;
    unsigned sum, cnt, mine, sp = 0u;
    for (;;) {
        sum = 0u; cnt = 0u; mine = 0u;
#pragma unroll
        for (unsigned j = 0; j < 16; ++j) { const unsigned c = xb_ld(&bar[XB_XCNT(j)]); sum += c; cnt += (c > 0u) ? 1u : 0u; mine = (j == x) ? c : mine; }
        if (sum == G) break;
        __builtin_amdgcn_s_sleep(1);
        if ((++sp & 255u) == 0u) { if (xb_ld(&bar[XB_TMO])) break; if (sp > XB_SPIN_CAP) { atomicAdd(&bar[XB_TMO], 1u); break; } }
    }
    nloc = mine > 0u ? mine : 1u; nx = cnt > 0u ? cnt : 1u;
}

__device__ __forceinline__ void xcd_barrier(const XcdBarrier& b) {
    asm volatile("s_waitcnt vmcnt(0)" ::: "memory");
    __syncthreads();
    if (threadIdx.x == 0) {
        unsigned* bar = b.bar;
        __builtin_amdgcn_s_waitcnt(0);
        unsigned nloc = b.st[0], nx = b.st[1];
        if (nloc == 0u) { xcd_barrier_complete(bar, b.x, nloc, nx); b.st[0] = nloc; b.st[1] = nx; }
        const unsigned old = xb_add(&bar[XB_XSUB(b.x)], 1u);
        const unsigned gen = old / nloc;
        if (old + 1u == (gen + 1u) * nloc) {
            __builtin_amdgcn_fence(__ATOMIC_RELEASE, "agent");
            asm volatile("s_waitcnt vmcnt(0)" ::: "memory");
            const unsigned og = xb_add(&bar[XB_TOP], 1u);
            const unsigned tg = og / nx;
            if (og + 1u == (tg + 1u) * nx) xb_add(&bar[XB_TOPGEN], 1u);
            else XB_SPIN(xb_ld(&bar[XB_TOPGEN]) == tg, bar);
            __builtin_amdgcn_fence(__ATOMIC_ACQUIRE, "agent");
            xb_add(&bar[XB_XGEN(b.x)], 1u);
            asm volatile("s_waitcnt vmcnt(0)" ::: "memory");
        } else {
            XB_SPIN(xb_ld(&bar[XB_XGEN(b.x)]) == gen, bar);
            __builtin_amdgcn_fence(__ATOMIC_ACQUIRE, "agent");
            asm volatile("s_waitcnt vmcnt(0)" ::: "memory");
        }
    }
    __syncthreads();
}


__device__ __forceinline__ int lane_now() { int t = threadIdx.x; asm volatile("" : "+v"(t)); return t & 63; }
struct Frame {
    LAS unsigned char* lds;
    volatile LAS unsigned* MISC;
    gu32* ctl;
    int tid, lane, wave;
    int vcu, G;
};
__device__ __forceinline__ float wave_sum(float v) {
#pragma unroll
    for (int o = 1; o < 64; o <<= 1) v += __shfl_xor(v, o);
    return v;
}
__constant__ double ROPE_INV[16] = {
    1.0, 0.44036660267178046, 0.19392274474868576, 0.08539710028576561, 0.03760603093086393, 0.016560440080994446, 0.007292664737217109, 0.003211445994752591,
    0.001414213562373095, 0.000622772421914596, 0.0002742481756762073, 0.00012076973741146504, 5.318295896944988e-05, 2.341999896140934e-05, 1.031338537721246e-05, 4.5416704806078695e-06 };

__device__ __forceinline__ void p0_transpose_item(const float* W, int K, int N, bf16* WT, LAS float* scr, int item, int lane) {
    const int nblk = N / 32, kb = item / nblk, nb = item % nblk, k0 = 64 * kb, n0 = 32 * nb;
#pragma unroll 8
    for (int i = 0; i < 32; ++i) { const int kk = 2 * i + (lane >> 5); scr[kk * 33 + (lane & 31)] = W[(size_t)(k0 + kk) * N + n0 + (lane & 31)]; }
    LDS_WAIT(); asm volatile("" ::: "memory");
    const int c = lane & 7;
#pragma unroll
    for (int j = 0; j < 4; ++j) { const int n = (lane >> 3) + 8 * j; const LAS float* s = scr + (8 * c) * 33 + n;
        v4u o; o.x = pk2(s[0 * 33], s[1 * 33]); o.y = pk2(s[2 * 33], s[3 * 33]); o.z = pk2(s[4 * 33], s[5 * 33]); o.w = pk2(s[6 * 33], s[7 * 33]);
        *(GAS v4u*)(WT + (size_t)(n0 + n) * K + k0 + 8 * c) = o; }
    LDS_WAIT(); asm volatile("" ::: "memory");
}
constexpr int CONV_SCR = 64 * 65 * 4;
__device__ __forceinline__ void conv_item64(const float* W, int K, int N, bf16* WT, LAS float* scr, int item, int lane) {
    const int nblk = N >> 6, kb = item / nblk, nb = item - kb * nblk, k0 = kb << 6, n0 = nb << 6;
    const float* src = W + (size_t)(k0 + (lane >> 4)) * N + n0 + 4 * (lane & 15);
    f32x4 v[16];
#pragma unroll
    for (int i = 0; i < 16; ++i) v[i] = *(const f32x4*)(src + (size_t)(4 * i) * N);
    LAS float* d = scr + (lane >> 4) * 65 + 4 * (lane & 15);
#pragma unroll
    for (int i = 0; i < 16; ++i) { LAS float* p = d + i * (4 * 65); p[0] = v[i].x; p[1] = v[i].y; p[2] = v[i].z; p[3] = v[i].w; }
    LDS_WAIT(); asm volatile("" ::: "memory");
    const int c = lane & 7;
#pragma unroll
    for (int j = 0; j < 8; ++j) { const int n = (lane >> 3) + 8 * j; const LAS float* s = scr + (8 * c) * 65 + n;
        v4u o; o.x = pk2(s[0 * 65], s[1 * 65]); o.y = pk2(s[2 * 65], s[3 * 65]); o.z = pk2(s[4 * 65], s[5 * 65]); o.w = pk2(s[6 * 65], s[7 * 65]);
        const int ng = n0 + n;
        *(GAS v4u*)(WT + ((size_t)(ng >> 8) * (K >> 6) + kb) * 16384 + (size_t)(ng & 255) * 64 + 8 * c) = o; }
    LDS_WAIT(); asm volatile("" ::: "memory");
}
__device__ __forceinline__ void rms_row_to_bf16(const float* xrow, const float* g, bf16* orow, int lane) {
    const GAS f32x4* xr = (const GAS f32x4*)xrow + lane; const GAS f32x4* gr = (const GAS f32x4*)g + lane;
    f32x4 v[16]; float s = 0.f;
#pragma unroll
    for (int j = 0; j < 16; ++j) { v[j] = xr[64 * j]; s += (v[j].x * v[j].x + v[j].y * v[j].y) + (v[j].z * v[j].z + v[j].w * v[j].w); }
    const float rstd = 1.0f / sqrtf(wave_sum(s) * (1.f / DM) + EPS);
    GAS unsigned long long* o8 = (GAS unsigned long long*)orow + lane;
#pragma unroll
    for (int j = 0; j < 16; ++j) { const f32x4 gg = gr[64 * j];
        o8[64 * j] = (unsigned long long)pk2(v[j].x * rstd * gg.x, v[j].y * rstd * gg.y) | ((unsigned long long)pk2(v[j].z * rstd * gg.z, v[j].w * rstd * gg.w) << 32); }
}
__device__ __forceinline__ float lambda_of(const float* q1, const float* k1, const float* q2, const float* k2, int lane) {
    const float a = wave_sum(q1[lane] * k1[lane] + q1[64 + lane] * k1[64 + lane]);
    const float b = wave_sum(q2[lane] * k2[lane] + q2[64 + lane] * k2[64 + lane]);
    return expf(a) - expf(b) + LAM_INIT;
}

typedef const __attribute__((address_space(4))) char* kaptr;
__device__ __forceinline__ kaptr karg_base() { kaptr ka = (kaptr)__builtin_amdgcn_kernarg_segment_ptr(); asm volatile("" : "+s"(ka)); return ka; }
__device__ __forceinline__ const float* karg_in(int i) { return *(const float* const __attribute__((address_space(4)))*)(karg_base() + 8 * i); }
__device__ __forceinline__ float* karg_out() { return *(float* const __attribute__((address_space(4)))*)(karg_base() + 152); }
__device__ __forceinline__ unsigned char* karg_ws() { return *(unsigned char* const __attribute__((address_space(4)))*)(karg_base() + 160); }
struct SkInProj {
    bf16* qkv; float* out_kvs; const float* rope;
    __device__ __forceinline__ void operator()(const sk::f32x16 (&acc)[2], const sk::Item& it, int wid, int r32, int hi) const {
        const int col0 = it.t * 64, tt = col0 >> 11, ct0 = col0 & 2047;
        const bool rot = (tt < 2) && ((col0 & 127) == 0);
        const int d = r32 & 15; const float sgn = (r32 < 16) ? -1.f : 1.f;
        const int idx = (tt == 1) ? 0 : (tt == 2) ? 1 : (tt == 4) ? 2 : 3; const bool f32out = (tt == 1 || tt == 2 || tt == 4 || tt == 5);
        bf16* qb = qkv + (size_t)tt * ((size_t)MROWS * HW) + (size_t)TP * HW; float* fo = out_kvs + (size_t)idx * (TS * HW);
#pragma unroll
        for (int r = 0; r < 16; ++r) { const int row = 32 * wid + sk::crow(r, hi);
            float v0 = acc[0][r]; const float v1 = acc[1][r];
            const float other = __shfl_xor(v0, 16);
            if (rot) { const float cc = rope[(size_t)(TP + row) * 32 + d], ss = rope[(size_t)(TP + row) * 32 + 16 + d]; v0 = v0 * cc + sgn * other * ss; }
            qb[(size_t)row * HW + ct0 + r32] = (bf16)f2bf(v0); qb[(size_t)row * HW + ct0 + 32 + r32] = (bf16)f2bf(v1);
            if (f32out) { fo[(size_t)row * HW + ct0 + r32] = v0; fo[(size_t)row * HW + ct0 + 32 + r32] = v1; } }
    }
};
struct SkPartial {
    float* part; int N;
    __device__ __forceinline__ void operator()(const sk::f32x16 (&acc)[2], const sk::Item& it, int wid, int r32, int hi) const {
#pragma unroll
        for (int r = 0; r < 16; ++r) { float* p = part + ((size_t)it.ks * TS + 32 * wid + sk::crow(r, hi)) * N + it.t * 64 + r32; p[0] = acc[0][r]; p[32] = acc[1][r]; }
    }
};
struct SkUp {
    const float* ssq; bf16* U;
    __device__ __forceinline__ void operator()(const sk::f32x16 (&acc)[2], const sk::Item& it, int wid, int r32, int hi) const {
#pragma unroll
        for (int r = 0; r < 16; ++r) { const int row = 32 * wid + sk::crow(r, hi); const float rs = 1.0f / sqrtf(ssq[TP + row] * (1.f / DM) + EPS);
            const float a = fmaxf(acc[0][r] * rs, 0.f), b = fmaxf(acc[1][r] * rs, 0.f);
            bf16* p = U + (size_t)(TP + row) * DFF + it.t * 64 + r32; p[0] = (bf16)f2bf(a * a); p[32] = (bf16)f2bf(b * b); }
    }
};
__device__ __forceinline__ void sample_slot(int G, int bx, int nrounds, int nitems, bool splitk, int& rstar, int& item0, int& istep) {
    if (G == 256) { const int x = bx & 7, w = bx >> 3; istep = nitems;
        if (!splitk) { const int idx = 32 * x + w; if (idx < nitems) { item0 = idx; rstar = x < nrounds ? x : nrounds - 1; } else { item0 = nitems; rstar = 1 << 19; } }
        else { rstar = (x >> 2) < nrounds ? (x >> 2) : nrounds - 1; item0 = 4 * ((x < 4) ? w : 32 + w) + (x & 3); if (item0 >= nitems) { item0 = nitems; rstar = 1 << 19; } } }
    else { rstar = 1 << 19; item0 = bx; istep = G; }
}
struct Args { const float* in[19]; float* out; unsigned char* ws; int ph_lo, ph_hi, li, pad; };
static_assert(offsetof(Args, out) == 152 && offsetof(Args, ws) == 160 && sizeof(Args) == 184, "kernarg layout used by karg_*");
__global__ void __launch_bounds__(NWAVES * 64, 2) hybrid_fwd(Args args) {
    extern __shared__ __attribute__((aligned(16))) unsigned char lds[];
    Frame F;
    F.lds = (LAS unsigned char*)lds;
    F.MISC = (volatile LAS unsigned*)(F.lds + MISC_OFF);
    F.tid = threadIdx.x; F.lane = 0; F.wave = __builtin_amdgcn_readfirstlane(F.tid >> 6);
    F.G = gridDim.x; { const int bx = blockIdx.x; F.vcu = (F.G % 8 == 0) ? (bx % 8) * (F.G / 8) + bx / 8 : bx; }
    F.ctl = (gu32*)(karg_ws() + WS_CTL);
    constexpr size_t QS = (size_t)MROWS * HW;
#define KIN(i) karg_in(i)
#define KWS(T, off) ((T*)(karg_ws() + (off)))
#define KSSQ(w) ((float*)(karg_ws() + WS_CTL) + (w))
    for (int u = F.tid; u < (LDS_BYTES - LDSCTL_OFF) / 4; u += NWAVES * 64) ((LAS unsigned*)(F.lds + LDSCTL_OFF))[u] = 0u;
    __syncthreads();
    XcdBarrier bar; bar.bar = (unsigned*)(F.ctl + CW_BAR); bar.x = 0; bar.st = nullptr;
    if (N_LAUNCHES == 1) bar = xcd_barrier_post((unsigned*)(F.ctl + CW_BAR), F.MISC + 8);
#define GRID_BAR() do { if (N_LAUNCHES == 1) xcd_barrier(bar); } while (0)
    const int lo = args.ph_lo, hi = args.ph_hi;
#ifndef PH_MASK
#define PH_MASK 0xff
#endif
#define IN(k) (((PH_MASK >> (k)) & 1) && lo <= (k) && (k) < hi)
#define BOTH(k) (IN(k) && IN((k) + 1))
    const int gw = F.vcu * NWAVES + F.wave, NGW = F.G * NWAVES;

    if (IN(0)) {
        LAS float* scr = (LAS float*)(F.lds + RING_OFF + F.wave * CONV_SCR);
        const float* x_prompt = KIN(0); const float* x_sample = KIN(1); const float* g_attn = KIN(6); const float* w_in = KIN(7);
        bf16* Win_t = KWS(bf16, WS_WIN); bf16* H0 = KWS(bf16, WS_H0); float* ROPE = KWS(float, WS_ROPE);
        for (int it = gw; it < (DM / 64) * (NIN / 64); it += NGW) conv_item64(w_in, DM, NIN, Win_t, scr, it, lane_now());
        for (int m = gw; m < MROWS; m += NGW) rms_row_to_bf16(m < TP ? x_prompt + (size_t)m * DM : x_sample + (size_t)(m - TP) * DM, g_attn, H0 + (size_t)m * DM, lane_now());
        for (int e = blockIdx.x * (NWAVES * 64) + F.tid; e < MROWS * 16; e += F.G * NWAVES * 64) {
            const int row = e >> 4, d = e & 15; const int pos = row < TP ? row : PAST + ((row - TP) & 15);
            const double rev = (double)pos * ROPE_INV[d] * 0.15915494309189535; const float fr = (float)(rev - floor(rev));
            ROPE[(size_t)row * 32 + d] = __builtin_amdgcn_cosf(fr); ROPE[(size_t)row * 32 + 16 + d] = __builtin_amdgcn_sinf(fr);
        }
        if (BOTH(0)) GRID_BAR();
    }
    if (IN(1)) {
        float* out = karg_out();
        { pg8::Gemm g{KWS(bf16, WS_H0), KWS(bf16, WS_WIN), TP, NIN, DM, DM}; pg8::StaticOrder S; S.init(TP, NIN, F.G, (int)blockIdx.x, WGM_P1);
          pg8::EpiInProj E{KWS(bf16, WS_QKV), out + OUT_KVP, out + OUT_KVS, KWS(float, WS_ROPE)};
          const SkInProj EK{KWS(bf16, WS_QKV), out + OUT_KVS, KWS(float, WS_ROPE)};
          int rstar, item0, istep; sample_slot(F.G, (int)blockIdx.x, TP / 256 * (NIN / 256) / 256, NIN / 64, false, rstar, item0, istep);
          _Pragma("unroll 1") for (int part = 0; part < 2; ++part) { S.i0 = part ? rstar + 1 : 0; S.i1 = part ? (1 << 20) : rstar + 1;
            if (!(args.pad & 32)) pg8::gemm_phase<pg8::EpiInProj, pg8::StaticOrder, true, true>(F.lds + RING_OFF, g, S, E);
            if (part == 0 && !(args.pad & 16)) for (int i = item0; i < NIN / 64; i += istep) sk::skinny_item(sk::Item{i, 0, DM / 64, 0}, KWS(bf16, WS_H0) + (size_t)TP * DM, DM, KWS(bf16, WS_WIN), DM / 64, EK, (LAS char*)(F.lds + RING_OFF)); } }
        if (BOTH(1)) GRID_BAR();
    }
    if (IN(2)) {
        LAS char* al = (LAS char*)(F.lds + RING_OFF);
        const bf16* QKV = KWS(bf16, WS_QKV); bf16* OB = KWS(bf16, WS_O);
        const bf16* AQ = QKV; const bf16* AK = QKV + QS; const bf16* AV = QKV + 2 * QS; const bf16* BQ = QKV + 3 * QS; const bf16* BK = QKV + 4 * QS; const bf16* BV = QKV + 5 * QS;
#ifndef P2_MASK
#define P2_MASK 7
#endif
        const int sub = args.pad ? args.pad : 15;
        if ((P2_MASK & 3) && (sub & 11)) {
            constexpr int NQE = 64 + DEC_B + 32;
            constexpr int CI_OUT = (DM / 64) * (DM / 64), CI_UP = (DM / 64) * (DFF / 64), CI_DOWN = (DFF / 64) * (DM / 64), CI_PER_UNIT = (CI_OUT + CI_UP + CI_DOWN) / 256;
            static_assert((CI_OUT + CI_UP + CI_DOWN) % 256 == 0 && CI_PER_UNIT % NWAVES == 0, "conversion items divide over 256 units x 8 waves");
            const int qx0 = (int)(xb_xcc_id() & 7u);
            for (int pass = 0; pass < 8; ++pass) {
                const int x = (qx0 + pass) & 7;
                for (;;) {
                    __syncthreads();
                    if (F.tid == 0) F.MISC[0] = __hip_atomic_fetch_add(F.ctl + CW_AQ + 64 * x, 1u, RLX_AGENT);
                    __syncthreads();
                    const int e = (int)F.MISC[0];
                    if (e >= NQE) break;
                    const int blk = e / 7, r = e - blk * 7;
                    if (r == 3 || r == 6) {
                        if (sub & 8) {
                            const int u = 32 * x + 2 * blk + (r == 6 ? 1 : 0); LAS float* scr = (LAS float*)(F.lds + RING_OFF + F.wave * CONV_SCR); const int lane = lane_now();
                            for (int t = 0; t < CI_PER_UNIT / NWAVES; ++t) {
                                int g = u * CI_PER_UNIT + t * NWAVES + F.wave;
                                if (g < CI_OUT) conv_item64(KIN(14), DM, DM, KWS(bf16, WS_WOUT), scr, g, lane);
                                else if (g < CI_OUT + CI_UP) conv_item64(KIN(16), DM, DFF, KWS(bf16, WS_WUP), scr, g - CI_OUT, lane);
                                else conv_item64(KIN(17), DFF, DM, KWS(bf16, WS_WDOWN), scr, g - CI_OUT - CI_UP, lane);
                            }
                        }
                        continue;
                    }
                    const int a = blk * 5 + (r < 3 ? r : r - 1);
                    const float lam = lambda_of(KIN(8), KIN(9), KIN(10), KIN(11), lane_now());
                    if (a >= 42 && a < 58) { if (sub & 2) att::attnA_sample_unit(a - 42, x, KIN(2), KIN(3), karg_out() + OUT_KVS, karg_out() + OUT_KVS + (size_t)TS * HW, AQ, lam, KIN(12), 1.0f - LAM_INIT, OB, al); }
                    else if (sub & 1) att::attnA_prompt_unit2(x, a < 42 ? 63 - a : 79 - a, AQ, AK, AV, lam, KIN(12), 1.0f - LAM_INIT, OB, al);
                }
            }
        }
        if ((P2_MASK & 4) && (sub & 4)) {
            LAS char* vbuf = al + F.wave * 16384; const float* g_sb = KIN(13); const float* cache_b_k = KIN(4); const float* cache_b_v = KIN(5);
            constexpr unsigned NBU = DEC_B * B_HEADS + B_HEADS * (TP / 32);
            for (;;) {
                unsigned u = 0;
                if (lane_now() == 0) u = __hip_atomic_fetch_add(F.ctl + CW_BQ, 1u, RLX_AGENT);
                u = (unsigned)__builtin_amdgcn_readfirstlane((int)u);
                if (u >= NBU) break;
                if (u < DEC_B * B_HEADS) att::stick_sample_unit((int)(u >> 4), (int)(u & 15), BQ, BK, BV, cache_b_k, cache_b_v, g_sb, OB, vbuf);
                else { const int idx = (int)u - DEC_B * B_HEADS; const int h = (idx >> 3) & 15, qt = (TP / 32 - 1) - ((idx & 7) | ((idx >> 7) << 3)); att::stick_prompt_unit(h, qt, BQ, BK, BV, g_sb, OB, vbuf); }
            }
        }
        if (BOTH(2)) GRID_BAR();
    }
    if (IN(3)) {
        { pg8::Gemm g{KWS(bf16, WS_O), KWS(bf16, WS_WOUT), TP, DM, DM, DM}; pg8::StaticOrder S; S.init(TP, DM, F.G, (int)blockIdx.x, WGM_P4);
          pg8::EpiOutProj E{KIN(0), KIN(1), KIN(15), KWS(bf16, WS_X1), KWS(bf16, WS_H1), KSSQ(CW_SSQ1)};
          const SkPartial EK{KWS(float, WS_PART2), DM};
          int rstar, item0, istep; sample_slot(F.G, (int)blockIdx.x, TP / 256 * (DM / 256) / 256, (DM / 64) * SPL2, true, rstar, item0, istep);
          _Pragma("unroll 1") for (int part = 0; part < 2; ++part) { S.i0 = part ? rstar + 1 : 0; S.i1 = part ? (1 << 20) : rstar + 1;
            if (!(args.pad & 32)) pg8::gemm_phase<pg8::EpiOutProj, pg8::StaticOrder, true, true>(F.lds + RING_OFF, g, S, E);
            if (part == 0 && !(args.pad & 16)) for (int i = item0; i < (DM / 64) * SPL2; i += istep) sk::skinny_item(sk::Item{i >> 2, (i & 3) * (DM / 64 / SPL2), DM / 64 / SPL2, i & 3}, KWS(bf16, WS_O) + (size_t)TP * DM, DM, KWS(bf16, WS_WOUT), DM / 64, EK, (LAS char*)(F.lds + RING_OFF)); } }
        if (BOTH(3)) GRID_BAR();
    }
    if (IN(4)) {
        const int lane = lane_now(); const float* PART = KWS(float, WS_PART2); const float* xs = KIN(1); const float* g = KIN(15); float* X1S = KWS(float, WS_X1S); bf16* H1 = KWS(bf16, WS_H1); float* SSQ1 = KSSQ(CW_SSQ1);
        for (int it = gw; it < TS * (DM / 512); it += NGW) {
            const int row = it / (DM / 512), col = (it % (DM / 512)) * 512 + lane * 8;
            f32x4 a0 = *(const f32x4*)(xs + (size_t)row * DM + col), a1 = *(const f32x4*)(xs + (size_t)row * DM + col + 4);
#pragma unroll
            for (int ks = 0; ks < SPL2; ++ks) { const float* p = PART + ((size_t)ks * TS + row) * DM + col; a0 += *(const f32x4*)p; a1 += *(const f32x4*)(p + 4); }
            float* xo = X1S + (size_t)row * DM + col; *(f32x4*)xo = a0; *(f32x4*)(xo + 4) = a1;
            const float ss = wave_sum((a0.x * a0.x + a0.y * a0.y) + (a0.z * a0.z + a0.w * a0.w) + (a1.x * a1.x + a1.y * a1.y) + (a1.z * a1.z + a1.w * a1.w));
            if (lane == 0) pg8::ssq_add(SSQ1 + TP + row, ss);
            const f32x4 g0 = *(const f32x4*)(g + col), g1 = *(const f32x4*)(g + col + 4);
            v4u w; w.x = pk2(a0.x * g0.x, a0.y * g0.y); w.y = pk2(a0.z * g0.z, a0.w * g0.w); w.z = pk2(a1.x * g1.x, a1.y * g1.y); w.w = pk2(a1.z * g1.z, a1.w * g1.w);
            *(v4u*)(H1 + (size_t)(TP + row) * DM + col) = w;
        }
        if (BOTH(4)) GRID_BAR();
    }
    if (IN(5)) {
        { pg8::Gemm g{KWS(bf16, WS_H1), KWS(bf16, WS_WUP), TP, DFF, DM, DM}; pg8::StaticOrder S; S.init(TP, DFF, F.G, (int)blockIdx.x, WGM_P5);
          pg8::EpiUp E{KSSQ(CW_SSQ1), KWS(bf16, WS_U)};
          const SkUp EK{KSSQ(CW_SSQ1), KWS(bf16, WS_U)};
          int rstar, item0, istep; sample_slot(F.G, (int)blockIdx.x, TP / 256 * (DFF / 256) / 256, DFF / 64, false, rstar, item0, istep);
          _Pragma("unroll 1") for (int part = 0; part < 2; ++part) { S.i0 = part ? rstar + 1 : 0; S.i1 = part ? (1 << 20) : rstar + 1;
            if (!(args.pad & 32)) pg8::gemm_phase<pg8::EpiUp, pg8::StaticOrder, true, true>(F.lds + RING_OFF, g, S, E);
            if (part == 0 && !(args.pad & 16)) for (int i = item0; i < DFF / 64; i += istep) sk::skinny_item(sk::Item{i, 0, DM / 64, 0}, KWS(bf16, WS_H1) + (size_t)TP * DM, DM, KWS(bf16, WS_WUP), DM / 64, EK, (LAS char*)(F.lds + RING_OFF)); } }
        if (BOTH(5)) GRID_BAR();
    }
    if (IN(6)) {
        { pg8::Gemm g{KWS(bf16, WS_U), KWS(bf16, WS_WDOWN), TP, DM, DFF, DFF}; pg8::StaticOrder S; S.init(TP, DM, F.G, (int)blockIdx.x, WGM_P6);
          pg8::EpiDown E{KWS(bf16, WS_X1), KWS(bf16, WS_X2B), KSSQ(CW_SSQ2)};
          const SkPartial EK{KWS(float, WS_PART4), DM};
          int rstar, item0, istep; sample_slot(F.G, (int)blockIdx.x, TP / 256 * (DM / 256) / 256, (DM / 64) * SPL4, true, rstar, item0, istep);
          _Pragma("unroll 1") for (int part = 0; part < 2; ++part) { S.i0 = part ? rstar + 1 : 0; S.i1 = part ? (1 << 20) : rstar + 1;
            if (!(args.pad & 32)) pg8::gemm_phase<pg8::EpiDown, pg8::StaticOrder, true, true>(F.lds + RING_OFF, g, S, E);
            if (part == 0 && !(args.pad & 16)) for (int i = item0; i < (DM / 64) * SPL4; i += istep) sk::skinny_item(sk::Item{i >> 2, (i & 3) * (DFF / 64 / SPL4), DFF / 64 / SPL4, i & 3}, KWS(bf16, WS_U) + (size_t)TP * DFF, DFF, KWS(bf16, WS_WDOWN), DFF / 64, EK, (LAS char*)(F.lds + RING_OFF)); } }
        if (BOTH(6)) GRID_BAR();
    }
    if (IN(7)) {
        unsigned bad = __hip_atomic_load(F.ctl + CW_BAR + XB_TMO, RLX_AGENT);
        const float poison = bad ? __builtin_nanf("") : 0.f; float* out = karg_out(); const float* g_final = KIN(18); const float* SSQ2 = KSSQ(CW_SSQ2);
        const int lane = lane_now();
        for (int m = gw; m < TS; m += NGW) {
            const float* PART = KWS(float, WS_PART4); const GAS f32x4* xr = (const GAS f32x4*)(KWS(float, WS_X1S) + (size_t)m * DM) + lane;
            f32x4 v[16]; float s = 0.f;
#pragma unroll
            for (int j = 0; j < 16; ++j) v[j] = xr[64 * j];
#pragma unroll 1
            for (int ks = 0; ks < SPL4; ++ks) { const GAS f32x4* pr = (const GAS f32x4*)(PART + ((size_t)ks * TS + m) * DM) + lane;
#pragma unroll
                for (int j = 0; j < 16; ++j) v[j] += pr[64 * j]; }
#pragma unroll
            for (int j = 0; j < 16; ++j) s += (v[j].x * v[j].x + v[j].y * v[j].y) + (v[j].z * v[j].z + v[j].w * v[j].w);
            const float rs = 1.0f / sqrtf(wave_sum(s) * (1.f / DM) + EPS) + poison;
            GAS f32x4* yr = (GAS f32x4*)(out + OUT_Y + (size_t)(TP + m) * DM) + lane; const GAS f32x4* gr = (const GAS f32x4*)g_final + lane;
#pragma unroll
            for (int j = 0; j < 16; ++j) yr[64 * j] = v[j] * rs * gr[64 * j];
        }
        const bf16* X2B = KWS(bf16, WS_X2B);
        for (int m = gw; m < TP; m += NGW) {
            const float rs = 1.0f / sqrtf(SSQ2[m] * (1.f / DM) + EPS) + poison;
            const GAS v4u* xr = (const GAS v4u*)(X2B + (size_t)m * DM) + lane; GAS f32x4* yr = (GAS f32x4*)(out + OUT_Y + (size_t)m * DM) + 2 * lane; const GAS f32x4* gr = (const GAS f32x4*)g_final + 2 * lane;
#pragma unroll
            for (int j = 0; j < 8; ++j) { const v4u w = xr[64 * j]; const f32x4 g0 = gr[128 * j], g1 = gr[128 * j + 1];
                yr[128 * j] = (f32x4){pg8::bf_lo(w.x), pg8::bf_hi(w.x), pg8::bf_lo(w.y), pg8::bf_hi(w.y)} * rs * g0; yr[128 * j + 1] = (f32x4){pg8::bf_lo(w.z), pg8::bf_hi(w.z), pg8::bf_lo(w.w), pg8::bf_hi(w.w)} * rs * g1; }
        }
    }
#undef IN
#undef BOTH
#undef GRID_BAR
}

extern "C" void kernel_launch(void* const* d_in, const int* in_sizes, int n_in, void* d_out, int out_size, void* d_ws, size_t ws_size, hipStream_t stream) {
    static int grid = 0;
    if (grid == 0) {
        if (n_in != 19 || in_sizes[0] != TP * DM || (size_t)out_size != OUT_TOTAL || ws_size < WS_END) {
            fprintf(stderr, "kernel_launch: shape mismatch (n_in %d, in0 %d, out %d, ws %zu; need ws >= %zu); nothing launched\n", n_in, n_in > 0 ? in_sizes[0] : -1, out_size, ws_size, (size_t)WS_END); grid = -1; return; }
        int dev = 0, cus = 0, per_cu = 0;
        if (hipGetDevice(&dev) != hipSuccess || hipDeviceGetAttribute(&cus, hipDeviceAttributeMultiprocessorCount, dev) != hipSuccess) { grid = -1; return; }
        if (hipFuncSetAttribute((const void*)hybrid_fwd, hipFuncAttributeMaxDynamicSharedMemorySize, LDS_BYTES) != hipSuccess) { fprintf(stderr, "kernel_launch: hipFuncSetAttribute failed\n"); grid = -1; return; }
        if (hipOccupancyMaxActiveBlocksPerMultiprocessor(&per_cu, (const void*)hybrid_fwd, NWAVES * 64, LDS_BYTES) != hipSuccess || per_cu < 1) { fprintf(stderr, "kernel_launch: occupancy query reports %d blocks per CU\n", per_cu); grid = -1; (void)hipGetLastError(); return; }
        (void)hipGetLastError();
        grid = cus;
    }
    if (grid < 0) return;
    if (hipMemsetAsync((char*)d_ws + WS_CTL, 0, CTL_ZERO_BYTES, stream) != hipSuccess) return;
    Args a{};
    for (int i = 0; i < 19; ++i) a.in[i] = (const float*)d_in[i];
    a.out = (float*)d_out; a.ws = (unsigned char*)d_ws;
#ifndef DUP_MASK
#define DUP_MASK 0
#endif
    for (int li = 0; li < N_LAUNCHES; ++li) {
        a.ph_lo = (N_LAUNCHES == 1) ? 0 : li; a.ph_hi = (N_LAUNCHES == 1) ? N_PHASES : li + 1; a.li = li; a.pad = 0;
        if (N_LAUNCHES != 1 && ((DUP_MASK >> li) & 1)) hipLaunchKernelGGL(hybrid_fwd, dim3(grid), dim3(NWAVES * 64), LDS_BYTES, stream, a);
#ifdef DUP_SUB
#ifndef DUP_PH
#define DUP_PH 2
#endif
        if (N_LAUNCHES != 1 && li == DUP_PH) { a.pad = DUP_SUB; hipLaunchKernelGGL(hybrid_fwd, dim3(grid), dim3(NWAVES * 64), LDS_BYTES, stream, a); a.pad = 0;
            (void)hipMemsetAsync((char*)d_ws + WS_CTL + CW_BQ * 4, 0, (CW_AQ + 64 * 8 - CW_BQ) * 4, stream); }
#endif
        hipLaunchKernelGGL(hybrid_fwd, dim3(grid), dim3(NWAVES * 64), LDS_BYTES, stream, a);
        const hipError_t le = hipPeekAtLastError();
        if (le != hipSuccess) { fprintf(stderr, "kernel_launch: launch %d failed: %s\n", li, hipGetErrorName(le)); break; }
    }
}
```

```cpp
#ifndef MK_N_LAUNCHES
#define MK_N_LAUNCHES 1
#endif
#include <hip/hip_runtime.h>
#include <cstdio>
#include <cstdint>
#include <cmath>
namespace pg8 {
#define PG8_LAS __attribute__((address_space(3)))
typedef unsigned short bf16_t;
typedef short bf16x8 __attribute__((ext_vector_type(8)));
typedef float f32x4 __attribute__((ext_vector_type(4)));
typedef unsigned u32x4 __attribute__((ext_vector_type(4)));
constexpr int BM = 256, BK = 64, HALF = 128, HTB = HALF * BK * 2  , STAGE_BYTES = 8 * HTB, NXCD = 8, WGM = 8;

__host__ __device__ __forceinline__ int lds_byte(int r, int c) { return r * 128 + ((((c >> 3) ^ (r >> 1)) & 7) << 4) + (c & 7) * 2; }
__host__ __device__ __forceinline__ void stage_rc(int b, int& R, int& C) { R = b >> 7; C = ((((b >> 4) ^ (R >> 1)) & 7)) * 8; }
__host__ __device__ __forceinline__ int perm32(int rho) { const int n = rho >> 4, i = rho & 15; return 8 * (i >> 2) + 4 * n + (i & 3); }

struct Unit { int pm, pn, kofs, ks; };
struct Gemm { const bf16_t* A; const bf16_t* Bt; int M, N, K, ld; };

struct StaticOrder {
    int nM, nN, nwg, G, c, wgm;
    __host__ __device__ void init(int M, int N, int G_, int c_, int wgm_ = WGM) { nM = M / BM; nN = N / BM; nwg = nM * nN; G = G_; c = c_; wgm = wgm_; }
    __host__ __device__ bool next(int i, Unit& u) const {
        const long L = (long)i * G + c; if (L >= nwg) return false;
        int wgid = (int)L; { const int q = nwg / NXCD, r = nwg % NXCD, xcd = wgid % NXCD, off = wgid / NXCD; wgid = (xcd < r ? xcd * (q + 1) : r * (q + 1) + (xcd - r) * q) + off; }
        const int nig = wgm * nN, gid = wgid / nig, fm = gid * wgm, gsz = (nM - fm) < wgm ? (nM - fm) : wgm;
        u.pm = fm + ((wgid % nig) % gsz); u.pn = (wgid % nig) / gsz; u.kofs = 0; u.ks = 0; return true;
    }
    __device__ __forceinline__ void a_ready(const Unit&) const {}
    __device__ __forceinline__ void done(const Unit&) const {}
};
struct MiniOrder {
    int nN, nsplit, ksl, G, c, pm;
    __host__ __device__ void init(int N, int nsplit_, int ksl_, int G_, int c_, int pm_) { nN = N / BM; nsplit = nsplit_; ksl = ksl_; G = G_; c = c_; pm = pm_; }
    __host__ __device__ bool next(int i, Unit& u) const {
        const long L = (long)i * G + c; if (L >= (long)nN * nsplit) return false;
        const int m = (int)L; u.pm = pm; u.pn = m / nsplit; u.ks = m % nsplit; u.kofs = u.ks * ksl; return true;
    }
    __device__ __forceinline__ void a_ready(const Unit&) const {}
    __device__ __forceinline__ void done(const Unit&) const {}
};


typedef float f32x2_cv __attribute__((ext_vector_type(2))); typedef __bf16 bf16x2_cv __attribute__((ext_vector_type(2)));
__device__ __forceinline__ unsigned cvt_pk_bf16(float lo, float hi) { f32x2_cv v = {lo, hi}; bf16x2_cv b = __builtin_convertvector(v, bf16x2_cv); return __builtin_bit_cast(unsigned, b); }
typedef float f32x2 __attribute__((ext_vector_type(2)));
constexpr int E_DM = 4096, E_TP = 8192, E_MROWS = 8448, E_HW = 2048, E_DFF = 16384;
constexpr float E_EPS = 1e-6f;
__device__ __forceinline__ float dot4(const f32x4 a) { return (a[0] * a[0] + a[1] * a[1]) + (a[2] * a[2] + a[3] * a[3]); }
__device__ __forceinline__ void ssq_add(float* p, float v) { __hip_atomic_fetch_add(p, v, __ATOMIC_RELAXED, __HIP_MEMORY_SCOPE_AGENT); }

struct EpiInProj {
    static constexpr bool PERM = true, AFTER_DRAIN = false;
    bf16_t* qkv;
    float* out_kvp;
    float* out_kvs;
    const float* rope;
    __device__ __forceinline__ void operator()(const f32x4 (&acc)[2][2][4][2], const Unit& u, int wr, int wc, int fr, int fq) const {
        const int t = u.pn >> 3;
        const int col0 = (u.pn & 7) * BM + wc * 32 + 8 * fq;
        const int row0 = u.pm * BM + wr * 64 + fr;
        bf16_t* base = qkv + (size_t)t * ((size_t)E_MROWS * E_HW);
        float* fo = nullptr;
        if (t == 1 || t == 2 || t == 4 || t == 5) {
            const int idx = (t == 1) ? 0 : (t == 2) ? 1 : (t == 4) ? 2 : 3;
            fo = (u.pm < 32) ? out_kvp + (size_t)idx * ((size_t)E_TP * E_HW) : out_kvs + (size_t)idx * (256 * E_HW) - (size_t)E_TP * E_HW;
        }
        const bool rope_on = (t < 2) && (wc == 0);
        const float sgn = (fq < 2) ? -1.f : 1.f;
#pragma unroll
        for (int ai = 0; ai < 2; ++ai)
#pragma unroll
            for (int m = 0; m < 4; ++m) {
                const int row = row0 + ai * HALF + m * 16;
                f32x4 v[2][2];
#pragma unroll
                for (int bj = 0; bj < 2; ++bj)
#pragma unroll
                    for (int n = 0; n < 2; ++n) v[bj][n] = acc[ai][bj][m][n];
                if (rope_on) {
                    const float* rp = rope + (size_t)row * 32 + 8 * (fq & 1);
                    const f32x4 c0 = *(const f32x4*)(rp), c1 = *(const f32x4*)(rp + 4), s0 = *(const f32x4*)(rp + 16), s1 = *(const f32x4*)(rp + 20);
#pragma unroll
                    for (int bj = 0; bj < 2; ++bj)
#pragma unroll
                        for (int n = 0; n < 2; ++n)
#pragma unroll
                            for (int j = 0; j < 4; ++j) {
                                const float mine = v[bj][n][j], other = __shfl_xor(mine, 32);
                                const float cc = n ? c1[j] : c0[j], ss = n ? s1[j] : s0[j];
                                v[bj][n][j] = mine * cc + sgn * other * ss;
                            }
                }
#pragma unroll
                for (int bj = 0; bj < 2; ++bj) {
                    u32x4 w; w.x = cvt_pk_bf16(v[bj][0][0], v[bj][0][1]); w.y = cvt_pk_bf16(v[bj][0][2], v[bj][0][3]); w.z = cvt_pk_bf16(v[bj][1][0], v[bj][1][1]); w.w = cvt_pk_bf16(v[bj][1][2], v[bj][1][3]);
                    *(u32x4*)(base + (size_t)row * E_HW + col0 + bj * HALF) = w;
                }
                if (fo) {
#pragma unroll
                    for (int bj = 0; bj < 2; ++bj) { float* p = fo + (size_t)row * E_HW + col0 + bj * HALF; *(f32x4*)p = v[bj][0]; *(f32x4*)(p + 4) = v[bj][1]; }
                }
            }
    }
};

struct EpiOutProj {
    static constexpr bool PERM = true, AFTER_DRAIN = false;
    const float* xp; const float* xs; const float* g; bf16_t* x1b; bf16_t* h1; float* ssq;
    __device__ __forceinline__ void operator()(const f32x4 (&acc)[2][2][4][2], const Unit& u, int wr, int wc, int fr, int fq) const {
        const int col0 = u.pn * BM + wc * 32 + 8 * fq;
        const int row0 = u.pm * BM + wr * 64 + fr;
        f32x4 gv[2][2];
#pragma unroll
        for (int bj = 0; bj < 2; ++bj) { gv[bj][0] = *(const f32x4*)(g + col0 + bj * HALF); gv[bj][1] = *(const f32x4*)(g + col0 + bj * HALF + 4); }
#pragma unroll
        for (int ai = 0; ai < 2; ++ai)
#pragma unroll
            for (int m = 0; m < 4; ++m) {
                const int row = row0 + ai * HALF + m * 16;
                const float* xrow = (row < E_TP) ? xp + (size_t)row * E_DM : xs + (size_t)(row - E_TP) * E_DM;
                float s = 0.f;
#pragma unroll
                for (int bj = 0; bj < 2; ++bj) {
                    const f32x4 r0 = *(const f32x4*)(xrow + col0 + bj * HALF), r1 = *(const f32x4*)(xrow + col0 + bj * HALF + 4);
                    const f32x4 v0 = acc[ai][bj][m][0] + r0, v1 = acc[ai][bj][m][1] + r1;
                    { u32x4 w; w.x = cvt_pk_bf16(v0[0], v0[1]); w.y = cvt_pk_bf16(v0[2], v0[3]); w.z = cvt_pk_bf16(v1[0], v1[1]); w.w = cvt_pk_bf16(v1[2], v1[3]); *(u32x4*)(x1b + (size_t)row * E_DM + col0 + bj * HALF) = w; }
                    s += dot4(v0) + dot4(v1);
                    const f32x4 a = v0 * gv[bj][0], b = v1 * gv[bj][1];
                    u32x4 w; w.x = cvt_pk_bf16(a[0], a[1]); w.y = cvt_pk_bf16(a[2], a[3]); w.z = cvt_pk_bf16(b[0], b[1]); w.w = cvt_pk_bf16(b[2], b[3]);
                    *(u32x4*)(h1 + (size_t)row * E_DM + col0 + bj * HALF) = w;
                }
                s += __shfl_xor(s, 16); s += __shfl_xor(s, 32);
                if (fq == 0) ssq_add(ssq + row, s);
                if (m & 1) asm volatile("" ::: "memory");
            }
    }
};

struct EpiUp {
    static constexpr bool PERM = true, AFTER_DRAIN = false;
    const float* ssq; bf16_t* U;
    __device__ __forceinline__ void operator()(const f32x4 (&acc)[2][2][4][2], const Unit& u, int wr, int wc, int fr, int fq) const {
        const int col0 = u.pn * BM + wc * 32 + 8 * fq;
        const int row0 = u.pm * BM + wr * 64 + fr;
#pragma unroll
        for (int ai = 0; ai < 2; ++ai)
#pragma unroll
            for (int m = 0; m < 4; ++m) {
                const int row = row0 + ai * HALF + m * 16;
                const float rs = __builtin_amdgcn_rsqf(ssq[row] * (1.0f / E_DM) + E_EPS);
#pragma unroll
                for (int bj = 0; bj < 2; ++bj) {
                    f32x4 a = acc[ai][bj][m][0] * rs, b = acc[ai][bj][m][1] * rs;
#pragma unroll
                    for (int j = 0; j < 4; ++j) { const float x = fmaxf(a[j], 0.f), y = fmaxf(b[j], 0.f); a[j] = x * x; b[j] = y * y; }
                    u32x4 w; w.x = cvt_pk_bf16(a[0], a[1]); w.y = cvt_pk_bf16(a[2], a[3]); w.z = cvt_pk_bf16(b[0], b[1]); w.w = cvt_pk_bf16(b[2], b[3]);
                    *(u32x4*)(U + (size_t)row * E_DFF + col0 + bj * HALF) = w;
                }
            }
    }
};

__device__ __forceinline__ float bf_lo(unsigned w) { return __uint_as_float(w << 16); }
__device__ __forceinline__ float bf_hi(unsigned w) { return __uint_as_float(w & 0xffff0000u); }
struct EpiDown {
    static constexpr bool PERM = true, AFTER_DRAIN = false;
    const bf16_t* x1b; bf16_t* x2b; float* ssq;
    __device__ __forceinline__ void operator()(const f32x4 (&acc)[2][2][4][2], const Unit& u, int wr, int wc, int fr, int fq) const {
        const int col0 = u.pn * BM + wc * 32 + 8 * fq;
        const int row0 = u.pm * BM + wr * 64 + fr;
#pragma unroll
        for (int ai = 0; ai < 2; ++ai)
#pragma unroll
            for (int m = 0; m < 4; ++m) {
                const int row = row0 + ai * HALF + m * 16;
                float s = 0.f;
#pragma unroll
                for (int bj = 0; bj < 2; ++bj) {
                    const u32x4 r = *(const u32x4*)(x1b + (size_t)row * E_DM + col0 + bj * HALF);
                    const f32x4 v0 = acc[ai][bj][m][0] + (f32x4){bf_lo(r.x), bf_hi(r.x), bf_lo(r.y), bf_hi(r.y)}, v1 = acc[ai][bj][m][1] + (f32x4){bf_lo(r.z), bf_hi(r.z), bf_lo(r.w), bf_hi(r.w)};
                    u32x4 w; w.x = cvt_pk_bf16(v0[0], v0[1]); w.y = cvt_pk_bf16(v0[2], v0[3]); w.z = cvt_pk_bf16(v1[0], v1[1]); w.w = cvt_pk_bf16(v1[2], v1[3]);
                    *(u32x4*)(x2b + (size_t)row * E_DM + col0 + bj * HALF) = w;
                    s += dot4(v0) + dot4(v1);
                }
                s += __shfl_xor(s, 16); s += __shfl_xor(s, 32);
                if (fq == 0) ssq_add(ssq + row, s);
                if (m & 1) asm volatile("" ::: "memory");
            }
    }
};

struct EpiPartial {
    static constexpr bool PERM = true, AFTER_DRAIN = false;
    float* part; int N;
    __device__ __forceinline__ void operator()(const f32x4 (&acc)[2][2][4][2], const Unit& u, int wr, int wc, int fr, int fq) const {
        const int col0 = u.pn * BM + wc * 32 + 8 * fq;
        float* base = part + ((size_t)u.ks * BM + wr * 64 + fr) * N + col0;
#pragma unroll
        for (int ai = 0; ai < 2; ++ai)
#pragma unroll
            for (int m = 0; m < 4; ++m)
#pragma unroll
                for (int bj = 0; bj < 2; ++bj) { float* p = base + (size_t)(ai * HALF + m * 16) * N + bj * HALF; *(f32x4*)p = acc[ai][bj][m][0]; *(f32x4*)(p + 4) = acc[ai][bj][m][1]; }
    }
};

template <class Epi, class Sched, bool ALIGN_EPI = false, bool SP2 = false>
__device__ __forceinline__ void gemm_phase(PG8_LAS unsigned char* lds, const Gemm g, const Sched& S, const Epi& E) {
    int tid = threadIdx.x; asm volatile("" : "+v"(tid));
    const int wid = __builtin_amdgcn_readfirstlane(tid >> 6), lane = tid & 63, wr = wid >> 2, wc = wid & 3, fr = lane & 15, fq = lane >> 4;
    const int K = g.ld, nt = g.K / BK;
    unsigned voffA[2], voffB[2];
#pragma unroll
    for (int i = 0; i < 2; ++i) { int R, C; stage_rc(tid * 16 + i * 8192, R, C); const int Rb = Epi::PERM ? ((R & ~31) + perm32(R & 31)) : R;
        voffA[i] = (unsigned)(R * K + C) * 2u; voffB[i] = (unsigned)(Rb * BK + C) * 2u; }
    const size_t kstep = (size_t)(BK * 2);
    const size_t hstep = (size_t)HALF * K * 2;
    const size_t tstep = 2 * hstep;
    const size_t kstepB = (size_t)BM * BK * 2, hstepB = (size_t)HALF * BK * 2, tstepB = (size_t)(K / BK) * kstepB;
    const unsigned ldsw = (unsigned)wid * 1024u;
    const int aoff0 = lds_byte(wr * 64 + fr, fq * 8), aoff1 = lds_byte(wr * 64 + fr, 32 + fq * 8), boff0 = lds_byte(wc * 32 + fr, fq * 8), boff1 = lds_byte(wc * 32 + fr, 32 + fq * 8);
#define PG8_SA(b, h) (((b) * 2 + (h)) * HTB)
#define PG8_SB(b, h) ((4 + (b) * 2 + (h)) * HTB)
#define PG8_STAGE(bufoff, gbase, voff) do { _Pragma("unroll") for (int _i = 0; _i < 2; ++_i) \
        __builtin_amdgcn_global_load_lds((const unsigned*)((const char*)(gbase) + (voff)[_i]), (PG8_LAS unsigned*)(lds + (bufoff) + ldsw + _i * 8192), 16, 0, 0); } while (0)
#define PG8_LDA(dst, b, h) do { _Pragma("unroll") for (int m = 0; m < 4; ++m) _Pragma("unroll") for (int k = 0; k < 2; ++k) dst[m][k] = *(const PG8_LAS bf16x8*)(lds + PG8_SA(b, h) + (k ? aoff1 : aoff0) + m * 2048); } while (0)
#define PG8_LDB(dst, b, h) do { _Pragma("unroll") for (int n = 0; n < 2; ++n) _Pragma("unroll") for (int k = 0; k < 2; ++k) dst[n][k] = *(const PG8_LAS bf16x8*)(lds + PG8_SB(b, h) + (k ? boff1 : boff0) + n * 2048); } while (0)
#define PG8_MMA(ai, bj, At, Bt) do { __builtin_amdgcn_s_setprio(1); _Pragma("unroll") for (int m = 0; m < 4; ++m) _Pragma("unroll") for (int n = 0; n < 2; ++n) _Pragma("unroll") for (int k = 0; k < 2; ++k) \
        acc[ai][bj][m][n] = __builtin_amdgcn_mfma_f32_16x16x32_bf16(Bt[n][k], At[m][k], acc[ai][bj][m][n], 0, 0, 0); __builtin_amdgcn_s_setprio(0); } while (0)
#define PG8_WAIT_V(n) asm volatile("s_waitcnt vmcnt(" #n ")" ::: "memory")
#define PG8_WAIT_L(n) asm volatile("s_waitcnt lgkmcnt(" #n ")" ::: "memory")
#define PG8_BAR __builtin_amdgcn_s_barrier()
#define PG8_SCHED __builtin_amdgcn_sched_barrier(0)
    Unit cur, nxt; int ui = 0;
    if (!S.next(0, cur)) return;
    f32x4 acc[2][2][4][2];
#pragma unroll
    for (int a = 0; a < 2; ++a)
#pragma unroll
        for (int b = 0; b < 2; ++b)
#pragma unroll
            for (int m = 0; m < 4; ++m)
#pragma unroll
                for (int n = 0; n < 2; ++n) acc[a][b][m][n] = (f32x4){0.f, 0.f, 0.f, 0.f};
    bf16x8 At[4][2], B0[2][2], B1[2][2];
    const char* cA = (const char*)g.A + (size_t)cur.pm * tstep + (size_t)cur.kofs * 2; const char* cB = (const char*)g.Bt + (size_t)cur.pn * tstepB + (size_t)(cur.kofs / BK) * kstepB;
    S.a_ready(cur);
    if constexpr (SP2) {
        PG8_STAGE(PG8_SB(0, 0), cB, voffB); PG8_STAGE(PG8_SB(0, 1), cB + hstepB, voffB); PG8_STAGE(PG8_SA(0, 0), cA, voffA); PG8_STAGE(PG8_SA(0, 1), cA + hstep, voffA);
        if (wr == 1) PG8_BAR;
        PG8_WAIT_V(2); PG8_BAR;
        PG8_STAGE(PG8_SB(1, 0), cB + kstepB, voffB); PG8_STAGE(PG8_SA(1, 0), cA + kstep, voffA); PG8_STAGE(PG8_SB(1, 1), cB + hstepB + kstepB, voffB);
        PG8_WAIT_V(6); PG8_BAR;
    } else {
        PG8_STAGE(PG8_SB(0, 0), cB, voffB); PG8_STAGE(PG8_SA(0, 0), cA, voffA); PG8_STAGE(PG8_SB(0, 1), cB + hstepB, voffB); PG8_STAGE(PG8_SA(0, 1), cA + hstep, voffA);
        if (wr == 1) PG8_BAR;
        PG8_WAIT_V(4); PG8_BAR;
        PG8_STAGE(PG8_SB(1, 0), cB + kstepB, voffB); PG8_STAGE(PG8_SA(1, 0), cA + kstep, voffA); PG8_STAGE(PG8_SB(1, 1), cB + hstepB + kstepB, voffB);
        PG8_WAIT_V(6); PG8_BAR;
    }
    for (;;) {
        const bool has_next = S.next(ui + 1, nxt);
        const char* nA = has_next ? (const char*)g.A + (size_t)nxt.pm * tstep + (size_t)nxt.kofs * 2 : cA; const char* nB = has_next ? (const char*)g.Bt + (size_t)nxt.pn * tstepB + (size_t)(nxt.kofs / BK) * kstepB : cB;
        for (int t = 0; t < nt; t += 2) {
            const bool last = (t == nt - 2);
            const char* a1 = cA + (size_t)(t + 1) * kstep;
            const char* a2 = last ? nA : cA + (size_t)(t + 2) * kstep; const char* b2 = last ? nB : cB + (size_t)(t + 2) * kstepB;
            const char* a3 = a2 + kstep; const char* b3 = b2 + kstepB;
            if (last && has_next) S.a_ready(nxt);
            if constexpr (SP2) {
            PG8_LDB(B0, 0, 0); PG8_LDB(B1, 0, 1); PG8_SCHED; PG8_LDA(At, 0, 0); PG8_STAGE(PG8_SA(1, 1), a1 + hstep, voffA);
            PG8_WAIT_V(8); PG8_WAIT_L(0); PG8_BAR; PG8_MMA(0, 0, At, B0); PG8_MMA(0, 1, At, B1); PG8_BAR; PG8_SCHED;
            PG8_LDA(At, 0, 1); PG8_STAGE(PG8_SB(0, 0), b2, voffB); PG8_STAGE(PG8_SB(0, 1), b2 + hstepB, voffB); PG8_STAGE(PG8_SA(0, 0), a2, voffA);
            PG8_WAIT_V(8); PG8_WAIT_L(0); PG8_BAR; PG8_MMA(1, 0, At, B0); PG8_MMA(1, 1, At, B1); PG8_BAR; PG8_SCHED;
            PG8_LDB(B0, 1, 0); PG8_LDB(B1, 1, 1); PG8_SCHED; PG8_LDA(At, 1, 0); PG8_STAGE(PG8_SA(0, 1), a2 + hstep, voffA);
            PG8_WAIT_V(8); PG8_WAIT_L(0); PG8_BAR; PG8_MMA(0, 0, At, B0); PG8_MMA(0, 1, At, B1); PG8_BAR; PG8_SCHED;
            PG8_LDA(At, 1, 1); PG8_STAGE(PG8_SB(1, 0), b3, voffB); PG8_STAGE(PG8_SB(1, 1), b3 + hstepB, voffB); PG8_STAGE(PG8_SA(1, 0), a3, voffA);
            PG8_WAIT_V(8); PG8_WAIT_L(0); PG8_BAR; PG8_MMA(1, 0, At, B0); PG8_MMA(1, 1, At, B1); PG8_BAR; PG8_SCHED;
            } else {
            PG8_LDB(B0, 0, 0); PG8_SCHED; PG8_LDA(At, 0, 0); PG8_STAGE(PG8_SA(1, 1), a1 + hstep, voffA);
            PG8_WAIT_L(8); PG8_BAR; PG8_WAIT_L(0); PG8_MMA(0, 0, At, B0); PG8_BAR; PG8_SCHED;
            PG8_LDB(B1, 0, 1); PG8_STAGE(PG8_SB(0, 0), b2, voffB);
            PG8_BAR; PG8_WAIT_L(0); PG8_MMA(0, 1, At, B1); PG8_BAR;
            PG8_LDA(At, 0, 1); PG8_STAGE(PG8_SA(0, 0), a2, voffA);
            PG8_BAR; PG8_WAIT_L(0); PG8_MMA(1, 0, At, B0); PG8_BAR; PG8_SCHED;
            PG8_STAGE(PG8_SB(0, 1), b2 + hstepB, voffB);
            PG8_WAIT_V(6); PG8_BAR; PG8_MMA(1, 1, At, B1); PG8_BAR;
            PG8_LDB(B0, 1, 0); PG8_SCHED; PG8_LDA(At, 1, 0); PG8_STAGE(PG8_SA(0, 1), a2 + hstep, voffA);
            PG8_WAIT_L(8); PG8_BAR; PG8_WAIT_L(0); PG8_MMA(0, 0, At, B0); PG8_BAR; PG8_SCHED;
            PG8_LDB(B1, 1, 1); PG8_STAGE(PG8_SB(1, 0), b3, voffB);
            PG8_BAR; PG8_WAIT_L(0); PG8_MMA(0, 1, At, B1); PG8_BAR;
            PG8_LDA(At, 1, 1); PG8_STAGE(PG8_SA(1, 0), a3, voffA);
            PG8_BAR; PG8_WAIT_L(0); PG8_MMA(1, 0, At, B0); PG8_BAR; PG8_SCHED;
            PG8_STAGE(PG8_SB(1, 1), b3 + hstepB, voffB);
            PG8_WAIT_V(6); PG8_BAR; PG8_MMA(1, 1, At, B1); PG8_BAR;
            }
        }
        if constexpr (ALIGN_EPI) { if (wr == 0) PG8_BAR; }
        if constexpr (!Epi::AFTER_DRAIN) { E(acc, cur, wr, wc, fr, fq); S.done(cur); }
        if (!has_next) break;
#pragma unroll
        for (int a = 0; a < 2; ++a)
#pragma unroll
            for (int b = 0; b < 2; ++b)
#pragma unroll
                for (int m = 0; m < 4; ++m)
#pragma unroll
                    for (int n = 0; n < 2; ++n) acc[a][b][m][n] = (f32x4){0.f, 0.f, 0.f, 0.f};
        cur = nxt; cA = nA; cB = nB; ++ui;
        if constexpr (ALIGN_EPI) { if (wr == 1) PG8_BAR; }
    }
    PG8_WAIT_V(0);
    if constexpr (!ALIGN_EPI) { if (wr == 0) PG8_BAR; }
    PG8_BAR;
    if constexpr (Epi::AFTER_DRAIN) { E.fused(acc, cur, wr, wc, fr, fq, lds, wid, lane); S.done(cur); }
#undef PG8_SA
#undef PG8_SB
#undef PG8_STAGE
#undef PG8_LDA
#undef PG8_LDB
#undef PG8_MMA
#undef PG8_WAIT_V
#undef PG8_WAIT_L
#undef PG8_BAR
#undef PG8_SCHED
}
}
namespace att {
#define ALAS __attribute__((address_space(3)))
typedef unsigned short bf16;
using bf16x8 = __attribute__((ext_vector_type(8))) short;
using s16x4  = __attribute__((ext_vector_type(4))) short;
using f32x16 = __attribute__((ext_vector_type(16))) float;
using f32x8  = __attribute__((ext_vector_type(8))) float;
using f32x4  = __attribute__((ext_vector_type(4))) float;
using u32x4  = __attribute__((ext_vector_type(4))) unsigned;
constexpr int D = 128, NW = 8, QBLK = 32, KVBLK = 64;
constexpr float SCALE = 0.088388347648318440f;
constexpr float LOG2E = 1.4426950408889634f, LN2 = 0.6931471805599453f;
constexpr float THR = 8.f;
constexpr int HW = 2048;
constexpr int DMODEL = 4096, TP = 8192;
constexpr float EPS = 1e-6f;
constexpr int SHM_V = KVBLK * D * 2, SHM_K = KVBLK * D * 2;
#define KSWZ(row, colB) ((row) * 256 + ((colB) ^ (((row) & 7) << 4)))
#define SBAR() __builtin_amdgcn_sched_barrier(0)
__device__ __forceinline__ int crow(int r, int hi) { return (r & 3) + 8 * (r >> 2) + 4 * hi; }
typedef float f32x2_cv __attribute__((ext_vector_type(2))); typedef __bf16 bf16x2_cv __attribute__((ext_vector_type(2)));
__device__ __forceinline__ unsigned cvtpk(float lo, float hi) { f32x2_cv v = {lo, hi}; bf16x2_cv b = __builtin_convertvector(v, bf16x2_cv); return __builtin_bit_cast(unsigned, b); }
__device__ __forceinline__ bf16x8 ld8bf(const bf16* p) { return *reinterpret_cast<const bf16x8*>(p); }
__device__ __forceinline__ f32x8 ld8f(const float* p) { return *reinterpret_cast<const f32x8*>(p); }
__device__ __forceinline__ bf16x8 tobf(f32x8 x) { u32x4 w = {cvtpk(x[0], x[1]), cvtpk(x[2], x[3]), cvtpk(x[4], x[5]), cvtpk(x[6], x[7])}; return *reinterpret_cast<bf16x8*>(&w); }
__device__ __forceinline__ bf16x8 ld8any(const bf16* p) { return ld8bf(p); }
__device__ __forceinline__ bf16x8 ld8any(const float* p) { return tobf(ld8f(p)); }
__device__ __forceinline__ float swap32(float x, int hi) {
    auto rr = __builtin_amdgcn_permlane32_swap(__float_as_uint(x), __float_as_uint(x), false, false);
    return __uint_as_float(hi ? rr[0] : rr[1]);
}

__device__ __forceinline__ void glds16(const void* gsrc, unsigned lds_dst) { unsigned keep;
  asm volatile("s_mov_b32 %0, m0\n\ts_mov_b32 m0, %2\n\ts_nop 0\n\tglobal_load_lds_dwordx4 %1, off\n\ts_mov_b32 m0, %0" : "=&s"(keep) : "v"(gsrc), "s"(lds_dst) : "memory"); }
__device__ __forceinline__ void partialSM(f32x16& p0, f32x16& p1, float& m_reg, float& mn, float& alpha, float msk = 0.f) {
  constexpr float C = SCALE * LOG2E;
  float pmax = p0[0];
#pragma unroll
  for (int r = 1; r < 16; ++r) pmax = fmaxf(pmax, p0[r]);
#pragma unroll
  for (int r = 0; r < 16; ++r) pmax = fmaxf(pmax, p1[r]);
  { auto rr = __builtin_amdgcn_permlane32_swap(__float_as_uint(pmax), __float_as_uint(pmax), false, false);
    pmax = fmaxf(__uint_as_float(rr[0]), __uint_as_float(rr[1])) + msk; }
  if (__builtin_expect(__all(pmax - m_reg <= THR / SCALE), 1)) { mn = m_reg; alpha = 1.f; }
  else { mn = fmaxf(m_reg, pmax); alpha = __builtin_amdgcn_exp2f((m_reg - mn) * C); m_reg = mn; }
  float mnC = -mn * C + msk;
#pragma unroll
  for (int r = 0; r < 16; ++r) p0[r] = fmaf(p0[r], C, mnC);
#pragma unroll
  for (int r = 0; r < 16; ++r) p1[r] = fmaf(p1[r], C, mnC);
#pragma unroll
  for (int r = 0; r < 16; ++r) p0[r] = __builtin_amdgcn_exp2f(p0[r]);
}
#define PK4(P, BASE, OUT) do { unsigned a0 = cvtpk(P[BASE + 0], P[BASE + 1]), a1 = cvtpk(P[BASE + 2], P[BASE + 3]);   \
    unsigned b0 = cvtpk(P[BASE + 4], P[BASE + 5]), b1 = cvtpk(P[BASE + 6], P[BASE + 7]);                              \
    auto r0 = __builtin_amdgcn_permlane32_swap(a0, b0, false, false); auto r1 = __builtin_amdgcn_permlane32_swap(a1, b1, false, false); \
    u32x4 w = {r0[0], r1[0], r0[1], r1[1]}; OUT = *reinterpret_cast<bf16x8*>(&w); } while (0)
__device__ __forceinline__ void finishSM(f32x16& p0, f32x16& p1, float alpha, float& l_reg, bf16x8& pa0, bf16x8& pa1, bf16x8& pa2, bf16x8& pa3) {
#pragma unroll
  for (int r = 0; r < 16; ++r) p1[r] = __builtin_amdgcn_exp2f(p1[r]);
  float ps = 0;
#pragma unroll
  for (int r = 0; r < 16; ++r) ps += p0[r];
#pragma unroll
  for (int r = 0; r < 16; ++r) ps += p1[r];
  { auto rr = __builtin_amdgcn_permlane32_swap(__float_as_uint(ps), __float_as_uint(ps), false, false);
    ps = __uint_as_float(rr[0]) + __uint_as_float(rr[1]); }
  l_reg = l_reg * alpha + ps;
  PK4(p0, 0, pa0); PK4(p0, 8, pa1); PK4(p1, 0, pa2); PK4(p1, 8, pa3);
}
__device__ __forceinline__ void qkt(f32x16& p0, f32x16& p1, const ALAS char* Ks, const bf16x8* qr, int r32, int hi) {
  p0 = f32x16{}; p1 = f32x16{};
#pragma unroll
  for (int d0 = 0; d0 < 8; ++d0) { int cb = (d0 * 16 + hi * 8) * 2;
    bf16x8 b0 = *reinterpret_cast<const ALAS bf16x8*>(Ks + KSWZ(r32, cb));
    bf16x8 b1 = *reinterpret_cast<const ALAS bf16x8*>(Ks + KSWZ(32 + r32, cb));
    p0 = __builtin_amdgcn_mfma_f32_32x32x16_bf16(b0, qr[d0], p0, 0, 0, 0);
    p1 = __builtin_amdgcn_mfma_f32_32x32x16_bf16(b1, qr[d0], p1, 0, 0, 0); }
}
template <int NQR>
__device__ __forceinline__ void qkt_h(f32x16& p0, f32x16& p1, const ALAS char* Ks, const bf16x8* qr, const ALAS char* Qs, int qrow, int r32, int hi) {
  p0 = f32x16{}; p1 = f32x16{};
#pragma unroll
  for (int d0 = 0; d0 < 8; ++d0) { int cb = (d0 * 16 + hi * 8) * 2;
    bf16x8 b0 = *reinterpret_cast<const ALAS bf16x8*>(Ks + KSWZ(r32, cb));
    bf16x8 b1 = *reinterpret_cast<const ALAS bf16x8*>(Ks + KSWZ(32 + r32, cb));
    bf16x8 q = d0 < NQR ? qr[d0] : *reinterpret_cast<const ALAS bf16x8*>(Qs + KSWZ(qrow, cb));
    p0 = __builtin_amdgcn_mfma_f32_32x32x16_bf16(b0, q, p0, 0, 0, 0);
    p1 = __builtin_amdgcn_mfma_f32_32x32x16_bf16(b1, q, p1, 0, 0, 0); }
}
__device__ __forceinline__ int v_st(int k, int c) { const int kk = (k & ~0xC) | ((k & 4) << 1) | ((k & 8) >> 1); return ((kk >> 3) * 4 + (c >> 5)) * 512 + ((kk & 7) * 32 + (c & 31)) * 2; }
__device__ __forceinline__ int v_rd_base(int lane) { return ((lane & 3) << 3) | (((lane >> 2) & 3) << 6) | (((lane >> 4) & 1) << 5) | (((lane >> 5) & 1) << 8); }
constexpr int v_rd_off(int d0, int ks, int half) { return d0 * 512 + ks * 4096 + half * 2048; }
template <int OFF> __device__ __forceinline__ s16x4 tr_read(int vb) {
  s16x4 r; asm volatile("ds_read_b64_tr_b16 %0, %1 offset:%2" : "=&v"(r) : "v"(vb), "i"(OFF) : "memory"); return r;
}
template <int D0> __device__ __forceinline__ void pv_one(f32x16& od, int vb, bf16x8 pa0, bf16x8 pa1, bf16x8 pa2, bf16x8 pa3) {
  const s16x4 l0 = tr_read<v_rd_off(D0, 0, 0)>(vb), h0 = tr_read<v_rd_off(D0, 0, 1)>(vb), l1 = tr_read<v_rd_off(D0, 1, 0)>(vb), h1 = tr_read<v_rd_off(D0, 1, 1)>(vb);
  const s16x4 l2 = tr_read<v_rd_off(D0, 2, 0)>(vb), h2 = tr_read<v_rd_off(D0, 2, 1)>(vb), l3 = tr_read<v_rd_off(D0, 3, 0)>(vb), h3 = tr_read<v_rd_off(D0, 3, 1)>(vb);
  asm volatile("s_waitcnt lgkmcnt(0)" ::: "memory"); SBAR();
#define PK(L, H) (bf16x8){L[0], L[1], L[2], L[3], H[0], H[1], H[2], H[3]}
  od = __builtin_amdgcn_mfma_f32_32x32x16_bf16(pa0, PK(l0, h0), od, 0, 0, 0);
  od = __builtin_amdgcn_mfma_f32_32x32x16_bf16(pa1, PK(l1, h1), od, 0, 0, 0);
  od = __builtin_amdgcn_mfma_f32_32x32x16_bf16(pa2, PK(l2, h2), od, 0, 0, 0);
  od = __builtin_amdgcn_mfma_f32_32x32x16_bf16(pa3, PK(l3, h3), od, 0, 0, 0);
#undef PK
}
__device__ __forceinline__ void pv_d0(f32x16* o, int vb, bf16x8 pa0, bf16x8 pa1, bf16x8 pa2, bf16x8 pa3) {
  pv_one<0>(o[0], vb, pa0, pa1, pa2, pa3); pv_one<1>(o[1], vb, pa0, pa1, pa2, pa3); pv_one<2>(o[2], vb, pa0, pa1, pa2, pa3); pv_one<3>(o[3], vb, pa0, pa1, pa2, pa3);
}
__device__ __forceinline__ void fill_neg(f32x16& p0, f32x16& p1) {
#pragma unroll
  for (int r = 0; r < 16; ++r) { p0[r] = -1e30f; p1[r] = -1e30f; }
}

constexpr int SHM_QOFF = 2 * SHM_V + 2 * SHM_K + NW * 64 * 4, SHM_ATTN = SHM_QOFF + 256 * 256;
constexpr int NQR = 8;
__device__ __forceinline__ void attnA_prompt_unit(int vh, int qb, const bf16* __restrict__ AQ, const bf16* __restrict__ AK, const bf16* __restrict__ AV, float* __restrict__ OA, ALAS char* lds) {
  int tid = threadIdx.x; asm volatile("" : "+v"(tid));
  const int wid = __builtin_amdgcn_readfirstlane(tid >> 6), lane = tid & 63, r32 = lane & 31, hi = lane >> 5;
  const int h = vh >> 2, c = (vh >> 1) & 1, vhalf = vh & 1;
  const bf16* Qb = AQ + (size_t)(qb * 256) * HW + h * 256 + c * 128;
  const bf16* Kh = AK + h * 256 + c * 128;
  const bf16* Vh = AV + h * 256 + vhalf * 128;
  float* Ob = OA + (size_t)(qb * 256) * DMODEL + h * 512 + c * 256 + vhalf * 128;
  const int NT = 4 * qb + 4, jmax = 4 * qb + (wid >> 1);
  ALAS char* V_lds = lds; ALAS char* K_lds = lds + 2 * SHM_V;
  ALAS float* ws = (ALAS float*)(lds + 2 * SHM_V + 2 * SHM_K) + wid * 64; ALAS float* li_l = ws; ALAS float* al_l = ws + 32;
  float m_reg = -1e30f, l_reg = 0; f32x16 o[4] = {}; bf16x8 qr[NQR];
  const bf16* Qw = Qb + (size_t)(wid * QBLK + r32) * HW + hi * 8;
  ALAS char* Q_lds = lds + SHM_QOFF; const int qrow = wid * QBLK + r32;
#pragma unroll
  for (int d0 = 0; d0 < 8; ++d0) { const bf16x8 q = ld8bf(Qw + d0 * 16); if (d0 < NQR) qr[d0] = q; else *(ALAS bf16x8*)(Q_lds + KSWZ(qrow, (d0 * 16 + hi * 8) * 2)) = q; }
  const int sr = tid >> 4, sc = (tid & 15) * 8, vst0 = v_st(sr, sc), vst1 = v_st(32 + sr, sc);
  const int vb0 = (int)(unsigned)(uintptr_t)V_lds + v_rd_base(lane);
  constexpr int SDEPTH = 1;
  struct { bf16x8 vs0, vs1, ks0, ks1; } sr_[SDEPTH];
  const unsigned lo0 = (unsigned)(sr * HW + sc) * 2u, lo1 = lo0 + 32u * HW * 2u;
#define SLOAD(i, k0) do { const char* kb_ = (const char*)Kh + (size_t)(k0) * (HW * 2); const char* vb_ = (const char*)Vh + (size_t)(k0) * (HW * 2); \
    sr_[i].vs0 = *(const bf16x8*)(vb_ + lo0); sr_[i].vs1 = *(const bf16x8*)(vb_ + lo1); sr_[i].ks0 = *(const bf16x8*)(kb_ + lo0); sr_[i].ks1 = *(const bf16x8*)(kb_ + lo1); } while (0)
#define SWRITE(b, i) do { *(ALAS bf16x8*)(V_lds + (b) * SHM_V + vst0) = sr_[i].vs0;          \
    *(ALAS bf16x8*)(V_lds + (b) * SHM_V + vst1) = sr_[i].vs1; int kc = sc * 2;               \
    *(ALAS bf16x8*)(K_lds + (b) * SHM_K + KSWZ(sr, kc)) = sr_[i].ks0;                       \
    *(ALAS bf16x8*)(K_lds + (b) * SHM_K + KSWZ(32 + sr, kc)) = sr_[i].ks1; } while (0)
#define SWAIT() do { if constexpr (SDEPTH == 2) asm volatile("s_waitcnt vmcnt(4)" ::: "memory"); else asm volatile("s_waitcnt vmcnt(0)" ::: "memory"); } while (0)
#define RESC(a) do { if (__any((a) < 1.f)) { if (hi == 0) al_l[r32] = (a); asm volatile("s_waitcnt lgkmcnt(0)" ::: "memory"); \
    _Pragma("unroll") for (int d = 0; d < 4; ++d) _Pragma("unroll") for (int r = 0; r < 16; ++r) o[d][r] *= al_l[crow(r, hi)]; } } while (0)
#define QKT_M(P0, P1, KS, j) qkt_h<NQR>(P0, P1, KS, qr, Q_lds, qrow, r32, hi)
#define MSK(j) (((j) <= jmax) ? 0.f : -1e30f)
  f32x16 pA0, pA1, pB0, pB1; float mnA, mnB, alA, alB; bf16x8 pa0, pa1, pa2, pa3;
  constexpr int SE = 0, SO = SDEPTH - 1;
  SLOAD(SE, 0); asm volatile("s_waitcnt vmcnt(0)" ::: "memory"); SWRITE(0, SE); __syncthreads();
  QKT_M(pA0, pA1, K_lds, 0); partialSM(pA0, pA1, m_reg, mnA, alA);
  SLOAD(SO, KVBLK); if constexpr (SDEPTH == 2) { if (2 < NT) SLOAD(SE, 2 * KVBLK); }
  SWAIT(); SWRITE(1, SO); __syncthreads();
  for (int j = 1; j + 1 < NT; j += 2) {
    SBAR(); QKT_M(pB0, pB1, K_lds + SHM_K, j);
    finishSM(pA0, pA1, alA, l_reg, pa0, pa1, pa2, pa3); SBAR();
    SLOAD(SO, (j + SDEPTH) * KVBLK); SBAR();
    pv_d0(o, vb0, pa0, pa1, pa2, pa3); partialSM(pB0, pB1, m_reg, mnB, alB, MSK(j));
    __syncthreads(); SWAIT(); SWRITE(0, SE);
    RESC(alB); __syncthreads();
    SBAR(); QKT_M(pA0, pA1, K_lds, j + 1);
    finishSM(pB0, pB1, alB, l_reg, pa0, pa1, pa2, pa3); SBAR();
    if (SDEPTH == 1 || j + 3 < NT) SLOAD(SE, (j + 1 + SDEPTH) * KVBLK); SBAR();
    pv_d0(o, vb0 + SHM_V, pa0, pa1, pa2, pa3); partialSM(pA0, pA1, m_reg, mnA, alA, MSK(j + 1));
    __syncthreads(); SWAIT(); SWRITE(1, SO);
    RESC(alA); __syncthreads();
  }
  SBAR(); QKT_M(pB0, pB1, K_lds + SHM_K, NT - 1);
  finishSM(pA0, pA1, alA, l_reg, pa0, pa1, pa2, pa3); SBAR();
  pv_d0(o, vb0, pa0, pa1, pa2, pa3); partialSM(pB0, pB1, m_reg, mnB, alB, MSK(NT - 1));
  __syncthreads(); RESC(alB);
  finishSM(pB0, pB1, alB, l_reg, pa0, pa1, pa2, pa3); SBAR();
  pv_d0(o, vb0 + SHM_V, pa0, pa1, pa2, pa3);
  if (hi == 0) li_l[r32] = l_reg; asm volatile("s_waitcnt lgkmcnt(0)" ::: "memory");
  float rli[16];
#pragma unroll
  for (int r = 0; r < 16; ++r) rli[r] = __builtin_amdgcn_rcpf(li_l[crow(r, hi)]);
  float* Ow = Ob + (size_t)(wid * QBLK) * DMODEL;
#pragma unroll
  for (int r = 0; r < 16; ++r) { int orow = crow(r, hi);
#pragma unroll
    for (int d0 = 0; d0 < 4; ++d0) Ow[(size_t)orow * DMODEL + d0 * 32 + r32] = o[d0][r] * rli[r]; }
  __syncthreads();
#undef SLOAD
#undef SWRITE
#undef SWAIT
#undef QKT_M
#undef MSK
}

constexpr int X_KB = 0, X_VB = 32768, X_WS = 131072, X_LDS = X_WS + NW * 64 * 4;
__device__ __forceinline__ void attnA_prompt_unit2(int h, int qb, const bf16* __restrict__ AQ, const bf16* __restrict__ AK, const bf16* __restrict__ AV, float lam, const float* __restrict__ g_subln, float post,
                                                   bf16* __restrict__ O, ALAS char* lds) {
  int tid = threadIdx.x; asm volatile("" : "+v"(tid));
  const int wid = __builtin_amdgcn_readfirstlane(tid >> 6), lane = tid & 63, r32 = lane & 31, hi = lane >> 5;
  const int c = wid >> 2, wq = wid & 3;
  const int NT = 4 * qb + 4, jmax = 4 * qb + 2 * (wq >> 1) + 1;
  ALAS float* ws = (ALAS float*)(lds + X_WS) + wid * 64; ALAS float* li_l = ws; ALAS float* al_l = ws + 32;
  bf16x8 qr[8];
  { const bf16* Qw = AQ + (size_t)(qb * 128 + wq * 32) * HW + h * 256 + c * 128; const unsigned qo = (unsigned)(r32 * HW + hi * 8) * 2u;
#pragma unroll
    for (int d0 = 0; d0 < 8; ++d0) qr[d0] = *(const bf16x8*)((const char*)Qw + qo + d0 * 32);
#pragma unroll
    for (int d0 = 0; d0 < 8; ++d0) asm volatile("" : "+v"(qr[d0])); }
  const char* Kg = (const char*)(AK + h * 256); const char* Vg = (const char*)(AV + h * 256);
  unsigned koff, voff;
  { const int row = 4 * wid + (lane >> 4), cs = lane & 15; koff = (unsigned)(row * (HW * 2) + ((cs ^ (row & 7)) * 16));
    const int sub = 2 * wid + (lane >> 5), kk = (sub >> 2) * 8 + ((lane & 31) >> 2), k = (kk & ~0xC) | ((kk & 4) << 1) | ((kk & 8) >> 1), c8 = (sub & 3) * 4 + (lane & 3);
    voff = (unsigned)(k * (HW * 2) + c8 * 16); }
  const unsigned lds0 = (unsigned)(uintptr_t)lds;
#define X_DMA(j) do { const size_t to_ = (size_t)(j) * (32 * HW * 2); const unsigned sl_ = (unsigned)__builtin_amdgcn_readfirstlane((int)(lds0 + ((j) & 3) * 32768 + wid * 1024)); \
    glds16(Kg + to_ + koff, sl_); glds16(Kg + to_ + 256 + koff, sl_ + 8192); glds16(Vg + to_ + voff, sl_ + 16384); glds16(Vg + to_ + 256 + voff, sl_ + 24576); } while (0)
  float m_reg = -1e30f, l_reg = 0.f; f32x16 o[8] = {};
  constexpr float C = SCALE * LOG2E;
  bf16x8 pa0, pa1;
#define X_BAR() asm volatile("s_waitcnt lgkmcnt(0)\n\ts_barrier" ::: "memory")
#define X_QK(j) \
    f32x16 p = {}; \
    { const ALAS char* Ks = lds + ((j) & 3) * 32768 + c * 8192; f32x16 p2 = {}; \
      _Pragma("unroll") for (int d0 = 0; d0 < 8; d0 += 2) { const bf16x8 kf = *reinterpret_cast<const ALAS bf16x8*>(Ks + KSWZ(r32, (d0 * 16 + hi * 8) * 2)); const bf16x8 kg = *reinterpret_cast<const ALAS bf16x8*>(Ks + KSWZ(r32, ((d0 + 1) * 16 + hi * 8) * 2)); \
        p = __builtin_amdgcn_mfma_f32_32x32x16_bf16(kf, qr[d0], p, 0, 0, 0); p2 = __builtin_amdgcn_mfma_f32_32x32x16_bf16(kg, qr[d0 + 1], p2, 0, 0, 0); } \
      _Pragma("unroll") for (int r = 0; r < 16; ++r) p[r] += p2[r]; } \
    const float msk = ((j) <= jmax) ? 0.f : -1e30f; \
    float pmax = p[0]; \
    _Pragma("unroll") for (int r = 1; r < 16; ++r) pmax = fmaxf(pmax, p[r]); \
    { auto rr = __builtin_amdgcn_permlane32_swap(__float_as_uint(pmax), __float_as_uint(pmax), false, false); pmax = fmaxf(__uint_as_float(rr[0]), __uint_as_float(rr[1])) + msk; } \
    float mn, alpha; bool resc = false; \
    if (__builtin_expect(__all(pmax - m_reg <= THR / SCALE), 1)) { mn = m_reg; alpha = 1.f; } \
    else { mn = fmaxf(m_reg, pmax); alpha = __builtin_amdgcn_exp2f((m_reg - mn) * C); m_reg = mn; resc = true; } \
    const float mnC = -mn * C + msk; float ps = 0.f;
#define X_EXP2(r0) do { p[r0] = __builtin_amdgcn_exp2f(fmaf(p[r0], C, mnC)); p[(r0) + 1] = __builtin_amdgcn_exp2f(fmaf(p[(r0) + 1], C, mnC)); ps += p[r0]; ps += p[(r0) + 1]; } while (0)
#define X_FIN() do { \
    { auto rr = __builtin_amdgcn_permlane32_swap(__float_as_uint(ps), __float_as_uint(ps), false, false); ps = __uint_as_float(rr[0]) + __uint_as_float(rr[1]); } \
    l_reg = l_reg * alpha + ps; \
    if (resc) { if (hi == 0) al_l[r32] = alpha; asm volatile("s_waitcnt lgkmcnt(0)" ::: "memory"); \
      _Pragma("unroll") for (int d = 0; d < 8; ++d) _Pragma("unroll") for (int r = 0; r < 16; ++r) o[d][r] *= al_l[crow(r, hi)]; } \
    PK4(p, 0, pa0); PK4(p, 8, pa1); } while (0)
#define X_RD4(A, IMG, D0) do { A[0] = tr_read<(IMG) * 8192 + v_rd_off(D0, 0, 0)>(vb); A[1] = tr_read<(IMG) * 8192 + v_rd_off(D0, 0, 1)>(vb); A[2] = tr_read<(IMG) * 8192 + v_rd_off(D0, 1, 0)>(vb); A[3] = tr_read<(IMG) * 8192 + v_rd_off(D0, 1, 1)>(vb); } while (0)
#define X_MM2(D8, A) do { o[D8] = __builtin_amdgcn_mfma_f32_32x32x16_bf16(pa0, (bf16x8){A[0][0], A[0][1], A[0][2], A[0][3], A[1][0], A[1][1], A[1][2], A[1][3]}, o[D8], 0, 0, 0); \
        o[D8] = __builtin_amdgcn_mfma_f32_32x32x16_bf16(pa1, (bf16x8){A[2][0], A[2][1], A[2][2], A[2][3], A[3][0], A[3][1], A[3][2], A[3][3]}, o[D8], 0, 0, 0); } while (0)
#define X_W(n) do { asm volatile("s_waitcnt lgkmcnt(" #n ")" ::: "memory"); SBAR(); } while (0)
  X_DMA(0); X_DMA(1);
  {
    asm volatile("s_waitcnt vmcnt(4)" ::: "memory"); X_BAR(); X_DMA(2);
    X_QK(0)
    X_EXP2(0); X_EXP2(2); X_EXP2(4); X_EXP2(6); X_EXP2(8); X_EXP2(10); X_EXP2(12); X_EXP2(14);
    X_FIN(); }
  for (int j = 1; j < NT; ++j) {
    if (j + 1 < NT) asm volatile("s_waitcnt vmcnt(4)" ::: "memory"); else asm volatile("s_waitcnt vmcnt(0)" ::: "memory");
    X_BAR();
    if (j + 2 < NT) X_DMA(j + 2);
    X_QK(j)
    SBAR();
    { const int vb = (int)(unsigned)(uintptr_t)(lds + ((j - 1) & 3) * 32768 + 16384) + v_rd_base(lane);
      s16x4 va[4], vc[4];
      X_RD4(va, 0, 0); X_RD4(vc, 0, 1); X_W(4); X_MM2(0, va); X_EXP2(0); SBAR();
      X_RD4(va, 0, 2); X_W(4); X_MM2(1, vc); X_EXP2(2); SBAR();
      X_RD4(vc, 0, 3); X_W(4); X_MM2(2, va); X_EXP2(4); SBAR();
      X_RD4(va, 1, 0); X_W(4); X_MM2(3, vc); X_EXP2(6); SBAR();
      X_RD4(vc, 1, 1); X_W(4); X_MM2(4, va); X_EXP2(8); SBAR();
      X_RD4(va, 1, 2); X_W(4); X_MM2(5, vc); X_EXP2(10); SBAR();
      X_RD4(vc, 1, 3); X_W(4); X_MM2(6, va); X_EXP2(12); SBAR();
      X_W(0); X_MM2(7, vc); X_EXP2(14); SBAR(); }
    X_FIN();
  }
  {
    const int vb = (int)(unsigned)(uintptr_t)(lds + ((NT - 1) & 3) * 32768 + 16384) + v_rd_base(lane);
    s16x4 va[4], vc[4];
    X_RD4(va, 0, 0); X_RD4(vc, 0, 1); X_W(4); X_MM2(0, va); SBAR();
    X_RD4(va, 0, 2); X_W(4); X_MM2(1, vc); SBAR();
    X_RD4(vc, 0, 3); X_W(4); X_MM2(2, va); SBAR();
    X_RD4(va, 1, 0); X_W(4); X_MM2(3, vc); SBAR();
    X_RD4(vc, 1, 1); X_W(4); X_MM2(4, va); SBAR();
    X_RD4(va, 1, 2); X_W(4); X_MM2(5, vc); SBAR();
    X_RD4(vc, 1, 3); X_W(4); X_MM2(6, va); SBAR();
    X_W(0); X_MM2(7, vc); SBAR(); }
#undef X_BAR
#undef X_QK
#undef X_EXP2
#undef X_FIN
#undef X_RD4
#undef X_MM2
#undef X_W
  __syncthreads();
  if (hi == 0) li_l[r32] = l_reg; asm volatile("s_waitcnt lgkmcnt(0)" ::: "memory");
  float rli[16];
#pragma unroll
  for (int r = 0; r < 16; ++r) rli[r] = __builtin_amdgcn_rcpf(li_l[crow(r, hi)]);
  ALAS float* XL = (ALAS float*)(lds) + wq * 8192;
  if (c == 1) {
#pragma unroll
    for (int r = 0; r < 16; ++r) { const float f = rli[r] * lam;
#pragma unroll
      for (int d = 0; d < 8; ++d) XL[crow(r, hi) * 256 + d * 32 + r32] = o[d][r] * f; }
  }
  __syncthreads();
  if (c == 0) {
    float gs[8];
#pragma unroll
    for (int d = 0; d < 8; ++d) gs[d] = g_subln[d * 32 + r32] * post;
#pragma unroll
    for (int r = 0; r < 16; ++r) { const int q = crow(r, hi); float ss = 0.f;
#pragma unroll
      for (int d = 0; d < 8; ++d) { const float v = o[d][r] * rli[r] - XL[q * 256 + d * 32 + r32]; o[d][r] = v; ss += v * v; }
#pragma unroll
      for (int m = 1; m < 32; m <<= 1) ss += __shfl_xor(ss, m);
      const float rs = __builtin_amdgcn_rsqf(ss * (1.0f / 256.0f) + EPS);
#pragma unroll
      for (int d = 0; d < 8; ++d) o[d][r] *= rs * gs[d]; }
    asm volatile("s_waitcnt lgkmcnt(0)" ::: "memory");
    ALAS bf16* stg = (ALAS bf16*)XL;
#pragma unroll
    for (int r = 0; r < 16; ++r) { const int q = crow(r, hi);
#pragma unroll
      for (int d = 0; d < 8; ++d) stg[q * 256 + d * 32 + r32] = (bf16)(cvtpk(o[d][r], 0.f) & 0xffffu); }
    asm volatile("s_waitcnt lgkmcnt(0)" ::: "memory");
    bf16* Ow = O + (size_t)(qb * 128 + wq * 32) * DMODEL + h * 256;
#pragma unroll
    for (int i = 0; i < 16; ++i) { const int id = i * 64 + lane, row = id >> 5, ch = id & 31; const u32x4 v = *(const ALAS u32x4*)(stg + row * 256 + ch * 8); *(u32x4*)(Ow + (size_t)row * DMODEL + ch * 8) = v; }
    asm volatile("s_waitcnt lgkmcnt(0)" ::: "memory");
  }
  __syncthreads();
#undef X_DMA
}

constexpr int SA_KB = 0, SA_VB = 65536, SA_WS = 131072, SA_LDS = SA_WS + NW * 64 * 4;
__device__ __forceinline__ void attnA_sample_unit(int b, int h, const float* __restrict__ cak, const float* __restrict__ cav, const float* __restrict__ nak, const float* __restrict__ nav,
                                                  const bf16* __restrict__ AQ, float lam, const float* __restrict__ g_subln, float post, bf16* __restrict__ O, ALAS char* lds) {
  int tid = threadIdx.x; asm volatile("" : "+v"(tid));
  const int wid = __builtin_amdgcn_readfirstlane(tid >> 6), lane = tid & 63, r32 = lane & 31, hi = lane >> 5;
  const int c = wid & 1, vq = wid >> 1;
  ALAS float* ws = (ALAS float*)(lds + SA_WS) + wid * 64; ALAS float* li_l = ws; ALAS float* al_l = ws + 32;
  bf16x8 qr[8];
  { const bf16* Qw = AQ + (size_t)(TP + b * 16 + (r32 & 15)) * HW + h * 256 + c * 128 + hi * 8;
#pragma unroll
    for (int d0 = 0; d0 < 8; ++d0) qr[d0] = ld8bf(Qw + d0 * 16); }
  const int sr = tid >> 3, sk = (tid & 7) * 16, sv = (tid & 7) * 32;
  f32x8 kreg[4], vreg[4];
#define SA_LOAD(j) do { if ((j) < 32) { const size_t ro = ((size_t)(b * 2048 + (j) * 64 + sr) * 8 + h) * 256; \
      kreg[0] = ld8f(cak + ro + sk); kreg[1] = ld8f(cak + ro + sk + 8); kreg[2] = ld8f(cak + ro + 128 + sk); kreg[3] = ld8f(cak + ro + 128 + sk + 8); \
      vreg[0] = ld8f(cav + ro + sv); vreg[1] = ld8f(cav + ro + sv + 8); vreg[2] = ld8f(cav + ro + sv + 16); vreg[3] = ld8f(cav + ro + sv + 24); } \
    else if (sr < 16) { const size_t ro = ((size_t)(b * 16 + sr) * 8 + h) * 256; \
      kreg[0] = ld8f(nak + ro + sk); kreg[1] = ld8f(nak + ro + sk + 8); kreg[2] = ld8f(nak + ro + 128 + sk); kreg[3] = ld8f(nak + ro + 128 + sk + 8); \
      vreg[0] = ld8f(nav + ro + sv); vreg[1] = ld8f(nav + ro + sv + 8); vreg[2] = ld8f(nav + ro + sv + 16); vreg[3] = ld8f(nav + ro + sv + 24); } \
    else { _Pragma("unroll") for (int i_ = 0; i_ < 4; ++i_) { kreg[i_] = f32x8{}; vreg[i_] = f32x8{}; } } } while (0)
#define SA_WRITE(buf) do { ALAS char* kb_ = lds + SA_KB + (buf) * 32768; ALAS char* vb_ = lds + SA_VB + (buf) * 32768 + (sv >> 7) * 16384; const int cv_ = sv & 127; \
    *(ALAS bf16x8*)(kb_ + KSWZ(sr, sk * 2)) = tobf(kreg[0]); *(ALAS bf16x8*)(kb_ + KSWZ(sr, (sk + 8) * 2)) = tobf(kreg[1]); \
    *(ALAS bf16x8*)(kb_ + 16384 + KSWZ(sr, sk * 2)) = tobf(kreg[2]); *(ALAS bf16x8*)(kb_ + 16384 + KSWZ(sr, (sk + 8) * 2)) = tobf(kreg[3]); \
    *(ALAS bf16x8*)(vb_ + v_st(sr, cv_)) = tobf(vreg[0]); *(ALAS bf16x8*)(vb_ + v_st(sr, cv_ + 8)) = tobf(vreg[1]); \
    *(ALAS bf16x8*)(vb_ + v_st(sr, cv_ + 16)) = tobf(vreg[2]); *(ALAS bf16x8*)(vb_ + v_st(sr, cv_ + 24)) = tobf(vreg[3]); } while (0)
  float m_reg = -1e30f, l_reg = 0.f; f32x16 o[2] = {};
  SA_LOAD(0); asm volatile("s_waitcnt vmcnt(0)" ::: "memory"); SA_WRITE(0); __syncthreads();
  for (int j = 0; j <= 32; ++j) {
    const int buf = j & 1;
    if (j < 32) SA_LOAD(j + 1);
    f32x16 p0, p1; float mn, alpha; bf16x8 pa0, pa1, pa2, pa3;
    qkt(p0, p1, lds + SA_KB + buf * 32768 + c * 16384, qr, r32, hi);
    if (j == 32) {
#pragma unroll
      for (int r = 0; r < 16; ++r) { if (crow(r, hi) >= 16) p0[r] = -1e30f; p1[r] = -1e30f; }
    }
    partialSM(p0, p1, m_reg, mn, alpha);
    if (__any(alpha < 1.f)) { if (hi == 0) al_l[r32] = alpha; asm volatile("s_waitcnt lgkmcnt(0)" ::: "memory");
#pragma unroll
      for (int d = 0; d < 2; ++d)
#pragma unroll
        for (int r = 0; r < 16; ++r) o[d][r] *= al_l[crow(r, hi)]; }
    finishSM(p0, p1, alpha, l_reg, pa0, pa1, pa2, pa3); SBAR();
    const int vb = (int)(unsigned)(uintptr_t)(lds + SA_VB + buf * 32768 + (vq >> 1) * 16384) + v_rd_base(lane);
    if (vq & 1) { pv_one<2>(o[0], vb, pa0, pa1, pa2, pa3); pv_one<3>(o[1], vb, pa0, pa1, pa2, pa3); }
    else        { pv_one<0>(o[0], vb, pa0, pa1, pa2, pa3); pv_one<1>(o[1], vb, pa0, pa1, pa2, pa3); }
    if (j < 32) { asm volatile("s_waitcnt vmcnt(0)" ::: "memory"); SA_WRITE(buf ^ 1); }
    __syncthreads();
  }
  if (hi == 0) li_l[r32] = l_reg; asm volatile("s_waitcnt lgkmcnt(0)" ::: "memory");
  ALAS float* OL = (ALAS float*)(lds + SA_KB);
#pragma unroll
  for (int r = 0; r < 8; ++r) { const int q = crow(r, hi); const float rl = __builtin_amdgcn_rcpf(li_l[q]);
#pragma unroll
    for (int dd = 0; dd < 2; ++dd) OL[(c * 16 + q) * 256 + vq * 64 + dd * 32 + r32] = o[dd][r] * rl; }
  __syncthreads();
  { const int q = tid >> 5, e0 = (tid & 31) * 8; float dv[8]; float ss = 0.f;
#pragma unroll
    for (int i = 0; i < 8; ++i) { dv[i] = OL[q * 256 + e0 + i] - lam * OL[(16 + q) * 256 + e0 + i]; ss += dv[i] * dv[i]; }
#pragma unroll
    for (int m = 1; m < 32; m <<= 1) ss += __shfl_xor(ss, m);
    const float rs = __builtin_amdgcn_rsqf(ss * (1.0f / 256.0f) + EPS) * post;
    u32x4 w; w.x = cvtpk(dv[0] * rs * g_subln[e0 + 0], dv[1] * rs * g_subln[e0 + 1]); w.y = cvtpk(dv[2] * rs * g_subln[e0 + 2], dv[3] * rs * g_subln[e0 + 3]);
    w.z = cvtpk(dv[4] * rs * g_subln[e0 + 4], dv[5] * rs * g_subln[e0 + 5]); w.w = cvtpk(dv[6] * rs * g_subln[e0 + 6], dv[7] * rs * g_subln[e0 + 7]);
    *(u32x4*)(O + (size_t)(TP + b * 16 + q) * DMODEL + h * 256 + e0) = w; }
  __syncthreads();
#undef SA_LOAD
#undef SA_WRITE
}

constexpr float SB_STOP = -104.0f;
__device__ __forceinline__ float softplus_f(float z) {
  const float e = __builtin_amdgcn_exp2f(-fabsf(z) * LOG2E);
  return fmaxf(z, 0.f) + LN2 * __builtin_amdgcn_logf(1.0f + e);
}
__device__ __forceinline__ void stick_half(f32x16& p, float& carry, int kbase, int kpos0, int qpos, int nvalid, bool need_mask, int hi) {
  float x[16];
#pragma unroll
  for (int r = 0; r < 16; ++r) {
    const float z = p[r] * SCALE; const float sp = softplus_f(z);
    bool ok = true;
    if (need_mask) { const int kl = kbase + crow(r, hi); ok = (kpos0 + kl < qpos) && (kl < nvalid); }
    x[r] = ok ? -sp : 0.f;
    p[r] = ok ? z - sp : -1e30f;
    if ((r & 3) == 3) SBAR();
  }
  float own[4], par[4], T[4], R[4];
#pragma unroll
  for (int g = 0; g < 4; ++g) { own[g] = (x[4 * g] + x[4 * g + 1]) + (x[4 * g + 2] + x[4 * g + 3]); par[g] = swap32(own[g], hi); T[g] = own[g] + par[g]; }
  R[3] = 0.f; R[2] = T[3]; R[1] = R[2] + T[2]; R[0] = R[1] + T[1];
#pragma unroll
  for (int g = 0; g < 4; ++g) {
    const float E = carry + R[g] + (hi == 0 ? par[g] : 0.f);
    const float w2 = x[4 * g + 3], w1 = w2 + x[4 * g + 2], w0 = w1 + x[4 * g + 1];
    p[4 * g + 3] = __builtin_amdgcn_exp2f((p[4 * g + 3] + E) * LOG2E); p[4 * g + 2] = __builtin_amdgcn_exp2f((p[4 * g + 2] + E + w2) * LOG2E);
    p[4 * g + 1] = __builtin_amdgcn_exp2f((p[4 * g + 1] + E + w1) * LOG2E); p[4 * g + 0] = __builtin_amdgcn_exp2f((p[4 * g + 0] + E + w0) * LOG2E);
    SBAR();
  }
  carry += R[0] + T[0];
}
template <typename TS>
__device__ __forceinline__ void stick_tile(f32x16 (&o)[4], float& carry, const bf16* __restrict__ Qw, const TS* __restrict__ Kt, const TS* __restrict__ Vt, int stride, int nvalid, int kpos0, int qpos,
                                           bool need_mask, ALAS char* vbuf, int lane, int r32, int hi) {
  constexpr bool SRC16 = sizeof(TS) == 2;
  f32x16 p0 = {}, p1 = {};
  { const int k0 = r32 < nvalid ? r32 : nvalid - 1, k1 = (32 + r32) < nvalid ? (32 + r32) : nvalid - 1;
    const TS* K0 = Kt + (size_t)k0 * stride + hi * 8; const TS* K1 = Kt + (size_t)k1 * stride + hi * 8;
    bf16x8 kf0[8], kf1[8], qr[8];
#pragma unroll
    for (int d0 = 0; d0 < 8; ++d0) qr[d0] = ld8bf(Qw + d0 * 16);
#pragma unroll
    for (int d0 = 0; d0 < 8; ++d0) kf0[d0] = ld8any(K0 + d0 * 16);
    if constexpr (SRC16) {
#pragma unroll
      for (int d0 = 0; d0 < 8; ++d0) kf1[d0] = ld8any(K1 + d0 * 16);
    }
#pragma unroll
    for (int d0 = 0; d0 < 8; ++d0) p0 = __builtin_amdgcn_mfma_f32_32x32x16_bf16(kf0[d0], qr[d0], p0, 0, 0, 0);
    if constexpr (!SRC16) {
      asm volatile("" ::: "memory");
#pragma unroll
      for (int d0 = 0; d0 < 8; ++d0) kf1[d0] = ld8any(K1 + d0 * 16);
    }
#pragma unroll
    for (int d0 = 0; d0 < 8; ++d0) p1 = __builtin_amdgcn_mfma_f32_32x32x16_bf16(kf1[d0], qr[d0], p1, 0, 0, 0);
  }
  asm volatile("" ::: "memory"); SBAR();
  const unsigned vsrc_off = (unsigned)(((lane >> 4) * stride + (lane & 15) * 8) * (int)sizeof(TS));
  const int vdst_off = (((lane & 15) * 8) >> 5) * 512 + ((lane >> 4) * 32 + (((lane & 15) * 8) & 31)) * 2;
  const int nvc = nvalid >> 2;
#define VSRC(i) ((const char*)Vt + (size_t)(((i) < nvc ? (i) : nvc - 1) * 4) * stride * sizeof(TS) + vsrc_off)
#define VDST(i) (vbuf + vdst_off + ((((i) & 1) + 2 * ((i) >> 2)) * 2048 + (((i) >> 1) & 1) * 256))
  bf16x8 vtb[16]; f32x8 vtf[4];
  if constexpr (SRC16) {
#pragma unroll
    for (int i = 0; i < 16; ++i) vtb[i] = *(const bf16x8*)VSRC(i);
  } else {
#pragma unroll
    for (int i = 0; i < 4; ++i) vtf[i] = *(const f32x8*)VSRC(i);
  }
  SBAR();
  bf16x8 pa0, pa1, pa2, pa3;
  stick_half(p1, carry, 32, kpos0, qpos, nvalid, need_mask, hi);
  PK4(p1, 0, pa2); PK4(p1, 8, pa3);
  stick_half(p0, carry, 0, kpos0, qpos, nvalid, need_mask, hi);
  PK4(p0, 0, pa0); PK4(p0, 8, pa1);
  if constexpr (SRC16) {
#pragma unroll
    for (int i = 0; i < 16; ++i) *(ALAS bf16x8*)VDST(i) = vtb[i];
  } else {
#pragma unroll
    for (int i = 0; i < 4; ++i) *(ALAS bf16x8*)VDST(i) = tobf(vtf[i]);
#pragma unroll
    for (int bt = 1; bt < 4; ++bt) {
#pragma unroll
      for (int i = 0; i < 4; ++i) vtf[i] = *(const f32x8*)VSRC(4 * bt + i);
#pragma unroll
      for (int i = 0; i < 4; ++i) *(ALAS bf16x8*)VDST(4 * bt + i) = tobf(vtf[i]);
    }
  }
#undef VSRC
#undef VDST
  asm volatile("s_waitcnt lgkmcnt(0)" ::: "memory"); SBAR();
  const int vb = (int)(unsigned)(uintptr_t)vbuf + v_rd_base(lane);
  pv_d0(o, vb, pa0, pa1, pa2, pa3);
}
__device__ __forceinline__ void stick_store(const f32x16 (&o)[4], const float* __restrict__ g_sb, bf16* __restrict__ Orow0, int nrows, ALAS char* vbuf, int lane, int r32, int hi) {
  float gs[4];
#pragma unroll
  for (int d0 = 0; d0 < 4; ++d0) gs[d0] = g_sb[d0 * 32 + r32];
  ALAS bf16* stg = (ALAS bf16*)vbuf;
#pragma unroll
  for (int r = 0; r < 16; ++r) {
    float ss = (o[0][r] * o[0][r] + o[1][r] * o[1][r]) + (o[2][r] * o[2][r] + o[3][r] * o[3][r]);
#pragma unroll
    for (int m = 1; m < 32; m <<= 1) ss += __shfl_xor(ss, m);
    const float rs = __builtin_amdgcn_rsqf(ss * (1.0f / 128.0f) + EPS);
    const int q = crow(r, hi);
#pragma unroll
    for (int d0 = 0; d0 < 4; ++d0) stg[q * 128 + d0 * 32 + r32] = (bf16)(cvtpk(o[d0][r] * rs * gs[d0], 0.f) & 0xffffu);
  }
  asm volatile("s_waitcnt lgkmcnt(0)" ::: "memory");
#pragma unroll
  for (int i = 0; i < 8; ++i) { const int id = i * 64 + lane, row = id >> 4, ch = id & 15;
    if (row < nrows) { const u32x4 v = *(const ALAS u32x4*)(stg + row * 128 + ch * 8); *(u32x4*)(Orow0 + (size_t)row * DMODEL + ch * 8) = v; } }
  asm volatile("s_waitcnt lgkmcnt(0)" ::: "memory");
}
__device__ __forceinline__ void stick_prompt_unit(int h, int qt, const bf16* __restrict__ BQ, const bf16* __restrict__ BK, const bf16* __restrict__ BV, const float* __restrict__ g_sb, bf16* __restrict__ O, ALAS char* vbuf) {
  int lane = threadIdx.x & 63; asm volatile("" : "+v"(lane)); const int r32 = lane & 31, hi = lane >> 5; const int t0 = 32 * qt;
  const bf16* Qw = BQ + (size_t)(t0 + r32) * HW + h * 128 + hi * 8;
  f32x16 o[4] = {}; float carry = 0.f; const int qpos = t0 + r32; const int jd = t0 >> 6;
  for (int j = jd; j >= 0; --j) {
    stick_tile<bf16>(o, carry, Qw, BK + (size_t)(64 * j) * HW + h * 128, BV + (size_t)(64 * j) * HW + h * 128, HW, 64, 64 * j, qpos, j == jd, vbuf, lane, r32, hi);
    if (__all(carry < SB_STOP)) break;
  }
  stick_store(o, g_sb, O + (size_t)t0 * DMODEL + 2048 + h * 128, 32, vbuf, lane, r32, hi);
}
__device__ __forceinline__ void stick_sample_unit(int b, int h, const bf16* __restrict__ BQ, const bf16* __restrict__ BK, const bf16* __restrict__ BV, const float* __restrict__ cbk, const float* __restrict__ cbv,
                                                  const float* __restrict__ g_sb, bf16* __restrict__ O, ALAS char* vbuf) {
  int lane = threadIdx.x & 63; asm volatile("" : "+v"(lane)); const int r32 = lane & 31, hi = lane >> 5; const size_t row0 = (size_t)TP + b * 16;
  const bf16* Qw = BQ + (row0 + (r32 & 15)) * HW + h * 128 + hi * 8;
  f32x16 o[4] = {}; float carry = 0.f; const int qpos = 2048 + (r32 & 15);
  stick_tile<bf16>(o, carry, Qw, BK + row0 * HW + h * 128, BV + row0 * HW + h * 128, HW, 16, 2048, qpos, true, vbuf, lane, r32, hi);
  for (int j = 31; j >= 0; --j) {
    if (__all(carry < SB_STOP)) break;
    const size_t ro = ((size_t)(b * 2048 + 64 * j) * 16 + h) * 128;
    stick_tile<float>(o, carry, Qw, cbk + ro, cbv + ro, 2048, 64, 64 * j, qpos, false, vbuf, lane, r32, hi);
  }
  stick_store(o, g_sb, O + row0 * DMODEL + 2048 + h * 128, 16, vbuf, lane, r32, hi);
}
#undef PK4
#undef SBAR
#undef RESC
}
namespace sk {
#define SLAS __attribute__((address_space(3)))
typedef unsigned short bf16;
using bf16x8 = __attribute__((ext_vector_type(8))) short;
using f32x16 = __attribute__((ext_vector_type(16))) float;
constexpr int SLOT = 40960, A_BYTES = 32768;
__device__ __forceinline__ int crow(int r, int hi) { return (r & 3) + 8 * (r >> 2) + 4 * hi; }
__device__ __forceinline__ void glds16(const void* gsrc, unsigned lds_dst) { unsigned keep;
  asm volatile("s_mov_b32 %0, m0\n\ts_mov_b32 m0, %2\n\ts_nop 0\n\tglobal_load_lds_dwordx4 %1, off\n\ts_mov_b32 m0, %0" : "=&s"(keep) : "v"(gsrc), "s"(lds_dst) : "memory"); }
struct Item { int t; int kt0; int nkt; int ks; };
template <class Epi>
__device__ __forceinline__ void skinny_item(const Item it, const bf16* __restrict__ A, int lda, const bf16* __restrict__ Wt, int KT  , const Epi& E, SLAS char* lds) {
  int tid = threadIdx.x; asm volatile("" : "+v"(tid));
  const int wid = __builtin_amdgcn_readfirstlane(tid >> 6), lane = tid & 63, r32 = lane & 31, hi = lane >> 5;
  const int arow0 = 32 * wid + (lane >> 3), cs = lane & 7;
  unsigned aoff[4];
#pragma unroll
  for (int q = 0; q < 4; ++q) { const int row = arow0 + 8 * q; aoff[q] = (unsigned)row * (unsigned)(lda * 2) + (unsigned)((cs ^ ((row >> 1) & 7)) * 16); }
  const int brow = 8 * wid + (lane >> 3); const unsigned boff = (unsigned)(brow * 128 + ((cs ^ ((brow >> 1) & 7)) * 16));
  const char* Ag = (const char*)A + (size_t)it.kt0 * 128;
  const char* Wg = (const char*)Wt + ((size_t)(it.t >> 2) * KT + it.kt0) * 32768 + (size_t)(it.t & 3) * 8192;
  const unsigned lds0 = (unsigned)(uintptr_t)lds;
#define SK_DMA(kt, slot) do { const unsigned sl_ = (unsigned)__builtin_amdgcn_readfirstlane((int)(lds0 + (slot) * SLOT)); const char* ag_ = Ag + (size_t)(kt) * 128; \
    glds16(ag_ + aoff[0], sl_ + (unsigned)(wid * 4096)); glds16(ag_ + aoff[1], sl_ + (unsigned)(wid * 4096 + 1024)); glds16(ag_ + aoff[2], sl_ + (unsigned)(wid * 4096 + 2048)); glds16(ag_ + aoff[3], sl_ + (unsigned)(wid * 4096 + 3072)); \
    glds16(Wg + (size_t)(kt) * 32768 + boff, sl_ + (unsigned)(A_BYTES + wid * 1024)); } while (0)
  const int ar = 32 * wid + r32, asw = (ar >> 1) & 7, b0sw = (r32 >> 1) & 7, b1sw = ((32 + r32) >> 1) & 7;
  f32x16 acc[2] = {};
  const int nkt = it.nkt;
  SK_DMA(0, 0); if (nkt > 1) SK_DMA(1, 1);
  int slot = 0, slot2 = 2;
  for (int kt = 0; kt < nkt; ++kt) {
    if (kt + 1 < nkt) asm volatile("s_waitcnt vmcnt(5)" ::: "memory"); else asm volatile("s_waitcnt vmcnt(0)" ::: "memory");
    asm volatile("s_waitcnt lgkmcnt(0)\n\ts_barrier" ::: "memory");
    if (kt + 2 < nkt) SK_DMA(kt + 2, slot2);
    const SLAS char* sa = lds + slot * SLOT + ar * 128; const SLAS char* sb = lds + slot * SLOT + A_BYTES;
#pragma unroll
    for (int s = 0; s < 4; ++s) { const int c = 2 * s + hi;
      const bf16x8 a = *reinterpret_cast<const SLAS bf16x8*>(sa + ((c ^ asw) * 16));
      const bf16x8 w0 = *reinterpret_cast<const SLAS bf16x8*>(sb + r32 * 128 + ((c ^ b0sw) * 16));
      const bf16x8 w1 = *reinterpret_cast<const SLAS bf16x8*>(sb + (32 + r32) * 128 + ((c ^ b1sw) * 16));
      acc[0] = __builtin_amdgcn_mfma_f32_32x32x16_bf16(a, w0, acc[0], 0, 0, 0);
      acc[1] = __builtin_amdgcn_mfma_f32_32x32x16_bf16(a, w1, acc[1], 0, 0, 0); }
    slot = (slot == 2) ? 0 : slot + 1; slot2 = (slot2 == 2) ? 0 : slot2 + 1;
  }
#undef SK_DMA
  E(acc, it, wid, r32, hi);
  asm volatile("s_waitcnt lgkmcnt(0)" ::: "memory"); __syncthreads();
}
#undef SLAS
}
constexpr int NWAVES = 8;
#ifndef MK_N_LAUNCHES
#define MK_N_LAUNCHES 1
#endif
constexpr int N_PHASES = 8;
constexpr int N_LAUNCHES = MK_N_LAUNCHES;
static_assert(N_LAUNCHES == 1 || N_LAUNCHES == N_PHASES, "MK_N_LAUNCHES is 1 or 8");

constexpr int DM = 4096, TP = 8192, TS = 256, MROWS = TP + TS, HW = 2048, NIN = 6 * HW, DFF = 16384;
constexpr int DEC_B = 16, DEC_T = 16, PAST = 2048, A_HEADS = 8, B_HEADS = 16;
constexpr float EPS = 1e-6f, LAM_INIT = 0.2f;
constexpr size_t OUT_Y = 0;
constexpr size_t OUT_KVP = (size_t)MROWS * DM;
constexpr size_t OUT_KVS = OUT_KVP + 4 * (size_t)TP * HW;
constexpr size_t OUT_TOTAL = OUT_KVS + 4 * (size_t)TS * HW;
static_assert(OUT_TOTAL == 103809024ull, "output size");
constexpr size_t MiB = 1u << 20;
constexpr size_t WS_CTL = 0, CTL_ZERO_BYTES = 1 * MiB;
constexpr size_t WS_ROPE = 2 * MiB;
constexpr size_t WS_WIN = 4 * MiB;
constexpr size_t WS_WOUT = WS_WIN + 96 * MiB;
constexpr size_t WS_WUP = WS_WOUT + 32 * MiB;
constexpr size_t WS_WDOWN = WS_WUP + 128 * MiB;
constexpr size_t WS_H0 = WS_WDOWN + 128 * MiB;
constexpr size_t WS_QKV = WS_H0 + 66 * MiB;
constexpr size_t WS_OA = WS_QKV + 198 * MiB;
constexpr size_t WS_O = WS_OA + 128 * MiB;
constexpr size_t WS_X1 = WS_O + 66 * MiB;
constexpr size_t WS_X1S = WS_X1 + 66 * MiB, WS_X2B = WS_OA;
constexpr size_t WS_H1 = WS_X1 + 132 * MiB;
constexpr size_t WS_U = WS_H1 + 66 * MiB;
constexpr size_t WS_PART1 = WS_U + 264 * MiB;
constexpr size_t WS_PART2 = WS_PART1 + 48 * MiB;
constexpr size_t WS_PART3 = WS_PART2 + 32 * MiB;
constexpr size_t WS_PART4 = WS_PART3 + 64 * MiB;
constexpr size_t WS_END = WS_PART4 + 64 * MiB;
#ifndef WGMS
#define WGMS 4, 4, 4, 4
#endif
constexpr int WGM_TAB[4] = {WGMS}; constexpr int WGM_P1 = WGM_TAB[0], WGM_P4 = WGM_TAB[1], WGM_P5 = WGM_TAB[2], WGM_P6 = WGM_TAB[3];
constexpr int SPL2 = 4, SPL4 = 4;
static_assert((size_t)MROWS * DM * 2 <= 66 * MiB && (size_t)MROWS * HW * 2 * 6 <= 198 * MiB && (size_t)MROWS * DM * 4 <= 132 * MiB && (size_t)MROWS * DFF * 2 <= 264 * MiB, "ws map");
constexpr int CW_TMO = 0, CW_CODE = 1;
constexpr int CW_BAR = 4096;
constexpr int CW_BQ = 8192, CW_AQ = 8704;
constexpr int CW_SSQ1 = 16384, CW_SSQ2 = 32768;
static_assert((CW_SSQ2 + MROWS) * 4 <= (int)CTL_ZERO_BYTES, "CTL words inside the memset region");
constexpr int RING_OFF = 0, RING_BYTES = 135168;
constexpr int LDSCTL_OFF = RING_BYTES, MISC_OFF = LDSCTL_OFF + 320;
constexpr int LDS_BYTES = 147456;
static_assert(MISC_OFF + 128 <= LDS_BYTES && 8 * 64 * 65 * 4 <= RING_BYTES && att::SA_LDS <= RING_BYTES && att::X_LDS <= RING_BYTES, "LDS map");

#define GAS __attribute__((address_space(1)))
#define LAS __attribute__((address_space(3)))
typedef unsigned short bf16;
typedef unsigned v4u __attribute__((ext_vector_type(4)));
typedef float f32x4 __attribute__((ext_vector_type(4)));
typedef short bf16x8 __attribute__((ext_vector_type(8)));
typedef GAS unsigned gu32;
typedef GAS unsigned long long gu64;
#define RLX_AGENT __ATOMIC_RELAXED, __HIP_MEMORY_SCOPE_AGENT
#define LDS_WAIT() asm volatile("s_waitcnt lgkmcnt(0)" ::: "memory")
#define VM_WAIT() asm volatile("s_waitcnt vmcnt(0)" ::: "memory")
__device__ __forceinline__ unsigned long long rt() { return __builtin_amdgcn_s_memrealtime(); }
__device__ __forceinline__ unsigned f2bf(float f) { unsigned u = __builtin_bit_cast(unsigned, f); return (u + 0x7fffu + ((u >> 16) & 1u)) >> 16; }
__device__ __forceinline__ unsigned pk2(float lo, float hi) { return f2bf(lo) | (f2bf(hi) << 16); }

#define XB_TMO      128
#define XB_XCNT(j)  (256  + 64 * (j))
#define XB_XSUB(j)  (1280 + 64 * (j))
#define XB_XGEN(j)  (2304 + 64 * (j))
#define XB_TOP      3328
#define XB_TOPGEN   3392
#define XCD_BAR_WORDS 3456
#define XB_SPIN_CAP (1u << 18)

__device__ __forceinline__ unsigned xb_ld(unsigned* p)              { return __hip_atomic_load(p, __ATOMIC_RELAXED, __HIP_MEMORY_SCOPE_AGENT); }
__device__ __forceinline__ unsigned xb_add(unsigned* p, unsigned v) { return __hip_atomic_fetch_add(p, v, __ATOMIC_RELAXED, __HIP_MEMORY_SCOPE_AGENT); }
__device__ __forceinline__ unsigned xb_xcc_id() { return (unsigned)__builtin_amdgcn_s_getreg((3 << 11) | 20) & 0xFu; }
#define XB_SPIN(cond, bar) do { unsigned _sp = 0; while (cond) { __builtin_amdgcn_s_sleep(1); \
    if ((++_sp & 255u) == 0u) { if (xb_ld(&(bar)[XB_TMO])) break; if (_sp > XB_SPIN_CAP) { atomicAdd(&(bar)[XB_TMO], 1u); break; } } } } while (0)

struct XcdBarrier {
    unsigned* bar; unsigned x;
    volatile LAS unsigned* st;
};

__device__ __forceinline__ XcdBarrier xcd_barrier_post(unsigned* bar, volatile LAS unsigned* st) {
    XcdBarrier b; b.bar = bar; b.x = xb_xcc_id(); b.st = st;
    if (threadIdx.x == 0) (void)xb_add(&bar[XB_XCNT(b.x)], 1u);
    return b;
}
__device__ __forceinline__ void xcd_barrier_complete(unsigned* bar, unsigned x, unsigned& nloc, unsigned& nx) {
    const unsigned G = gridDim.x * gridDim.y * gridDim.z;
    unsigned sum, cnt, mine, sp = 0u;
    for (;;) {
        sum = 0u; cnt = 0u; mine = 0u;
#pragma unroll
        for (unsigned j = 0; j < 16; ++j) { const unsigned c = xb_ld(&bar[XB_XCNT(j)]); sum += c; cnt += (c > 0u) ? 1u : 0u; mine = (j == x) ? c : mine; }
        if (sum == G) break;
        __builtin_amdgcn_s_sleep(1);
        if ((++sp & 255u) == 0u) { if (xb_ld(&bar[XB_TMO])) break; if (sp > XB_SPIN_CAP) { atomicAdd(&bar[XB_TMO], 1u); break; } }
    }
    nloc = mine > 0u ? mine : 1u; nx = cnt > 0u ? cnt : 1u;
}

__device__ __forceinline__ void xcd_barrier(const XcdBarrier& b) {
    asm volatile("s_waitcnt vmcnt(0)" ::: "memory");
    __syncthreads();
    if (threadIdx.x == 0) {
        unsigned* bar = b.bar;
        __builtin_amdgcn_s_waitcnt(0);
        unsigned nloc = b.st[0], nx = b.st[1];
        if (nloc == 0u) { xcd_barrier_complete(bar, b.x, nloc, nx); b.st[0] = nloc; b.st[1] = nx; }
        const unsigned old = xb_add(&bar[XB_XSUB(b.x)], 1u);
        const unsigned gen = old / nloc;
        if (old + 1u == (gen + 1u) * nloc) {
            __builtin_amdgcn_fence(__ATOMIC_RELEASE, "agent");
            asm volatile("s_waitcnt vmcnt(0)" ::: "memory");
            const unsigned og = xb_add(&bar[XB_TOP], 1u);
            const unsigned tg = og / nx;
            if (og + 1u == (tg + 1u) * nx) xb_add(&bar[XB_TOPGEN], 1u);
            else XB_SPIN(xb_ld(&bar[XB_TOPGEN]) == tg, bar);
            __builtin_amdgcn_fence(__ATOMIC_ACQUIRE, "agent");
            xb_add(&bar[XB_XGEN(b.x)], 1u);
            asm volatile("s_waitcnt vmcnt(0)" ::: "memory");
        } else {
            XB_SPIN(xb_ld(&bar[XB_XGEN(b.x)]) == gen, bar);
            __builtin_amdgcn_fence(__ATOMIC_ACQUIRE, "agent");
            asm volatile("s_waitcnt vmcnt(0)" ::: "memory");
        }
    }
    __syncthreads();
}


__device__ __forceinline__ int lane_now() { int t = threadIdx.x; asm volatile("" : "+v"(t)); return t & 63; }
struct Frame {
    LAS unsigned char* lds;
    volatile LAS unsigned* MISC;
    gu32* ctl;
    int tid, lane, wave;
    int vcu, G;
};
__device__ __forceinline__ float wave_sum(float v) {
#pragma unroll
    for (int o = 1; o < 64; o <<= 1) v += __shfl_xor(v, o);
    return v;
}
__constant__ double ROPE_INV[16] = {
    1.0, 0.44036660267178046, 0.19392274474868576, 0.08539710028576561, 0.03760603093086393, 0.016560440080994446, 0.007292664737217109, 0.003211445994752591,
    0.001414213562373095, 0.000622772421914596, 0.0002742481756762073, 0.00012076973741146504, 5.318295896944988e-05, 2.341999896140934e-05, 1.031338537721246e-05, 4.5416704806078695e-06 };

__device__ __forceinline__ void p0_transpose_item(const float* W, int K, int N, bf16* WT, LAS float* scr, int item, int lane) {
    const int nblk = N / 32, kb = item / nblk, nb = item % nblk, k0 = 64 * kb, n0 = 32 * nb;
#pragma unroll 8
    for (int i = 0; i < 32; ++i) { const int kk = 2 * i + (lane >> 5); scr[kk * 33 + (lane & 31)] = W[(size_t)(k0 + kk) * N + n0 + (lane & 31)]; }
    LDS_WAIT(); asm volatile("" ::: "memory");
    const int c = lane & 7;
#pragma unroll
    for (int j = 0; j < 4; ++j) { const int n = (lane >> 3) + 8 * j; const LAS float* s = scr + (8 * c) * 33 + n;
        v4u o; o.x = pk2(s[0 * 33], s[1 * 33]); o.y = pk2(s[2 * 33], s[3 * 33]); o.z = pk2(s[4 * 33], s[5 * 33]); o.w = pk2(s[6 * 33], s[7 * 33]);
        *(GAS v4u*)(WT + (size_t)(n0 + n) * K + k0 + 8 * c) = o; }
    LDS_WAIT(); asm volatile("" ::: "memory");
}
constexpr int CONV_SCR = 64 * 65 * 4;
__device__ __forceinline__ void conv_item64(const float* W, int K, int N, bf16* WT, LAS float* scr, int item, int lane) {
    const int nblk = N >> 6, kb = item / nblk, nb = item - kb * nblk, k0 = kb << 6, n0 = nb << 6;
    const float* src = W + (size_t)(k0 + (lane >> 4)) * N + n0 + 4 * (lane & 15);
    f32x4 v[16];
#pragma unroll
    for (int i = 0; i < 16; ++i) v[i] = *(const f32x4*)(src + (size_t)(4 * i) * N);
    LAS float* d = scr + (lane >> 4) * 65 + 4 * (lane & 15);
#pragma unroll
    for (int i = 0; i < 16; ++i) { LAS float* p = d + i * (4 * 65); p[0] = v[i].x; p[1] = v[i].y; p[2] = v[i].z; p[3] = v[i].w; }
    LDS_WAIT(); asm volatile("" ::: "memory");
    const int c = lane & 7;
#pragma unroll
    for (int j = 0; j < 8; ++j) { const int n = (lane >> 3) + 8 * j; const LAS float* s = scr + (8 * c) * 65 + n;
        v4u o; o.x = pk2(s[0 * 65], s[1 * 65]); o.y = pk2(s[2 * 65], s[3 * 65]); o.z = pk2(s[4 * 65], s[5 * 65]); o.w = pk2(s[6 * 65], s[7 * 65]);
        const int ng = n0 + n;
        *(GAS v4u*)(WT + ((size_t)(ng >> 8) * (K >> 6) + kb) * 16384 + (size_t)(ng & 255) * 64 + 8 * c) = o; }
    LDS_WAIT(); asm volatile("" ::: "memory");
}
__device__ __forceinline__ void rms_row_to_bf16(const float* xrow, const float* g, bf16* orow, int lane) {
    const GAS f32x4* xr = (const GAS f32x4*)xrow + lane; const GAS f32x4* gr = (const GAS f32x4*)g + lane;
    f32x4 v[16]; float s = 0.f;
#pragma unroll
    for (int j = 0; j < 16; ++j) { v[j] = xr[64 * j]; s += (v[j].x * v[j].x + v[j].y * v[j].y) + (v[j].z * v[j].z + v[j].w * v[j].w); }
    const float rstd = 1.0f / sqrtf(wave_sum(s) * (1.f / DM) + EPS);
    GAS unsigned long long* o8 = (GAS unsigned long long*)orow + lane;
#pragma unroll
    for (int j = 0; j < 16; ++j) { const f32x4 gg = gr[64 * j];
        o8[64 * j] = (unsigned long long)pk2(v[j].x * rstd * gg.x, v[j].y * rstd * gg.y) | ((unsigned long long)pk2(v[j].z * rstd * gg.z, v[j].w * rstd * gg.w) << 32); }
}
__device__ __forceinline__ float lambda_of(const float* q1, const float* k1, const float* q2, const float* k2, int lane) {
    const float a = wave_sum(q1[lane] * k1[lane] + q1[64 + lane] * k1[64 + lane]);
    const float b = wave_sum(q2[lane] * k2[lane] + q2[64 + lane] * k2[64 + lane]);
    return expf(a) - expf(b) + LAM_INIT;
}

typedef const __attribute__((address_space(4))) char* kaptr;
__device__ __forceinline__ kaptr karg_base() { kaptr ka = (kaptr)__builtin_amdgcn_kernarg_segment_ptr(); asm volatile("" : "+s"(ka)); return ka; }
__device__ __forceinline__ const float* karg_in(int i) { return *(const float* const __attribute__((address_space(4)))*)(karg_base() + 8 * i); }
__device__ __forceinline__ float* karg_out() { return *(float* const __attribute__((address_space(4)))*)(karg_base() + 152); }
__device__ __forceinline__ unsigned char* karg_ws() { return *(unsigned char* const __attribute__((address_space(4)))*)(karg_base() + 160); }
struct SkInProj {
    bf16* qkv; float* out_kvs; const float* rope;
    __device__ __forceinline__ void operator()(const sk::f32x16 (&acc)[2], const sk::Item& it, int wid, int r32, int hi) const {
        const int col0 = it.t * 64, tt = col0 >> 11, ct0 = col0 & 2047;
        const bool rot = (tt < 2) && ((col0 & 127) == 0);
        const int d = r32 & 15; const float sgn = (r32 < 16) ? -1.f : 1.f;
        const int idx = (tt == 1) ? 0 : (tt == 2) ? 1 : (tt == 4) ? 2 : 3; const bool f32out = (tt == 1 || tt == 2 || tt == 4 || tt == 5);
        bf16* qb = qkv + (size_t)tt * ((size_t)MROWS * HW) + (size_t)TP * HW; float* fo = out_kvs + (size_t)idx * (TS * HW);
#pragma unroll
        for (int r = 0; r < 16; ++r) { const int row = 32 * wid + sk::crow(r, hi);
            float v0 = acc[0][r]; const float v1 = acc[1][r];
            const float other = __shfl_xor(v0, 16);
            if (rot) { const float cc = rope[(size_t)(TP + row) * 32 + d], ss = rope[(size_t)(TP + row) * 32 + 16 + d]; v0 = v0 * cc + sgn * other * ss; }
            qb[(size_t)row * HW + ct0 + r32] = (bf16)f2bf(v0); qb[(size_t)row * HW + ct0 + 32 + r32] = (bf16)f2bf(v1);
            if (f32out) { fo[(size_t)row * HW + ct0 + r32] = v0; fo[(size_t)row * HW + ct0 + 32 + r32] = v1; } }
    }
};
struct SkPartial {
    float* part; int N;
    __device__ __forceinline__ void operator()(const sk::f32x16 (&acc)[2], const sk::Item& it, int wid, int r32, int hi) const {
#pragma unroll
        for (int r = 0; r < 16; ++r) { float* p = part + ((size_t)it.ks * TS + 32 * wid + sk::crow(r, hi)) * N + it.t * 64 + r32; p[0] = acc[0][r]; p[32] = acc[1][r]; }
    }
};
struct SkUp {
    const float* ssq; bf16* U;
    __device__ __forceinline__ void operator()(const sk::f32x16 (&acc)[2], const sk::Item& it, int wid, int r32, int hi) const {
#pragma unroll
        for (int r = 0; r < 16; ++r) { const int row = 32 * wid + sk::crow(r, hi); const float rs = 1.0f / sqrtf(ssq[TP + row] * (1.f / DM) + EPS);
            const float a = fmaxf(acc[0][r] * rs, 0.f), b = fmaxf(acc[1][r] * rs, 0.f);
            bf16* p = U + (size_t)(TP + row) * DFF + it.t * 64 + r32; p[0] = (bf16)f2bf(a * a); p[32] = (bf16)f2bf(b * b); }
    }
};
struct Args { const float* in[19]; float* out; unsigned char* ws; int ph_lo, ph_hi, li, pad; };
static_assert(offsetof(Args, out) == 152 && offsetof(Args, ws) == 160 && sizeof(Args) == 184, "kernarg layout used by karg_*");
__global__ void __launch_bounds__(NWAVES * 64, 2) hybrid_fwd(Args args) {
    extern __shared__ __attribute__((aligned(16))) unsigned char lds[];
    Frame F;
    F.lds = (LAS unsigned char*)lds;
    F.MISC = (volatile LAS unsigned*)(F.lds + MISC_OFF);
    F.tid = threadIdx.x; F.lane = 0; F.wave = __builtin_amdgcn_readfirstlane(F.tid >> 6);
    F.G = gridDim.x; { const int bx = blockIdx.x; F.vcu = (F.G % 8 == 0) ? (bx % 8) * (F.G / 8) + bx / 8 : bx; }
    F.ctl = (gu32*)(karg_ws() + WS_CTL);
    constexpr size_t QS = (size_t)MROWS * HW;
#define KIN(i) karg_in(i)
#define KWS(T, off) ((T*)(karg_ws() + (off)))
#define KSSQ(w) ((float*)(karg_ws() + WS_CTL) + (w))
    for (int u = F.tid; u < (LDS_BYTES - LDSCTL_OFF) / 4; u += NWAVES * 64) ((LAS unsigned*)(F.lds + LDSCTL_OFF))[u] = 0u;
    __syncthreads();
    XcdBarrier bar; bar.bar = (unsigned*)(F.ctl + CW_BAR); bar.x = 0; bar.st = nullptr;
    if (N_LAUNCHES == 1) bar = xcd_barrier_post((unsigned*)(F.ctl + CW_BAR), F.MISC + 8);
#define GRID_BAR() do { if (N_LAUNCHES == 1) xcd_barrier(bar); } while (0)
    const int lo = args.ph_lo, hi = args.ph_hi;
#ifndef PH_MASK
#define PH_MASK 0xff
#endif
#define IN(k) (((PH_MASK >> (k)) & 1) && lo <= (k) && (k) < hi)
#define BOTH(k) (IN(k) && IN((k) + 1))
    const int gw = F.vcu * NWAVES + F.wave, NGW = F.G * NWAVES;

    if (IN(0)) {
        LAS float* scr = (LAS float*)(F.lds + RING_OFF + F.wave * CONV_SCR);
        const float* x_prompt = KIN(0); const float* x_sample = KIN(1); const float* g_attn = KIN(6); const float* w_in = KIN(7);
        bf16* Win_t = KWS(bf16, WS_WIN); bf16* H0 = KWS(bf16, WS_H0); float* ROPE = KWS(float, WS_ROPE);
        for (int it = gw; it < (DM / 64) * (NIN / 64); it += NGW) conv_item64(w_in, DM, NIN, Win_t, scr, it, lane_now());
        for (int m = gw; m < MROWS; m += NGW) rms_row_to_bf16(m < TP ? x_prompt + (size_t)m * DM : x_sample + (size_t)(m - TP) * DM, g_attn, H0 + (size_t)m * DM, lane_now());
        for (int e = blockIdx.x * (NWAVES * 64) + F.tid; e < MROWS * 16; e += F.G * NWAVES * 64) {
            const int row = e >> 4, d = e & 15; const int pos = row < TP ? row : PAST + ((row - TP) & 15);
            const double rev = (double)pos * ROPE_INV[d] * 0.15915494309189535; const float fr = (float)(rev - floor(rev));
            ROPE[(size_t)row * 32 + d] = __builtin_amdgcn_cosf(fr); ROPE[(size_t)row * 32 + 16 + d] = __builtin_amdgcn_sinf(fr);
        }
        if (BOTH(0)) GRID_BAR();
    }
    if (IN(1)) {
        float* out = karg_out();
        { pg8::Gemm g{KWS(bf16, WS_H0), KWS(bf16, WS_WIN), TP, NIN, DM, DM}; pg8::StaticOrder S; S.init(TP, NIN, F.G, (int)blockIdx.x, WGM_P1);
          pg8::EpiInProj E{KWS(bf16, WS_QKV), out + OUT_KVP, out + OUT_KVS, KWS(float, WS_ROPE)};
          if (!(args.pad & 32)) pg8::gemm_phase<pg8::EpiInProj, pg8::StaticOrder, true, true>(F.lds + RING_OFF, g, S, E); }
        if (!(args.pad & 16)) {
            const SkInProj E{KWS(bf16, WS_QKV), out + OUT_KVS, KWS(float, WS_ROPE)};
            for (int i = (int)blockIdx.x; i < NIN / 64; i += F.G) sk::skinny_item(sk::Item{i, 0, DM / 64, 0}, KWS(bf16, WS_H0) + (size_t)TP * DM, DM, KWS(bf16, WS_WIN), DM / 64, E, (LAS char*)(F.lds + RING_OFF));
        }
        if (BOTH(1)) GRID_BAR();
    }
    if (IN(2)) {
        LAS char* al = (LAS char*)(F.lds + RING_OFF);
        const bf16* QKV = KWS(bf16, WS_QKV); bf16* OB = KWS(bf16, WS_O);
        const bf16* AQ = QKV; const bf16* AK = QKV + QS; const bf16* AV = QKV + 2 * QS; const bf16* BQ = QKV + 3 * QS; const bf16* BK = QKV + 4 * QS; const bf16* BV = QKV + 5 * QS;
#ifndef P2_MASK
#define P2_MASK 7
#endif
        const int sub = args.pad ? args.pad : 15;
        if ((P2_MASK & 3) && (sub & 11)) {
            constexpr int NQE = 64 + DEC_B + 32;
            constexpr int CI_OUT = (DM / 64) * (DM / 64), CI_UP = (DM / 64) * (DFF / 64), CI_DOWN = (DFF / 64) * (DM / 64), CI_PER_UNIT = (CI_OUT + CI_UP + CI_DOWN) / 256;
            static_assert((CI_OUT + CI_UP + CI_DOWN) % 256 == 0 && CI_PER_UNIT % NWAVES == 0, "conversion items divide over 256 units x 8 waves");
            const int qx0 = (int)(xb_xcc_id() & 7u);
            for (int pass = 0; pass < 8; ++pass) {
                const int x = (qx0 + pass) & 7;
                for (;;) {
                    __syncthreads();
                    if (F.tid == 0) F.MISC[0] = __hip_atomic_fetch_add(F.ctl + CW_AQ + 64 * x, 1u, RLX_AGENT);
                    __syncthreads();
                    const int e = (int)F.MISC[0];
                    if (e >= NQE) break;
                    const int blk = e / 7, r = e - blk * 7;
                    if (r == 3 || r == 6) {
                        if (sub & 8) {
                            const int u = 32 * x + 2 * blk + (r == 6 ? 1 : 0); LAS float* scr = (LAS float*)(F.lds + RING_OFF + F.wave * CONV_SCR); const int lane = lane_now();
                            for (int t = 0; t < CI_PER_UNIT / NWAVES; ++t) {
                                int g = u * CI_PER_UNIT + t * NWAVES + F.wave;
                                if (g < CI_OUT) conv_item64(KIN(14), DM, DM, KWS(bf16, WS_WOUT), scr, g, lane);
                                else if (g < CI_OUT + CI_UP) conv_item64(KIN(16), DM, DFF, KWS(bf16, WS_WUP), scr, g - CI_OUT, lane);
                                else conv_item64(KIN(17), DFF, DM, KWS(bf16, WS_WDOWN), scr, g - CI_OUT - CI_UP, lane);
                            }
                        }
                        continue;
                    }
                    const int a = blk * 5 + (r < 3 ? r : r - 1);
                    const float lam = lambda_of(KIN(8), KIN(9), KIN(10), KIN(11), lane_now());
                    if (a >= 42 && a < 58) { if (sub & 2) att::attnA_sample_unit(a - 42, x, KIN(2), KIN(3), karg_out() + OUT_KVS, karg_out() + OUT_KVS + (size_t)TS * HW, AQ, lam, KIN(12), 1.0f - LAM_INIT, OB, al); }
                    else if (sub & 1) att::attnA_prompt_unit2(x, a < 42 ? 63 - a : 79 - a, AQ, AK, AV, lam, KIN(12), 1.0f - LAM_INIT, OB, al);
                }
            }
        }
        if ((P2_MASK & 4) && (sub & 4)) {
            LAS char* vbuf = al + F.wave * 16384; const float* g_sb = KIN(13); const float* cache_b_k = KIN(4); const float* cache_b_v = KIN(5);
            constexpr unsigned NBU = DEC_B * B_HEADS + B_HEADS * (TP / 32);
            for (;;) {
                unsigned u = 0;
                if (lane_now() == 0) u = __hip_atomic_fetch_add(F.ctl + CW_BQ, 1u, RLX_AGENT);
                u = (unsigned)__builtin_amdgcn_readfirstlane((int)u);
                if (u >= NBU) break;
                if (u < DEC_B * B_HEADS) att::stick_sample_unit((int)(u >> 4), (int)(u & 15), BQ, BK, BV, cache_b_k, cache_b_v, g_sb, OB, vbuf);
                else { const int idx = (int)u - DEC_B * B_HEADS; const int h = (idx >> 3) & 15, qt = (TP / 32 - 1) - ((idx & 7) | ((idx >> 7) << 3)); att::stick_prompt_unit(h, qt, BQ, BK, BV, g_sb, OB, vbuf); }
            }
        }
        if (BOTH(2)) GRID_BAR();
    }
    if (IN(3)) {
        { pg8::Gemm g{KWS(bf16, WS_O), KWS(bf16, WS_WOUT), TP, DM, DM, DM}; pg8::StaticOrder S; S.init(TP, DM, F.G, (int)blockIdx.x, WGM_P4);
          pg8::EpiOutProj E{KIN(0), KIN(1), KIN(15), KWS(bf16, WS_X1), KWS(bf16, WS_H1), KSSQ(CW_SSQ1)};
          if (!(args.pad & 32)) pg8::gemm_phase<pg8::EpiOutProj, pg8::StaticOrder, true, true>(F.lds + RING_OFF, g, S, E); }
        if (!(args.pad & 16)) {
            const SkPartial E{KWS(float, WS_PART2), DM};
            for (int i = (int)blockIdx.x; i < (DM / 64) * SPL2; i += F.G) sk::skinny_item(sk::Item{i >> 2, (i & 3) * (DM / 64 / SPL2), DM / 64 / SPL2, i & 3}, KWS(bf16, WS_O) + (size_t)TP * DM, DM, KWS(bf16, WS_WOUT), DM / 64, E, (LAS char*)(F.lds + RING_OFF));
        }
        if (BOTH(3)) GRID_BAR();
    }
    if (IN(4)) {
        const int lane = lane_now(); const float* PART = KWS(float, WS_PART2); const float* xs = KIN(1); const float* g = KIN(15); float* X1S = KWS(float, WS_X1S); bf16* H1 = KWS(bf16, WS_H1); float* SSQ1 = KSSQ(CW_SSQ1);
        for (int it = gw; it < TS * (DM / 512); it += NGW) {
            const int row = it / (DM / 512), col = (it % (DM / 512)) * 512 + lane * 8;
            f32x4 a0 = *(const f32x4*)(xs + (size_t)row * DM + col), a1 = *(const f32x4*)(xs + (size_t)row * DM + col + 4);
#pragma unroll
            for (int ks = 0; ks < SPL2; ++ks) { const float* p = PART + ((size_t)ks * TS + row) * DM + col; a0 += *(const f32x4*)p; a1 += *(const f32x4*)(p + 4); }
            float* xo = X1S + (size_t)row * DM + col; *(f32x4*)xo = a0; *(f32x4*)(xo + 4) = a1;
            const float ss = wave_sum((a0.x * a0.x + a0.y * a0.y) + (a0.z * a0.z + a0.w * a0.w) + (a1.x * a1.x + a1.y * a1.y) + (a1.z * a1.z + a1.w * a1.w));
            if (lane == 0) pg8::ssq_add(SSQ1 + TP + row, ss);
            const f32x4 g0 = *(const f32x4*)(g + col), g1 = *(const f32x4*)(g + col + 4);
            v4u w; w.x = pk2(a0.x * g0.x, a0.y * g0.y); w.y = pk2(a0.z * g0.z, a0.w * g0.w); w.z = pk2(a1.x * g1.x, a1.y * g1.y); w.w = pk2(a1.z * g1.z, a1.w * g1.w);
            *(v4u*)(H1 + (size_t)(TP + row) * DM + col) = w;
        }
        if (BOTH(4)) GRID_BAR();
    }
    if (IN(5)) {
        { pg8::Gemm g{KWS(bf16, WS_H1), KWS(bf16, WS_WUP), TP, DFF, DM, DM}; pg8::StaticOrder S; S.init(TP, DFF, F.G, (int)blockIdx.x, WGM_P5);
          pg8::EpiUp E{KSSQ(CW_SSQ1), KWS(bf16, WS_U)};
          if (!(args.pad & 32)) pg8::gemm_phase<pg8::EpiUp, pg8::StaticOrder, true, true>(F.lds + RING_OFF, g, S, E); }
        if (!(args.pad & 16)) {
            const SkUp E{KSSQ(CW_SSQ1), KWS(bf16, WS_U)};
            for (int i = (int)blockIdx.x; i < DFF / 64; i += F.G) sk::skinny_item(sk::Item{i, 0, DM / 64, 0}, KWS(bf16, WS_H1) + (size_t)TP * DM, DM, KWS(bf16, WS_WUP), DM / 64, E, (LAS char*)(F.lds + RING_OFF));
        }
        if (BOTH(5)) GRID_BAR();
    }
    if (IN(6)) {
        { pg8::Gemm g{KWS(bf16, WS_U), KWS(bf16, WS_WDOWN), TP, DM, DFF, DFF}; pg8::StaticOrder S; S.init(TP, DM, F.G, (int)blockIdx.x, WGM_P6);
          pg8::EpiDown E{KWS(bf16, WS_X1), KWS(bf16, WS_X2B), KSSQ(CW_SSQ2)};
          if (!(args.pad & 32)) pg8::gemm_phase<pg8::EpiDown, pg8::StaticOrder, true, true>(F.lds + RING_OFF, g, S, E); }
        if (!(args.pad & 16)) {
            const SkPartial E{KWS(float, WS_PART4), DM};
            for (int i = (int)blockIdx.x; i < (DM / 64) * SPL4; i += F.G) sk::skinny_item(sk::Item{i >> 2, (i & 3) * (DFF / 64 / SPL4), DFF / 64 / SPL4, i & 3}, KWS(bf16, WS_U) + (size_t)TP * DFF, DFF, KWS(bf16, WS_WDOWN), DFF / 64, E, (LAS char*)(F.lds + RING_OFF));
        }
        if (BOTH(6)) GRID_BAR();
    }
    if (IN(7)) {
        unsigned bad = __hip_atomic_load(F.ctl + CW_BAR + XB_TMO, RLX_AGENT);
        const float poison = bad ? __builtin_nanf("") : 0.f; float* out = karg_out(); const float* g_final = KIN(18); const float* SSQ2 = KSSQ(CW_SSQ2);
        const int lane = lane_now();
        for (int m = gw; m < TS; m += NGW) {
            const float* PART = KWS(float, WS_PART4); const GAS f32x4* xr = (const GAS f32x4*)(KWS(float, WS_X1S) + (size_t)m * DM) + lane;
            f32x4 v[16]; float s = 0.f;
#pragma unroll
            for (int j = 0; j < 16; ++j) v[j] = xr[64 * j];
#pragma unroll 1
            for (int ks = 0; ks < SPL4; ++ks) { const GAS f32x4* pr = (const GAS f32x4*)(PART + ((size_t)ks * TS + m) * DM) + lane;
#pragma unroll
                for (int j = 0; j < 16; ++j) v[j] += pr[64 * j]; }
#pragma unroll
            for (int j = 0; j < 16; ++j) s += (v[j].x * v[j].x + v[j].y * v[j].y) + (v[j].z * v[j].z + v[j].w * v[j].w);
            const float rs = 1.0f / sqrtf(wave_sum(s) * (1.f / DM) + EPS) + poison;
            GAS f32x4* yr = (GAS f32x4*)(out + OUT_Y + (size_t)(TP + m) * DM) + lane; const GAS f32x4* gr = (const GAS f32x4*)g_final + lane;
#pragma unroll
            for (int j = 0; j < 16; ++j) yr[64 * j] = v[j] * rs * gr[64 * j];
        }
        const bf16* X2B = KWS(bf16, WS_X2B);
        for (int m = gw; m < TP; m += NGW) {
            const float rs = 1.0f / sqrtf(SSQ2[m] * (1.f / DM) + EPS) + poison;
            const GAS v4u* xr = (const GAS v4u*)(X2B + (size_t)m * DM) + lane; GAS f32x4* yr = (GAS f32x4*)(out + OUT_Y + (size_t)m * DM) + 2 * lane; const GAS f32x4* gr = (const GAS f32x4*)g_final + 2 * lane;
#pragma unroll
            for (int j = 0; j < 8; ++j) { const v4u w = xr[64 * j]; const f32x4 g0 = gr[128 * j], g1 = gr[128 * j + 1];
                yr[128 * j] = (f32x4){pg8::bf_lo(w.x), pg8::bf_hi(w.x), pg8::bf_lo(w.y), pg8::bf_hi(w.y)} * rs * g0; yr[128 * j + 1] = (f32x4){pg8::bf_lo(w.z), pg8::bf_hi(w.z), pg8::bf_lo(w.w), pg8::bf_hi(w.w)} * rs * g1; }
        }
    }
#undef IN
#undef BOTH
#undef GRID_BAR
}

extern "C" void kernel_launch(void* const* d_in, const int* in_sizes, int n_in, void* d_out, int out_size, void* d_ws, size_t ws_size, hipStream_t stream) {
    static int grid = 0;
    if (grid == 0) {
        if (n_in != 19 || in_sizes[0] != TP * DM || (size_t)out_size != OUT_TOTAL || ws_size < WS_END) {
            fprintf(stderr, "kernel_launch: shape mismatch (n_in %d, in0 %d, out %d, ws %zu; need ws >= %zu); nothing launched\n", n_in, n_in > 0 ? in_sizes[0] : -1, out_size, ws_size, (size_t)WS_END); grid = -1; return; }
        int dev = 0, cus = 0, per_cu = 0;
        if (hipGetDevice(&dev) != hipSuccess || hipDeviceGetAttribute(&cus, hipDeviceAttributeMultiprocessorCount, dev) != hipSuccess) { grid = -1; return; }
        if (hipFuncSetAttribute((const void*)hybrid_fwd, hipFuncAttributeMaxDynamicSharedMemorySize, LDS_BYTES) != hipSuccess) { fprintf(stderr, "kernel_launch: hipFuncSetAttribute failed\n"); grid = -1; return; }
        if (hipOccupancyMaxActiveBlocksPerMultiprocessor(&per_cu, (const void*)hybrid_fwd, NWAVES * 64, LDS_BYTES) != hipSuccess || per_cu < 1) { fprintf(stderr, "kernel_launch: occupancy query reports %d blocks per CU\n", per_cu); grid = -1; (void)hipGetLastError(); return; }
        (void)hipGetLastError();
        grid = cus;
    }
    if (grid < 0) return;
    if (hipMemsetAsync((char*)d_ws + WS_CTL, 0, CTL_ZERO_BYTES, stream) != hipSuccess) return;
    Args a{};
    for (int i = 0; i < 19; ++i) a.in[i] = (const float*)d_in[i];
    a.out = (float*)d_out; a.ws = (unsigned char*)d_ws;
#ifndef DUP_MASK
#define DUP_MASK 0
#endif
    for (int li = 0; li < N_LAUNCHES; ++li) {
        a.ph_lo = (N_LAUNCHES == 1) ? 0 : li; a.ph_hi = (N_LAUNCHES == 1) ? N_PHASES : li + 1; a.li = li; a.pad = 0;
        if (N_LAUNCHES != 1 && ((DUP_MASK >> li) & 1)) hipLaunchKernelGGL(hybrid_fwd, dim3(grid), dim3(NWAVES * 64), LDS_BYTES, stream, a);
#ifdef DUP_SUB
#ifndef DUP_PH
#define DUP_PH 2
#endif
        if (N_LAUNCHES != 1 && li == DUP_PH) { a.pad = DUP_SUB; hipLaunchKernelGGL(hybrid_fwd, dim3(grid), dim3(NWAVES * 64), LDS_BYTES, stream, a); a.pad = 0;
            (void)hipMemsetAsync((char*)d_ws + WS_CTL + CW_BQ * 4, 0, (CW_AQ + 64 * 8 - CW_BQ) * 4, stream); }
#endif
        hipLaunchKernelGGL(hybrid_fwd, dim3(grid), dim3(NWAVES * 64), LDS_BYTES, stream, a);
        const hipError_t le = hipPeekAtLastError();
        if (le != hipSuccess) { fprintf(stderr, "kernel_launch: launch %d failed: %s\n", li, hipGetErrorName(le)); break; }
    }
}
```
